# Optimizing an MI355X kernel written in HIP

```python
import math
import jax, jax.numpy as jnp
from jax import lax
import numpy as np

D_MODEL = 1024
BATCH = 8
SEQ = 4096
DEPTH = 1
DEC_BATCH = 128
DEC_SEQ = 4
PAST_LEN = 8192
PAGE_SIZE = 128

NORM_EPS = 1e-6
SSD_D_INNER = D_MODEL
SSD_HEAD_DIM = 64
SSD_N_HEADS = SSD_D_INNER // SSD_HEAD_DIM
SSD_N_GROUPS = 4
SSD_D_STATE = 128
SSD_CONV = 4
SSD_CHUNK = 128
SSD_CONV_DIM = SSD_D_INNER + 2 * SSD_N_GROUPS * SSD_D_STATE
ATT_WINDOWS = (128, 512, 2048)
ATT_DILATIONS = (1, 4, 16)
ATT_N_GROUPS = 3
ATT_HEADS = 8
ATT_HEAD_DIM = 64
ATT_WIDTH = ATT_HEADS * ATT_HEAD_DIM
ROPE_DIM = ATT_HEAD_DIM // 4
ROPE_THETA = 500000.0
MEM_LEN = 256
MEM_HEADS = 4
MEM_HEAD_DIM = 128
MEM_WIDTH = MEM_HEADS * MEM_HEAD_DIM
N_BRANCHES = 3
IN_SIZES = (SSD_D_INNER, SSD_CONV_DIM, SSD_N_HEADS, ATT_N_GROUPS * 3 * ATT_WIDTH, ATT_WIDTH, MEM_WIDTH, MEM_WIDTH, N_BRANCHES * D_MODEL)
D_IN_PROJ = sum(IN_SIZES)
NEG_INF = -1e30

kernel_name = 'hybrid_ssd_dilated_attn_decoder_step'


def _rmsnorm(x, w):
    x32 = x.astype(jnp.float32)
    r = x32 * lax.rsqrt(jnp.mean(x32 * x32, axis=-1, keepdims=True) + NORM_EPS)
    return (r * w.astype(jnp.float32)).astype(x.dtype)


def _split_in(u):
    cuts = [int(c) for c in np.cumsum(IN_SIZES)[:-1]]
    return jnp.split(u, cuts, axis=-1)


def _rope(x, pos):
    half = ROPE_DIM // 2
    inv = jnp.power(ROPE_THETA, -jnp.arange(half, dtype=jnp.float32) * 2.0 / ROPE_DIM)
    ang = pos.astype(jnp.float32)[:, None] * inv[None, :]
    shape = (1, x.shape[1]) + (1,) * (x.ndim - 3) + (half,)
    cos = jnp.cos(ang).reshape(shape).astype(x.dtype)
    sin = jnp.sin(ang).reshape(shape).astype(x.dtype)
    x1, x2, rest = x[..., :half], x[..., half:ROPE_DIM], x[..., ROPE_DIM:]
    return jnp.concatenate([x1 * cos - x2 * sin, x2 * cos + x1 * sin, rest], axis=-1)


def _dilated_prompt(q, k, v, window, dil):
    b, s, h, dh = q.shape
    nk = window // dil
    length = s // dil
    nb = -(-length // nk)
    lp = nb * nk

    def to_blocks(a):
        a = a.reshape(b, length, dil, h, dh).transpose(0, 2, 1, 3, 4)
        a = jnp.pad(a, ((0, 0), (0, 0), (0, lp - length), (0, 0), (0, 0)))
        return a.reshape(b, dil, nb, nk, h, dh)

    def with_prev(a):
        prev = jnp.pad(a, ((0, 0), (0, 0), (1, 0), (0, 0), (0, 0), (0, 0)))[:, :, :nb]
        return jnp.concatenate([prev, a], axis=3)

    qb = to_blocks(q)
    kb = with_prev(to_blocks(k))
    vb = with_prev(to_blocks(v))
    sc = jnp.einsum('brnqhd,brnkhd->brnhqk', qb, kb, preferred_element_type=jnp.float32) * (dh ** -0.5)
    qi = jnp.arange(nk)[:, None]
    kj = jnp.arange(2 * nk)[None, :]
    rel = nk + qi - kj
    blk = jnp.arange(nb)[:, None, None]
    valid = (rel >= 0) & (rel <= nk) & ((blk - 1) * nk + kj >= 0)
    sc = jnp.where(valid[None, None, :, None], sc, NEG_INF)
    m = jnp.max(sc, axis=-1, keepdims=True)
    p = jnp.exp(sc - m)
    den = jnp.sum(p, axis=-1, keepdims=True)
    o = jnp.einsum('brnhqk,brnkhd->brnqhd', p.astype(v.dtype), vb, preferred_element_type=jnp.float32)
    o = o / jnp.swapaxes(den, 3, 4)
    lse = jnp.swapaxes((m + jnp.log(den))[..., 0], 3, 4)

    def from_blocks(a):
        a = a.reshape((b, dil, lp) + a.shape[4:])[:, :, :length]
        a = jnp.moveaxis(a, 1, 2)
        return a.reshape((b, s) + a.shape[3:])

    return from_blocks(o), from_blocks(lse)


def _dilated_sample(q, kv_new, buf, window, dil):
    b, t, h, dh = q.shape
    nk = window // dil
    wb = buf.shape[1]
    idx = wb + jnp.arange(t)[:, None] - dil * jnp.arange(nk + 1)[None, :]
    valid = idx >= 0
    kv_old = buf[:, jnp.clip(idx, 0, wb - 1)]
    kv_cur = kv_new.astype(buf.dtype)[:, jnp.clip(idx - wb, 0, t - 1)]
    kv_g = jnp.where((idx >= wb)[None, :, :, None, None, None], kv_cur, kv_old)
    sc = jnp.einsum('bthd,btkhd->bthk', q, kv_g[:, :, :, 0], preferred_element_type=jnp.float32) * (dh ** -0.5)
    sc = jnp.where(valid[None, :, None, :], sc, NEG_INF)
    m = jnp.max(sc, axis=-1, keepdims=True)
    p = jnp.exp(sc - m)
    den = jnp.sum(p, axis=-1, keepdims=True)
    o = jnp.einsum('bthk,btkhd->bthd', p.astype(kv_g.dtype), kv_g[:, :, :, 1], preferred_element_type=jnp.float32) / den
    lse = (m + jnp.log(den))[..., 0]
    return o, lse


def _mem_kv(mem, mem_norm_w, w_mem_kv):
    b, m, _ = mem.shape
    return (_rmsnorm(mem, mem_norm_w) @ w_mem_kv).reshape(b, m, 2, MEM_HEADS, MEM_HEAD_DIM)


def _mem_attn(q, kv):
    b, t = q.shape[0], q.shape[1]
    sc = jnp.einsum('bthd,bmhd->bhtm', q, kv[:, :, 0], preferred_element_type=jnp.float32) * (MEM_HEAD_DIM ** -0.5)
    p = jax.nn.softmax(sc, axis=-1)
    o = jnp.einsum('bhtm,bmhd->bthd', p.astype(kv.dtype), kv[:, :, 1])
    return o.reshape(b, t, MEM_WIDTH)


def _ssd_scan(x, dt, a_neg, bm, cm, init_state):
    b, t, h, p = x.shape
    g, n = bm.shape[2], bm.shape[3]
    e = h // g
    q = min(SSD_CHUNK, t)
    nc = -(-t // q)
    pad = nc * q - t

    def padf(a):
        return jnp.pad(a, ((0, 0), (0, pad)) + ((0, 0),) * (a.ndim - 2))

    x, dt, bm, cm = padf(x), padf(dt), padf(bm), padf(cm)
    xdt = (x * dt[..., None]).reshape(b, nc, q, g, e, p)
    acs = jnp.cumsum((dt * a_neg).reshape(b, nc, q, g, e), axis=2)
    bm = bm.reshape(b, nc, q, g, n)
    cm = cm.reshape(b, nc, q, g, n)
    diff = acs[:, :, :, None] - acs[:, :, None, :]
    tril = jnp.tril(jnp.ones((q, q), dtype=bool))[None, None, :, :, None, None]
    lmat = jnp.exp(jnp.where(tril, diff, -jnp.inf))
    cb = jnp.einsum('bclgn,bcsgn->bclsg', cm, bm)
    y_diag = jnp.einsum('bclsg,bclsge,bcsgep->bclgep', cb, lmat, xdt)
    decay_out = jnp.exp(acs[:, :, -1:] - acs)
    st = jnp.einsum('bclgn,bclge,bclgep->bcgepn', bm, decay_out, xdt)
    chunk_decay = jnp.exp(acs[:, :, -1])

    def step(s, inp):
        dec, add = inp
        return s * dec[..., None, None] + add, s

    final, prev = lax.scan(step, init_state.reshape(b, g, e, p, n),
                           (chunk_decay.transpose(1, 0, 2, 3), st.transpose(1, 0, 2, 3, 4, 5)))
    prev = prev.transpose(1, 0, 2, 3, 4, 5)
    y_off = jnp.einsum('bclgn,bcgepn,bclge->bclgep', cm, prev, jnp.exp(acs))
    y = (y_diag + y_off).reshape(b, nc * q, h, p)[:, :t]
    return y, final.reshape(b, h, p, n)


def _ssd_branch(z, xbc, dt_raw, conv_prev, ssm_prev, conv_w, conv_b, dt_bias, a_log, d_skip, ssd_norm_w):
    b, t, _ = xbc.shape
    xp = jnp.concatenate([conv_prev.astype(xbc.dtype), xbc], axis=1)
    acc = conv_b + xp[:, 0:t] * conv_w[0]
    for kk in range(1, SSD_CONV):
        acc = acc + xp[:, kk:kk + t] * conv_w[kk]
    xc = jax.nn.silu(acc)
    new_conv = xp[:, xp.shape[1] - (SSD_CONV - 1):]
    gn = SSD_N_GROUPS * SSD_D_STATE
    xs = xc[..., :SSD_D_INNER].reshape(b, t, SSD_N_HEADS, SSD_HEAD_DIM).astype(jnp.float32)
    bm = xc[..., SSD_D_INNER:SSD_D_INNER + gn].reshape(b, t, SSD_N_GROUPS, SSD_D_STATE).astype(jnp.float32)
    cm = xc[..., SSD_D_INNER + gn:].reshape(b, t, SSD_N_GROUPS, SSD_D_STATE).astype(jnp.float32)
    dt = jax.nn.softplus(dt_raw.astype(jnp.float32) + dt_bias.astype(jnp.float32))
    a_neg = -jnp.exp(a_log.astype(jnp.float32))
    y, new_ssm = _ssd_scan(xs, dt, a_neg, bm, cm, ssm_prev.astype(jnp.float32))
    y = y + d_skip.astype(jnp.float32)[:, None] * xs
    y = y.reshape(b, t, SSD_D_INNER).astype(z.dtype)
    y = _rmsnorm(y * jax.nn.silu(z), ssd_norm_w)
    return y, new_conv, new_ssm.astype(ssm_prev.dtype)


def _layer(x, pos0, mem_kv, conv_prev, ssm_prev, win_bufs, norm_in_w, w_in, conv_w, conv_b, dt_bias, a_log,
           d_skip, ssd_norm_w, w_br_ssd, w_br_att, w_br_mem, w_out, norm_f_w):
    b, t, _ = x.shape
    h = _rmsnorm(x, norm_in_w)
    u = h @ w_in
    z_ssd, xbc, dt_raw, qkv, z_att, q_mem, z_mem, gate_raw = _split_in(u)
    y_ssd, new_conv, new_ssm = _ssd_branch(z_ssd, xbc, dt_raw, conv_prev, ssm_prev, conv_w, conv_b,
                                           dt_bias, a_log, d_skip, ssd_norm_w)
    qkv = qkv.reshape(b, t, ATT_N_GROUPS, 3, ATT_HEADS, ATT_HEAD_DIM)
    pos = pos0 + jnp.arange(t)
    q = _rope(qkv[:, :, :, 0], pos)
    k = _rope(qkv[:, :, :, 1], pos)
    v = qkv[:, :, :, 2]
    kv = jnp.stack([k, v], axis=3)
    outs, lses, new_win = [], [], []
    for gi in range(ATT_N_GROUPS):
        w, d = ATT_WINDOWS[gi], ATT_DILATIONS[gi]
        if win_bufs is None:
            o, l = _dilated_prompt(q[:, :, gi], k[:, :, gi], v[:, :, gi], w, d)
            new_win.append(kv[:, t - min(w, t):, gi])
        else:
            o, l = _dilated_sample(q[:, :, gi], kv[:, :, gi], win_bufs[gi], w, d)
            new_win.append(kv[:, :, gi])
        outs.append(o)
        lses.append(l)
    wts = jax.nn.softmax(jnp.stack(lses), axis=0)
    o_att = jnp.sum(wts[..., None] * jnp.stack(outs), axis=0).reshape(b, t, ATT_WIDTH).astype(x.dtype)
    y_att = o_att * jax.nn.silu(z_att)
    y_mem = _mem_attn(q_mem.reshape(b, t, MEM_HEADS, MEM_HEAD_DIM), mem_kv).astype(x.dtype) * jax.nn.silu(z_mem)
    gates = jax.nn.sigmoid(gate_raw).reshape(b, t, N_BRANCHES, D_MODEL)
    merged = (gates[:, :, 0] * (y_ssd @ w_br_ssd) + gates[:, :, 1] * (y_att @ w_br_att)
              + gates[:, :, 2] * (y_mem @ w_br_mem))
    y = _rmsnorm(x + merged @ w_out, norm_f_w)
    return y, new_win, new_conv, new_ssm


def setup_inputs(seed: int = 0) -> dict:
    key = jax.random.key(seed)
    ks = jax.random.split(key, 32)
    f32 = jnp.float32

    def nrm(k, shape, scale):
        return scale * jax.random.normal(k, shape, f32)

    dt0 = jnp.exp(jax.random.uniform(ks[0], (SSD_N_HEADS,), f32, math.log(1e-3), math.log(1e-1)))
    win_shape = lambda w: (DEC_BATCH, min(w, PAST_LEN), 2, ATT_HEADS, ATT_HEAD_DIM)
    return {
        'x_prompt': nrm(ks[1], (BATCH, SEQ, D_MODEL), 1.0),
        'x_sample': nrm(ks[2], (DEC_BATCH, DEC_SEQ, D_MODEL), 1.0),
        'mem_prompt': nrm(ks[3], (BATCH, MEM_LEN, D_MODEL), 1.0),
        'cache_win128_kv': nrm(ks[4], win_shape(ATT_WINDOWS[0]), 1.0),
        'cache_win512_kv': nrm(ks[5], win_shape(ATT_WINDOWS[1]), 1.0),
        'cache_win2048_kv': nrm(ks[6], win_shape(ATT_WINDOWS[2]), 1.0),
        'cache_mem_kv': nrm(ks[7], (DEC_BATCH, MEM_LEN, 2, MEM_HEADS, MEM_HEAD_DIM), 1.0),
        'state_conv': nrm(ks[8], (DEC_BATCH, SSD_CONV - 1, SSD_CONV_DIM), 1.0),
        'state_ssm': nrm(ks[9], (DEC_BATCH, SSD_N_HEADS, SSD_HEAD_DIM, SSD_D_STATE), 0.1),
        'norm_in_w': 1.0 + nrm(ks[10], (D_MODEL,), 0.02),
        'w_in': nrm(ks[11], (D_MODEL, D_IN_PROJ), D_MODEL ** -0.5),
        'conv_w': nrm(ks[12], (SSD_CONV, SSD_CONV_DIM), SSD_CONV ** -0.5),
        'conv_b': nrm(ks[13], (SSD_CONV_DIM,), 0.01),
        'dt_bias': dt0 + jnp.log(-jnp.expm1(-dt0)),
        'a_log': jnp.log(jax.random.uniform(ks[14], (SSD_N_HEADS,), f32, 1.0, 16.0)),
        'd_skip': 1.0 + nrm(ks[15], (SSD_N_HEADS,), 0.1),
        'ssd_norm_w': 1.0 + nrm(ks[16], (SSD_D_INNER,), 0.02),
        'mem_norm_w': 1.0 + nrm(ks[17], (D_MODEL,), 0.02),
        'w_mem_kv': nrm(ks[18], (D_MODEL, 2 * MEM_WIDTH), D_MODEL ** -0.5),
        'w_br_ssd': nrm(ks[19], (SSD_D_INNER, D_MODEL), SSD_D_INNER ** -0.5),
        'w_br_att': nrm(ks[20], (ATT_WIDTH, D_MODEL), ATT_WIDTH ** -0.5),
        'w_br_mem': nrm(ks[21], (MEM_WIDTH, D_MODEL), MEM_WIDTH ** -0.5),
        'w_out': nrm(ks[22], (D_MODEL, D_MODEL), D_MODEL ** -0.5),
        'norm_f_w': 1.0 + nrm(ks[23], (D_MODEL,), 0.02),
    }


def reference(x_prompt, x_sample, mem_prompt, cache_win128_kv, cache_win512_kv, cache_win2048_kv, cache_mem_kv,
              state_conv, state_ssm, norm_in_w, w_in, conv_w, conv_b, dt_bias, a_log, d_skip, ssd_norm_w,
              mem_norm_w, w_mem_kv, w_br_ssd, w_br_att, w_br_mem, w_out, norm_f_w):
    bp = x_prompt.shape[0]
    p_mem_kv = _mem_kv(mem_prompt, mem_norm_w, w_mem_kv)
    conv0 = jnp.zeros((bp, SSD_CONV - 1, SSD_CONV_DIM), x_prompt.dtype)
    ssm0 = jnp.zeros((bp, SSD_N_HEADS, SSD_HEAD_DIM, SSD_D_STATE), jnp.float32)
    y_prompt, p_win, p_conv, p_ssm = _layer(
        x_prompt, 0, p_mem_kv, conv0, ssm0, None, norm_in_w, w_in, conv_w, conv_b, dt_bias, a_log, d_skip,
        ssd_norm_w, w_br_ssd, w_br_att, w_br_mem, w_out, norm_f_w)
    y_sample, s_win, s_conv, s_ssm = _layer(
        x_sample, PAST_LEN, cache_mem_kv, state_conv, state_ssm, (cache_win128_kv, cache_win512_kv, cache_win2048_kv),
        norm_in_w, w_in, conv_w, conv_b, dt_bias, a_log, d_skip, ssd_norm_w, w_br_ssd, w_br_att, w_br_mem,
        w_out, norm_f_w)
    return (y_prompt, y_sample, p_win[0], p_win[1], p_win[2], p_mem_kv, p_conv, p_ssm,
            s_win[0], s_win[1], s_win[2], s_conv, s_ssm)
```

```cpp
#include <hip/hip_runtime.h>
#include <cstdio>
#include <cstdint>

#ifndef MK_ONE_LAUNCH
#define MK_ONE_LAUNCH 0
#endif

#define GAS __attribute__((address_space(1)))
#define LAS __attribute__((address_space(3)))
typedef unsigned short bf16_t;
typedef short bf16x8 __attribute__((ext_vector_type(8)));
typedef float f32x4 __attribute__((ext_vector_type(4)));
typedef float f32x2 __attribute__((ext_vector_type(2)));
typedef unsigned u32x4 __attribute__((ext_vector_type(4)));
typedef unsigned u32x2 __attribute__((ext_vector_type(2)));
#define RLX_AGENT __ATOMIC_RELAXED, __HIP_MEMORY_SCOPE_AGENT
#define LDS_WAIT() asm volatile("s_waitcnt lgkmcnt(0)" ::: "memory")
#define VM_WAIT() asm volatile("s_waitcnt vmcnt(0)" ::: "memory")

constexpr int DM = 1024;
constexpr int RP = 8 * 4096, RS = 128 * 4, RT = RP + RS;
constexpr int NINP = 12544;
constexpr int LDU = 12288;
constexpr int U_Z = 0, U_XBC = 1024, U_QKV = 3072, U_ZA = 7680, U_QM = 8192, U_ZM = 8704, U_GATE = 9216;
constexpr int LDA = 2048;
constexpr float EPS = 1e-6f;
constexpr size_t O_YP = 0, O_YS = 33554432, O_PW128 = 34078720, O_PW512 = 35127296, O_PW2048 = 39321600, O_PMEM = 56098816, O_PCONV = 58195968, O_PSSM = 58245120,
                 O_SW128 = 59293696, O_SW512 = 59817984, O_SW2048 = 60342272, O_SCONV = 60866560, O_SSSM = 61652992, O_TOTAL = 78430208;
constexpr size_t MiB = 1u << 20;
constexpr size_t WS_CTL = 0, CTL_ZERO_BYTES = 1 * MiB;
constexpr size_t WS_WIN = 1 * MiB;
constexpr size_t WS_WMEM = 26 * MiB;
constexpr size_t WS_WBR = 30 * MiB;
constexpr size_t WS_WOUT = 34 * MiB;
constexpr size_t WS_CS = 36 * MiB;
constexpr size_t WS_DT = 37 * MiB;
constexpr size_t WS_SSQ = 40 * MiB;
constexpr size_t WS_RSQ = 43 * MiB;
constexpr size_t WS_MB = 46 * MiB;
constexpr size_t WS_MKV = 50 * MiB;
constexpr size_t WS_XB = 58 * MiB;
constexpr size_t WS_MERGED = 124 * MiB;
constexpr size_t WS_ACAT = 190 * MiB;
constexpr size_t WS_U = 321 * MiB;
constexpr size_t WS_END = WS_U + (size_t)RT * LDU * 2;
static_assert(WS_WIN + (size_t)NINP * 1024 * 2 <= WS_WMEM && WS_XB + (size_t)RT * 1024 * 2 <= WS_MERGED && WS_MERGED + (size_t)RT * 1024 * 2 <= WS_ACAT && WS_ACAT + (size_t)RT * LDA * 2 <= WS_U, "d_ws map");
constexpr int CW_Q = 64;
constexpr int CW_BAR = 4096;
constexpr int RING_BYTES = 131072, LDSCTL_OFF = RING_BYTES, MISC_OFF = LDSCTL_OFF + 320, LDS_BYTES = 147456;
constexpr int NWAVES = 8, NTHREADS = 512;

__device__ __forceinline__ float bf2f(bf16_t b) { return __uint_as_float(((unsigned)b) << 16); }
__device__ __forceinline__ unsigned f2bf(float f) { unsigned u = __float_as_uint(f); return (u + 0x7fffu + ((u >> 16) & 1u)) >> 16; }
__device__ __forceinline__ unsigned pk2(float lo, float hi) { return f2bf(lo) | (f2bf(hi) << 16); }
__device__ __forceinline__ float silu_f(float x) { return x / (1.0f + __expf(-x)); }
__device__ __forceinline__ float wave_sum(float v) {
#pragma unroll
    for (int o = 1; o < 64; o <<= 1) v += __shfl_xor(v, o);
    return v;
}
__device__ __forceinline__ float wave_max(float v) {
#pragma unroll
    for (int o = 1; o < 64; o <<= 1) v = fmaxf(v, __shfl_xor(v, o));
    return v;
}
namespace pg8 {
constexpr int BM = 256, BK = 64, HALF = 128, HTB = HALF * BK * 2  , STAGE_BYTES = 8 * HTB, NXCD = 8, WGM = 8;

__host__ __device__ __forceinline__ int lds_byte(int r, int c) { const int st = (r >> 4) * 2 + (c >> 5), rr = r & 15, cc = c & 31, ob = rr * 64 + cc * 2; return st * 1024 + (ob ^ (((ob >> 9) & 1) << 5)); }
__host__ __device__ __forceinline__ void stage_rc(int b, int& R, int& C) { const int st = b / 1024, sb = b % 1024, swz = sb ^ (((sb >> 9) & 1) << 5); R = (st >> 1) * 16 + swz / 64; C = (st & 1) * 32 + (swz % 64) / 2; }
__host__ __device__ __forceinline__ int perm32(int rho) { const int n = rho >> 4, i = rho & 15; return 8 * (i >> 2) + 4 * n + (i & 3); }

struct Unit { int pm, pn, k0, nt, kind; };
struct Gemm { const bf16_t* A; const bf16_t* Bt; int ld; };

struct TileOrder {
    int nM, nN, nwg, G, c, nsub, ntfull;
    __device__ __forceinline__ void init(int nM_, int nN_, int G_, int c_, int nsub_, int ntfull_) { nM = nM_; nN = nN_; nwg = nM * nN; G = G_; c = c_; nsub = nsub_; ntfull = ntfull_; }
    __device__ __forceinline__ bool next(int i, Unit& u) const {
        int ti = i, sub = 0;
        if (nsub == 3) { ti = i / 3; sub = i - 3 * ti; }
        const long L = (long)ti * G + c; if (L >= nwg) return false;
        int wgid = (int)L; { const int q = nwg / NXCD, r = nwg % NXCD, xcd = wgid % NXCD, off = wgid / NXCD; wgid = (xcd < r ? xcd * (q + 1) : r * (q + 1) + (xcd - r) * q) + off; }
        const int nig = WGM * nN, gid = wgid / nig, fm = gid * WGM, gsz = (nM - fm) < WGM ? (nM - fm) : WGM;
        u.pm = fm + ((wgid % nig) % gsz); u.pn = (wgid % nig) / gsz; u.kind = sub;
        if (nsub == 3) { u.k0 = sub == 0 ? 0 : (sub == 1 ? 1024 : 1536); u.nt = sub == 0 ? 16 : 8; } else { u.k0 = 0; u.nt = ntfull; }
        return true;
    }
};

__device__ __forceinline__ unsigned cvt_pk_bf16(float lo, float hi) { unsigned r; asm volatile("v_cvt_pk_bf16_f32 %0, %1, %2" : "=v"(r) : "v"(lo), "v"(hi)); return r; }

template <class Epi, class Sched, bool ALIGN_EPI = true>
__device__ __forceinline__ void gemm_phase(LAS unsigned char* lds, const Gemm g, const Sched& S, const Epi& E) {
    const int tid = threadIdx.x, wid = __builtin_amdgcn_readfirstlane(tid >> 6), lane = tid & 63, wr = wid >> 2, wc = wid & 3, fr = lane & 15, fq = lane >> 4;
    const int K = g.ld;
    unsigned voffA[2], voffB[2];
#pragma unroll
    for (int i = 0; i < 2; ++i) { int R, C; stage_rc(tid * 16 + i * 8192, R, C); const int Rb = Epi::PERM ? ((R & ~31) + perm32(R & 31)) : R;
        voffA[i] = (unsigned)(R * K + C) * 2u; voffB[i] = (unsigned)(Rb * K + C) * 2u; }
    const size_t kstep = (size_t)(BK * 2);
    const size_t hstep = (size_t)HALF * K * 2;
    const size_t tstep = 2 * hstep;
    const unsigned ldsw = (unsigned)wid * 1024u;
    const int aoff = lds_byte(wr * 64 + fr, fq * 8), boff = lds_byte(wc * 32 + fr, fq * 8);
#define PG8_SA(b, h) (((b) * 2 + (h)) * HTB)
#define PG8_SB(b, h) ((4 + (b) * 2 + (h)) * HTB)
#define PG8_STAGE(bufoff, gbase, voff) do { _Pragma("unroll") for (int _i = 0; _i < 2; ++_i) \
        __builtin_amdgcn_global_load_lds((const unsigned*)((const char*)(gbase) + (voff)[_i]), (LAS unsigned*)(lds + (bufoff) + ldsw + _i * 8192), 16, 0, 0); } while (0)
#define PG8_LDA(dst, b, h) do { _Pragma("unroll") for (int m = 0; m < 4; ++m) _Pragma("unroll") for (int k = 0; k < 2; ++k) dst[m][k] = *(const LAS bf16x8*)(lds + PG8_SA(b, h) + aoff + m * 2048 + k * 1024); } while (0)
#define PG8_LDB(dst, b, h) do { _Pragma("unroll") for (int n = 0; n < 2; ++n) _Pragma("unroll") for (int k = 0; k < 2; ++k) dst[n][k] = *(const LAS bf16x8*)(lds + PG8_SB(b, h) + boff + n * 2048 + k * 1024); } while (0)
#define PG8_MMA(ai, bj, At, Bt) do { __builtin_amdgcn_s_setprio(1); _Pragma("unroll") for (int m = 0; m < 4; ++m) _Pragma("unroll") for (int n = 0; n < 2; ++n) _Pragma("unroll") for (int k = 0; k < 2; ++k) \
        acc[ai][bj][m][n] = __builtin_amdgcn_mfma_f32_16x16x32_bf16(Bt[n][k], At[m][k], acc[ai][bj][m][n], 0, 0, 0); __builtin_amdgcn_s_setprio(0); } while (0)
#define PG8_WAIT_V(n) asm volatile("s_waitcnt vmcnt(" #n ")" ::: "memory")
#define PG8_WAIT_L(n) asm volatile("s_waitcnt lgkmcnt(" #n ")" ::: "memory")
#define PG8_BAR __builtin_amdgcn_s_barrier()
#define PG8_SCHED __builtin_amdgcn_sched_barrier(0)
    Unit cur, nxt; int ui = 0;
    if (!S.next(0, cur)) return;
    f32x4 acc[2][2][4][2];
#pragma unroll
    for (int a = 0; a < 2; ++a)
#pragma unroll
        for (int b = 0; b < 2; ++b)
#pragma unroll
            for (int m = 0; m < 4; ++m)
#pragma unroll
                for (int n = 0; n < 2; ++n) acc[a][b][m][n] = (f32x4){0.f, 0.f, 0.f, 0.f};
    bf16x8 At[4][2], B0[2][2], B1[2][2];
    const char* cA = (const char*)g.A + (size_t)cur.pm * tstep + (size_t)cur.k0 * 2; const char* cB = (const char*)g.Bt + (size_t)cur.pn * tstep + (size_t)cur.k0 * 2;
    PG8_STAGE(PG8_SB(0, 0), cB, voffB); PG8_STAGE(PG8_SB(0, 1), cB + hstep, voffB); PG8_STAGE(PG8_SA(0, 0), cA, voffA); PG8_STAGE(PG8_SA(0, 1), cA + hstep, voffA);
    if (wr == 1) PG8_BAR;
    PG8_WAIT_V(2); PG8_BAR;
    PG8_STAGE(PG8_SB(1, 0), cB + kstep, voffB); PG8_STAGE(PG8_SA(1, 0), cA + kstep, voffA); PG8_STAGE(PG8_SB(1, 1), cB + hstep + kstep, voffB);
    PG8_WAIT_V(6); PG8_BAR;
    for (;;) {
        const bool has_next = S.next(ui + 1, nxt);
        const char* nA = has_next ? (const char*)g.A + (size_t)nxt.pm * tstep + (size_t)nxt.k0 * 2 : cA; const char* nB = has_next ? (const char*)g.Bt + (size_t)nxt.pn * tstep + (size_t)nxt.k0 * 2 : cB;
        const int nt = cur.nt;
        for (int t = 0; t < nt; t += 2) {
            const bool last = (t == nt - 2);
            const char* a1 = cA + (size_t)(t + 1) * kstep;
            const char* a2 = last ? nA : cA + (size_t)(t + 2) * kstep; const char* b2 = last ? nB : cB + (size_t)(t + 2) * kstep;
            const char* a3 = a2 + kstep; const char* b3 = b2 + kstep;
            PG8_LDB(B0, 0, 0); PG8_LDB(B1, 0, 1); PG8_SCHED; PG8_LDA(At, 0, 0); PG8_STAGE(PG8_SA(1, 1), a1 + hstep, voffA);
            PG8_WAIT_V(8); PG8_WAIT_L(0); PG8_BAR; PG8_MMA(0, 0, At, B0); PG8_MMA(0, 1, At, B1); PG8_BAR; PG8_SCHED;
            PG8_LDA(At, 0, 1); PG8_STAGE(PG8_SB(0, 0), b2, voffB); PG8_STAGE(PG8_SB(0, 1), b2 + hstep, voffB); PG8_STAGE(PG8_SA(0, 0), a2, voffA);
            PG8_WAIT_V(8); PG8_WAIT_L(0); PG8_BAR; PG8_MMA(1, 0, At, B0); PG8_MMA(1, 1, At, B1); PG8_BAR; PG8_SCHED;
            PG8_LDB(B0, 1, 0); PG8_LDB(B1, 1, 1); PG8_SCHED; PG8_LDA(At, 1, 0); PG8_STAGE(PG8_SA(0, 1), a2 + hstep, voffA);
            PG8_WAIT_V(8); PG8_WAIT_L(0); PG8_BAR; PG8_MMA(0, 0, At, B0); PG8_MMA(0, 1, At, B1); PG8_BAR; PG8_SCHED;
            PG8_LDA(At, 1, 1); PG8_STAGE(PG8_SB(1, 0), b3, voffB); PG8_STAGE(PG8_SB(1, 1), b3 + hstep, voffB); PG8_STAGE(PG8_SA(1, 0), a3, voffA);
            PG8_WAIT_V(8); PG8_WAIT_L(0); PG8_BAR; PG8_MMA(1, 0, At, B0); PG8_MMA(1, 1, At, B1); PG8_BAR; PG8_SCHED;
        }
        if constexpr (ALIGN_EPI) { if (wr == 0) PG8_BAR; }
        E(acc, cur, wr, wc, fr, fq);
        if (!has_next) break;
        if (E.zero_after(cur)) {
#pragma unroll
        for (int a = 0; a < 2; ++a)
#pragma unroll
            for (int b = 0; b < 2; ++b)
#pragma unroll
                for (int m = 0; m < 4; ++m)
#pragma unroll
                    for (int n = 0; n < 2; ++n) acc[a][b][m][n] = (f32x4){0.f, 0.f, 0.f, 0.f};
        }
        cur = nxt; cA = nA; cB = nB; ++ui;
        if constexpr (ALIGN_EPI) { if (wr == 1) PG8_BAR; }
    }
    PG8_WAIT_V(0);
    if constexpr (!ALIGN_EPI) { if (wr == 0) PG8_BAR; }
    PG8_BAR;
#undef PG8_SA
#undef PG8_SB
#undef PG8_STAGE
#undef PG8_LDA
#undef PG8_LDB
#undef PG8_MMA
#undef PG8_WAIT_V
#undef PG8_WAIT_L
#undef PG8_BAR
#undef PG8_SCHED
}
}
#define XB_TMO      128
#define XB_XCNT(j)  (256  + 64 * (j))
#define XB_XSUB(j)  (1280 + 64 * (j))
#define XB_XGEN(j)  (2304 + 64 * (j))
#define XB_TOP      3328
#define XB_TOPGEN   3392
#define XCD_BAR_WORDS 3456
#define XB_SPIN_CAP (1u << 18)

__device__ __forceinline__ unsigned xb_ld(unsigned* p)              { return __hip_atomic_load(p, __ATOMIC_RELAXED, __HIP_MEMORY_SCOPE_AGENT); }
__device__ __forceinline__ unsigned xb_add(unsigned* p, unsigned v) { return __hip_atomic_fetch_add(p, v, __ATOMIC_RELAXED, __HIP_MEMORY_SCOPE_AGENT); }
__device__ __forceinline__ unsigned xb_xcc_id() { return (unsigned)__builtin_amdgcn_s_getreg((3 << 11) | 20) & 0xFu; }
#define XB_SPIN(cond, bar) do { unsigned _sp = 0; while (cond) { __builtin_amdgcn_s_sleep(1); \
    if ((++_sp & 255u) == 0u) { if (xb_ld(&(bar)[XB_TMO])) break; if (_sp > XB_SPIN_CAP) { atomicAdd(&(bar)[XB_TMO], 1u); break; } } } } while (0)

struct XcdBarrier {
    unsigned* bar; unsigned x;
    volatile LAS unsigned* st;
};

__device__ __forceinline__ XcdBarrier xcd_barrier_post(unsigned* bar, volatile LAS unsigned* st) {
    XcdBarrier b; b.bar = bar; b.x = xb_xcc_id(); b.st = st;
    if (threadIdx.x == 0) (void)xb_add(&bar[XB_XCNT(b.x)], 1u);
    return b;
}
__device__ __forceinline__ void xcd_barrier_complete(unsigned* bar, unsigned x, unsigned& nloc, unsigned& nx) {
    const unsigned G = gridDim.x * gridDim.y * gridDim.z;
    unsigned sum, cnt, mine, sp = 0u;
    for (;;) {
        sum = 0u; cnt = 0u; mine = 0u;
#pragma unroll
        for (unsigned j = 0; j < 16; ++j) { const unsigned c = xb_ld(&bar[XB_XCNT(j)]); sum += c; cnt += (c > 0u) ? 1u : 0u; mine = (j == x) ? c : mine; }
        if (sum == G) break;
        __builtin_amdgcn_s_sleep(1);
        if ((++sp & 255u) == 0u) { if (xb_ld(&bar[XB_TMO])) break; if (sp > XB_SPIN_CAP) { atomicAdd(&bar[XB_TMO], 1u); break; } }
    }
    nloc = mine > 0u ? mine : 1u; nx = cnt > 0u ? cnt : 1u;
}

__device__ __forceinline__ void xcd_barrier(const XcdBarrier& b) {
    asm volatile("s_waitcnt vmcnt(0)" ::: "memory");
    __syncthreads();
    if (threadIdx.x == 0) {
        unsigned* bar = b.bar;
        __builtin_amdgcn_s_waitcnt(0);
        unsigned nloc = b.st[0], nx = b.st[1];
        if (nloc == 0u) { xcd_barrier_complete(bar, b.x, nloc, nx); b.st[0] = nloc; b.st[1] = nx; }
        const unsigned old = xb_add(&bar[XB_XSUB(b.x)], 1u);
        const unsigned gen = old / nloc;
        if (old + 1u == (gen + 1u) * nloc) {
            __builtin_amdgcn_fence(__ATOMIC_RELEASE, "agent");
            asm volatile("s_waitcnt vmcnt(0)" ::: "memory");
            const unsigned og = xb_add(&bar[XB_TOP], 1u);
            const unsigned tg = og / nx;
            if (og + 1u == (tg + 1u) * nx) xb_add(&bar[XB_TOPGEN], 1u);
            else XB_SPIN(xb_ld(&bar[XB_TOPGEN]) == tg, bar);
            __builtin_amdgcn_fence(__ATOMIC_ACQUIRE, "agent");
            xb_add(&bar[XB_XGEN(b.x)], 1u);
            asm volatile("s_waitcnt vmcnt(0)" ::: "memory");
        } else {
            XB_SPIN(xb_ld(&bar[XB_XGEN(b.x)]) == gen, bar);
            __builtin_amdgcn_fence(__ATOMIC_ACQUIRE, "agent");
            asm volatile("s_waitcnt vmcnt(0)" ::: "memory");
        }
    }
    __syncthreads();
}

using pg8::Unit; using pg8::cvt_pk_bf16;
__device__ __forceinline__ u32x4 pack8(const f32x4 v0, const f32x4 v1) { u32x4 w; w.x = cvt_pk_bf16(v0[0], v0[1]); w.y = cvt_pk_bf16(v0[2], v0[3]); w.z = cvt_pk_bf16(v1[0], v1[1]); w.w = cvt_pk_bf16(v1[2], v1[3]); return w; }

struct EpiIn {
    static constexpr bool PERM = true;
    bf16_t* U; float* DT; const float* CS; float* out;
    __device__ __forceinline__ bool zero_after(const Unit&) const { return true; }
    __device__ __forceinline__ void operator()(f32x4 (&acc)[2][2][4][2], const Unit& u, int wr, int wc, int fr, int fq) const {
        const int pn = u.pn, rbase = u.pm * 256 + wr * 64 + fr, lc0 = wc * 32 + 8 * fq;
        if (pn == 48) {
            if (wc == 0 && fq < 2) {
#pragma unroll
                for (int ai = 0; ai < 2; ++ai)
#pragma unroll
                    for (int m = 0; m < 4; ++m) { float* d = DT + (size_t)(rbase + ai * 128 + m * 16) * 16 + 8 * fq; *(f32x4*)d = acc[ai][0][m][0]; *(f32x4*)(d + 4) = acc[ai][0][m][1]; }
            }
            return;
        }
        int kind = 0, g = 0, half = 0;
        if (pn >= 4 && pn < 12) kind = 1;
        else if (pn >= 12 && pn < 30) { const int t12 = pn - 12; g = t12 / 6; const int j = (t12 - 6 * g) >> 1; half = t12 & 1; kind = 2 + j; }
        const bool rope = (kind == 2 || kind == 3) && ((wc & 1) == 0);
        const int W = g == 0 ? 128 : (g == 1 ? 512 : 2048);
        const size_t opw = g == 0 ? O_PW128 : (g == 1 ? O_PW512 : O_PW2048), osw = g == 0 ? O_SW128 : (g == 1 ? O_SW512 : O_SW2048);
#pragma unroll
        for (int ai = 0; ai < 2; ++ai)
#pragma unroll
            for (int m = 0; m < 4; ++m) {
                const int row = rbase + ai * 128 + m * 16;
                const bool samp = row >= RP;
                const int t = samp ? ((row - RP) & 3) : (row & 4095), b = samp ? ((row - RP) >> 2) : (row >> 12);
                f32x4 c0, c1, s0, s1;
                if (rope) { const float* cs = CS + (size_t)(samp ? 4096 + t : t) * 16; c0 = *(const f32x4*)cs; c1 = *(const f32x4*)(cs + 4); s0 = *(const f32x4*)(cs + 8); s1 = *(const f32x4*)(cs + 12);
                    if (fq == 0) { s0 = -s0; s1 = -s1; } }
#pragma unroll
                for (int bj = 0; bj < 2; ++bj) {
                    f32x4 v0 = acc[ai][bj][m][0], v1 = acc[ai][bj][m][1];
                    if (rope) {
                        f32x4 p0, p1;
#pragma unroll
                        for (int e = 0; e < 4; ++e) { p0[e] = __shfl_xor(v0[e], 16); p1[e] = __shfl_xor(v1[e], 16); }
                        if (fq < 2) { v0 = v0 * c0 + p0 * s0; v1 = v1 * c1 + p1 * s1; }
                    }
                    if (kind == 2) { v0 = v0 * 0.125f; v1 = v1 * 0.125f; }
                    const int lc = bj * 128 + lc0;
                    *(u32x4*)(U + (size_t)row * LDU + pn * 256 + lc) = pack8(v0, v1);
                    if (kind == 1) {
                        const int col = (pn - 4) * 256 + lc;
                        if (samp) { if (t >= 1) { float* d = out + O_SCONV + (size_t)(b * 3 + t - 1) * 2048 + col; *(f32x4*)d = v0; *(f32x4*)(d + 4) = v1; } }
                        else if (t >= 4093) { float* d = out + O_PCONV + (size_t)(b * 3 + t - 4093) * 2048 + col; *(f32x4*)d = v0; *(f32x4*)(d + 4) = v1; }
                    } else if (kind >= 3) {
                        const int hd = half * 256 + lc, kv = kind - 3;
                        if (samp) { float* d = out + osw + ((size_t)(row - RP) * 2 + kv) * 512 + hd; *(f32x4*)d = v0; *(f32x4*)(d + 4) = v1; }
                        else if (t >= 4096 - W) { float* d = out + opw + ((size_t)(b * W + t - (4096 - W)) * 2 + kv) * 512 + hd; *(f32x4*)d = v0; *(f32x4*)(d + 4) = v1; }
                    }
                }
            }
    }
};

struct EpiMem {
    static constexpr bool PERM = true;
    bf16_t* MKV; float* out;
    __device__ __forceinline__ bool zero_after(const Unit&) const { return true; }
    __device__ __forceinline__ void operator()(f32x4 (&acc)[2][2][4][2], const Unit& u, int wr, int wc, int fr, int fq) const {
        const int rbase = u.pm * 256 + wr * 64 + fr, c0 = u.pn * 256 + wc * 32 + 8 * fq;
#pragma unroll
        for (int ai = 0; ai < 2; ++ai)
#pragma unroll
            for (int m = 0; m < 4; ++m) { const int row = rbase + ai * 128 + m * 16;
#pragma unroll
                for (int bj = 0; bj < 2; ++bj) { const f32x4 v0 = acc[ai][bj][m][0], v1 = acc[ai][bj][m][1]; const size_t o = (size_t)row * 1024 + c0 + bj * 128;
                    *(u32x4*)(MKV + o) = pack8(v0, v1); float* d = out + O_PMEM + o; *(f32x4*)d = v0; *(f32x4*)(d + 4) = v1; } }
    }
};

struct EpiBr {
    static constexpr bool PERM = true;
    const bf16_t* U; const float* SSQ; bf16_t* MERGED;
    __device__ __forceinline__ bool zero_after(const Unit& u) const { return u.kind == 2; }
    __device__ __forceinline__ void operator()(f32x4 (&acc)[2][2][4][2], const Unit& u, int wr, int wc, int fr, int fq) const {
        const int rbase = u.pm * 256 + wr * 64 + fr, c0 = u.pn * 256 + wc * 32 + 8 * fq, kind = u.kind;
#pragma unroll
        for (int ai = 0; ai < 2; ++ai)
#pragma unroll
            for (int m = 0; m < 4; ++m) { const int row = rbase + ai * 128 + m * 16;
                float rs = 1.0f;
                if (kind == 0) { const f32x4* q = (const f32x4*)(SSQ + (size_t)row * 16); const f32x4 a = q[0], b = q[1], c = q[2], d = q[3];
                    const float s = ((a[0] + a[1]) + (a[2] + a[3])) + ((b[0] + b[1]) + (b[2] + b[3])) + ((c[0] + c[1]) + (c[2] + c[3])) + ((d[0] + d[1]) + (d[2] + d[3]));
                    rs = 1.0f / sqrtf(s * (1.0f / 1024.0f) + EPS); }
#pragma unroll
                for (int bj = 0; bj < 2; ++bj) {
                    const bf16_t* gp = U + (size_t)row * LDU + U_GATE + c0 + bj * 128;
                    const u32x4 ga = *(const u32x4*)(gp + (kind == 0 ? 0 : (kind == 1 ? 1024 : 2048)));
                    const u32x4 gb = *(const u32x4*)(gp + (kind == 0 ? 1024 : 2048));
                    float f[8];
#pragma unroll
                    for (int e = 0; e < 4; ++e) {
                        const float a_lo = fminf(fmaxf(__uint_as_float(ga[e] << 16), -60.f), 60.f), a_hi = fminf(fmaxf(__uint_as_float(ga[e] & 0xffff0000u), -60.f), 60.f);
                        const float b_lo = fminf(fmaxf(__uint_as_float(gb[e] << 16), -60.f), 60.f), b_hi = fminf(fmaxf(__uint_as_float(gb[e] & 0xffff0000u), -60.f), 60.f);
                        const float da_lo = 1.0f + __expf(-a_lo), da_hi = 1.0f + __expf(-a_hi);
                        if (kind == 2) { f[2 * e] = 1.0f / da_lo; f[2 * e + 1] = 1.0f / da_hi; }
                        else { f[2 * e] = rs * (1.0f + __expf(-b_lo)) / da_lo; f[2 * e + 1] = rs * (1.0f + __expf(-b_hi)) / da_hi; }
                    }
                    f32x4 v0 = acc[ai][bj][m][0], v1 = acc[ai][bj][m][1];
                    v0 = v0 * (f32x4){f[0], f[1], f[2], f[3]}; v1 = v1 * (f32x4){f[4], f[5], f[6], f[7]};
                    acc[ai][bj][m][0] = v0; acc[ai][bj][m][1] = v1;
                    if (kind == 2) *(u32x4*)(MERGED + (size_t)row * 1024 + c0 + bj * 128) = pack8(v0, v1);
                }
            }
    }
};

struct EpiOut {
    static constexpr bool PERM = false;
    const float* xp; const float* xs; float* out; float* RSQ;
    __device__ __forceinline__ bool zero_after(const Unit&) const { return true; }
    __device__ __forceinline__ void operator()(f32x4 (&acc)[2][2][4][2], const Unit& u, int wr, int wc, int fr, int fq) const {
        const int rbase = u.pm * 256 + wr * 64 + fr, c0 = u.pn * 256 + wc * 32 + 4 * fq;
#pragma unroll
        for (int ai = 0; ai < 2; ++ai)
#pragma unroll
            for (int m = 0; m < 4; ++m) { const int row = rbase + ai * 128 + m * 16;
                const float* xr = (row < RP ? xp + (size_t)row * 1024 : xs + (size_t)(row - RP) * 1024) + c0; float* orow = out + (size_t)row * 1024 + c0;
                float s = 0.f;
#pragma unroll
                for (int bj = 0; bj < 2; ++bj)
#pragma unroll
                    for (int n = 0; n < 2; ++n) { const f32x4 r = *(const f32x4*)(xr + bj * 128 + n * 16) + acc[ai][bj][m][n]; *(f32x4*)(orow + bj * 128 + n * 16) = r;
                        s += (r[0] * r[0] + r[1] * r[1]) + (r[2] * r[2] + r[3] * r[3]); }
                s += __shfl_xor(s, 16); s += __shfl_xor(s, 32);
                if (fq == 0) RSQ[(size_t)row * 16 + u.pn * 4 + wc] = s;
            }
    }
};
struct Frame {
    LAS unsigned char* lds;
    unsigned* ctl;
    int tid, lane, wave, G, vcu;
    const float *xp, *xs, *memp, *cw128, *cw512, *cw2048, *cmem, *sconv, *sssm, *norm_in_w, *w_in, *conv_w, *conv_b, *dt_bias, *a_log, *d_skip, *ssd_norm_w, *mem_norm_w, *w_mem_kv, *w_br_ssd, *w_br_att, *w_br_mem, *w_out, *norm_f_w;
    float* out;
    bf16_t *WinT, *WmemT, *WbrT, *WoutT, *XB, *MB, *U, *MKV, *ACAT, *MERGED;
    float *CS, *DT, *SSQ, *RSQ;
};

template <int MODE>
__device__ __forceinline__ void transpose_item(const float* W, int N, const float* ksc, bf16_t* WT, int ldk, int koff, int kb, int nb, LAS float* scr, int lane) {
    const int k0 = 64 * kb, n0 = 32 * nb;
    int nsrc = n0 + (lane & 31);
    if (MODE == 1) nsrc = nsrc < 3072 ? nsrc : (nsrc < 12288 ? nsrc + 16 : (nsrc < 12304 ? 3072 + nsrc - 12288 : -1));
#pragma unroll 8
    for (int i = 0; i < 32; ++i) { const int kk = 2 * i + (lane >> 5); float v = 0.f; if (nsrc >= 0) v = W[(size_t)(k0 + kk) * N + nsrc]; if (ksc) v *= ksc[k0 + kk]; scr[kk * 33 + (lane & 31)] = v; }
    LDS_WAIT(); asm volatile("" ::: "memory");
    const int c = lane & 7;
#pragma unroll
    for (int j = 0; j < 4; ++j) { const int n = (lane >> 3) + 8 * j; const LAS float* s = scr + (8 * c) * 33 + n;
        u32x4 o; o.x = pk2(s[0 * 33], s[1 * 33]); o.y = pk2(s[2 * 33], s[3 * 33]); o.z = pk2(s[4 * 33], s[5 * 33]); o.w = pk2(s[6 * 33], s[7 * 33]);
        *(u32x4*)(WT + (size_t)(n0 + n) * ldk + koff + k0 + 8 * c) = o; }
    LDS_WAIT(); asm volatile("" ::: "memory");
}
__device__ __forceinline__ void rms_row_to_bf16(const float* xrow, bf16_t* orow, int lane) {
    const f32x4* xr = (const f32x4*)xrow + lane;
    f32x4 v[4]; float s = 0.f;
#pragma unroll
    for (int j = 0; j < 4; ++j) { v[j] = xr[64 * j]; s += (v[j][0] * v[j][0] + v[j][1] * v[j][1]) + (v[j][2] * v[j][2] + v[j][3] * v[j][3]); }
    const float rstd = 1.0f / sqrtf(wave_sum(s) * (1.0f / 1024.0f) + EPS);
    u32x2* o8 = (u32x2*)orow + lane;
#pragma unroll
    for (int j = 0; j < 4; ++j) { u32x2 w; w.x = pk2(v[j][0] * rstd, v[j][1] * rstd); w.y = pk2(v[j][2] * rstd, v[j][3] * rstd); o8[64 * j] = w; }
}
__device__ __forceinline__ void sincos_d(float angf, float& sn, float& cs) {
    const double a = (double)angf; const double k = rint(a * 0.15915494309189533577);
    double r = a - k * 6.283185307179586232; r -= k * 2.4492935982947064e-16;
    const double r2 = r * r; double ts = r, tc = 1.0, ss = r, sc = 1.0;
#pragma unroll 1
    for (int i = 1; i <= 14; ++i) { tc = -tc * r2 / (double)((2 * i - 1) * (2 * i)); ts = -ts * r2 / (double)((2 * i) * (2 * i + 1)); sc += tc; ss += ts; }
    sn = (float)ss; cs = (float)sc;
}
__device__ __forceinline__ void p0_prologue(Frame& F) {
    LAS float* scr = (LAS float*)(F.lds + F.wave * 16384);
    const int gw = F.vcu * NWAVES + F.wave, NGW = F.G * NWAVES, lane = F.lane;
    constexpr int I_IN = 16 * (NINP / 32), I_MEM = 16 * 32, I_B1 = 16 * 32, I_B2 = 8 * 32, I_B3 = 8 * 32, I_OUT = 16 * 32;
    constexpr int NITEMS = I_IN + I_MEM + I_B1 + I_B2 + I_B3 + I_OUT;
#ifndef P0_MASK
#define P0_MASK 7
#endif
    if (P0_MASK & 1)
    for (int it = gw; it < NITEMS; it += NGW) {
        int r = it;
        if (r < I_IN) { transpose_item<1>(F.w_in, 12304, F.norm_in_w, F.WinT, 1024, 0, r / (NINP / 32), r % (NINP / 32), scr, lane); continue; } r -= I_IN;
        if (r < I_MEM) { transpose_item<0>(F.w_mem_kv, 1024, F.mem_norm_w, F.WmemT, 1024, 0, r / 32, r % 32, scr, lane); continue; } r -= I_MEM;
        if (r < I_B1) { transpose_item<0>(F.w_br_ssd, 1024, F.ssd_norm_w, F.WbrT, 2048, 0, r / 32, r % 32, scr, lane); continue; } r -= I_B1;
        if (r < I_B2) { transpose_item<0>(F.w_br_att, 1024, nullptr, F.WbrT, 2048, 1024, r / 32, r % 32, scr, lane); continue; } r -= I_B2;
        if (r < I_B3) { transpose_item<0>(F.w_br_mem, 1024, nullptr, F.WbrT, 2048, 1536, r / 32, r % 32, scr, lane); continue; } r -= I_B3;
        transpose_item<0>(F.w_out, 1024, nullptr, F.WoutT, 1024, 0, r / 32, r % 32, scr, lane);
    }
    if (P0_MASK & 2)
    for (int m = gw; m < RT + 2048; m += NGW) {
        if (m < RP) rms_row_to_bf16(F.xp + (size_t)m * 1024, F.XB + (size_t)m * 1024, lane);
        else if (m < RT) rms_row_to_bf16(F.xs + (size_t)(m - RP) * 1024, F.XB + (size_t)m * 1024, lane);
        else rms_row_to_bf16(F.memp + (size_t)(m - RT) * 1024, F.MB + (size_t)(m - RT) * 1024, lane);
    }
    if (P0_MASK & 4)
    for (int idx = (F.vcu * NTHREADS + F.tid); idx < 4100 * 8; idx += F.G * NTHREADS) {
        const int pi = idx >> 3, i = idx & 7; const int pos = pi < 4096 ? pi : 8192 + (pi - 4096);
        const float inv = i == 0 ? 1.0f : i == 1 ? 0.1939227432012558f : i == 2 ? 0.03760603070259094f : i == 3 ? 0.007292664609849453f : i == 4 ? 0.0014142135623842478f : i == 5 ? 0.00027424818836152554f : i == 6 ? 5.318296098266728e-05f : 1.0313386155758053e-05f;
        const float ang = (float)pos * inv; float sn, cs; sincos_d(ang, sn, cs);
        F.CS[(size_t)pi * 16 + i] = cs; F.CS[(size_t)pi * 16 + 8 + i] = sn;
    }
}

__device__ __forceinline__ float dot64_bf16(const bf16_t* kp, const LAS float* q) {
    float s = 0.f;
#pragma unroll
    for (int c = 0; c < 8; ++c) { const u32x4 w = *(const u32x4*)(kp + 8 * c); const f32x4 q0 = *(const LAS f32x4*)(q + 8 * c), q1 = *(const LAS f32x4*)(q + 8 * c + 4);
        s += __uint_as_float(w.x << 16) * q0[0] + __uint_as_float(w.x & 0xffff0000u) * q0[1] + __uint_as_float(w.y << 16) * q0[2] + __uint_as_float(w.y & 0xffff0000u) * q0[3]
           + __uint_as_float(w.z << 16) * q1[0] + __uint_as_float(w.z & 0xffff0000u) * q1[1] + __uint_as_float(w.w << 16) * q1[2] + __uint_as_float(w.w & 0xffff0000u) * q1[3]; }
    return s;
}
__device__ __forceinline__ float dot64_f32(const float* kp, const LAS float* q) {
    float s = 0.f;
#pragma unroll
    for (int c = 0; c < 16; ++c) { const f32x4 w = *(const f32x4*)(kp + 4 * c); const f32x4 q0 = *(const LAS f32x4*)(q + 4 * c); s += w[0] * q0[0] + w[1] * q0[1] + w[2] * q0[2] + w[3] * q0[3]; }
    return s;
}
__device__ __forceinline__ void att_naive_unit(Frame& F, int row, int head, LAS float* qs) {
    const int lane = F.lane; const bool samp = row >= RP;
    const int t = samp ? ((row - RP) & 3) : (row & 4095), b = samp ? ((row - RP) >> 2) : (row >> 12);
    LAS float* sb = qs + 128;
    float mrun = -1e30f, lrun = 0.f, o = 0.f;
#pragma unroll
    for (int g = 0; g < 3; ++g) {
        const int dil = g == 0 ? 1 : (g == 1 ? 4 : 16), W = 128 * dil;
        const float* cache = g == 0 ? F.cw128 : (g == 1 ? F.cw512 : F.cw2048);
        const int qoff = U_QKV + g * 1536 + head * 64;
        LDS_WAIT(); asm volatile("" ::: "memory");
        qs[lane] = bf2f(F.U[(size_t)row * LDU + qoff + lane]);
        LDS_WAIT(); asm volatile("" ::: "memory");
        float lm = -1e30f;
#pragma unroll 1
        for (int p = 0; p < 3; ++p) {
            const int j = p * 64 + lane; float s = -1e30f;
            if (j <= 128) {
                if (!samp) { const int tk = t - j * dil; if (tk >= 0) s = dot64_bf16(F.U + (size_t)(b * 4096 + tk) * LDU + qoff + 512, qs); }
                else { const int idx = W + t - dil * j;
                    if (idx >= W) s = dot64_bf16(F.U + (size_t)(RP + b * 4 + (idx - W)) * LDU + qoff + 512, qs);
                    else s = dot64_f32(cache + ((size_t)(b * W + idx) * 2 + 0) * 512 + head * 64, qs); }
            }
            sb[j] = s; lm = fmaxf(lm, s);
        }
        const float gm = wave_max(lm);
        const float mnew = fmaxf(mrun, gm), fsc = __expf(mrun - mnew);
        float ps = 0.f;
#pragma unroll 1
        for (int p = 0; p < 3; ++p) { const float s = sb[p * 64 + lane]; const float pr = s > -1e29f ? __expf(s - mnew) : 0.f; sb[p * 64 + lane] = pr; ps += pr; }
        lrun = lrun * fsc + wave_sum(ps); o *= fsc; mrun = mnew;
        LDS_WAIT(); asm volatile("" ::: "memory");
#pragma unroll 2
        for (int j = 0; j <= 128; ++j) {
            const float pj = sb[j];
            if (!samp) { const int tk = t - j * dil; if (tk >= 0) o += pj * bf2f(F.U[(size_t)(b * 4096 + tk) * LDU + qoff + 1024 + lane]); }
            else { const int idx = W + t - dil * j;
                if (idx >= W) o += pj * bf2f(F.U[(size_t)(RP + b * 4 + (idx - W)) * LDU + qoff + 1024 + lane]);
                else o += pj * cache[((size_t)(b * W + idx) * 2 + 1) * 512 + head * 64 + lane]; }
        }
    }
    const float z = bf2f(F.U[(size_t)row * LDU + U_ZA + head * 64 + lane]);
    F.ACAT[(size_t)row * LDA + 1024 + head * 64 + lane] = (bf16_t)f2bf(o / lrun * silu_f(z));
}
__device__ __forceinline__ void mem_naive_unit(Frame& F, int row, int head, LAS float* qs) {
    const int lane = F.lane; const bool samp = row >= RP; const int b = samp ? ((row - RP) >> 2) : (row >> 12);
    LAS float* sb = qs + 128;
    LDS_WAIT(); asm volatile("" ::: "memory");
    qs[lane] = bf2f(F.U[(size_t)row * LDU + U_QM + head * 128 + lane]) * 0.08838834764831845f;
    qs[lane + 64] = bf2f(F.U[(size_t)row * LDU + U_QM + head * 128 + 64 + lane]) * 0.08838834764831845f;
    LDS_WAIT(); asm volatile("" ::: "memory");
    float lm = -1e30f;
#pragma unroll 1
    for (int p = 0; p < 4; ++p) { const int m = p * 64 + lane; float s;
        if (!samp) { const bf16_t* kp = F.MKV + (size_t)(b * 256 + m) * 1024 + head * 128; s = dot64_bf16(kp, qs) + dot64_bf16(kp + 64, qs + 64); }
        else { const float* kp = F.cmem + ((size_t)(b * 256 + m) * 2 + 0) * 512 + head * 128; s = dot64_f32(kp, qs) + dot64_f32(kp + 64, qs + 64); }
        sb[m] = s; lm = fmaxf(lm, s); }
    const float gm = wave_max(lm);
    float ps = 0.f;
#pragma unroll 1
    for (int p = 0; p < 4; ++p) { const float pr = __expf(sb[p * 64 + lane] - gm); sb[p * 64 + lane] = pr; ps += pr; }
    const float l = wave_sum(ps);
    LDS_WAIT(); asm volatile("" ::: "memory");
    float o0 = 0.f, o1 = 0.f;
#pragma unroll 2
    for (int m = 0; m < 256; ++m) { const float pj = sb[m];
        if (!samp) { const bf16_t* vp = F.MKV + (size_t)(b * 256 + m) * 1024 + 512 + head * 128; o0 += pj * bf2f(vp[lane]); o1 += pj * bf2f(vp[lane + 64]); }
        else { const float* vp = F.cmem + ((size_t)(b * 256 + m) * 2 + 1) * 512 + head * 128; o0 += pj * vp[lane]; o1 += pj * vp[lane + 64]; } }
    const float z0 = bf2f(F.U[(size_t)row * LDU + U_ZM + head * 128 + lane]), z1 = bf2f(F.U[(size_t)row * LDU + U_ZM + head * 128 + 64 + lane]);
    F.ACAT[(size_t)row * LDA + 1536 + head * 128 + lane] = (bf16_t)f2bf(o0 / l * silu_f(z0));
    F.ACAT[(size_t)row * LDA + 1536 + head * 128 + 64 + lane] = (bf16_t)f2bf(o1 / l * silu_f(z1));
}
__device__ __forceinline__ void ssd_naive_unit(Frame& F, bool samp, int b, int h) {
    const int tid = F.tid, lane = F.lane, wave = F.wave;
    const int T = samp ? 4 : 4096, row0 = samp ? RP + b * 4 : b * 4096, g = h >> 2;
    constexpr int CH = 64;
    LAS float* xc = (LAS float*)F.lds;
    LAS float* dtv = xc + CH * 320;
    LAS float* ybuf = dtv + CH;
    const int p = tid >> 3, nq = tid & 7;
    float st[16];
    float* sout = F.out + (samp ? O_SSSM : O_PSSM) + ((size_t)(b * 16 + h) * 64 + p) * 128 + nq * 16;
    if (samp) { const float* sp = F.sssm + ((size_t)(b * 16 + h) * 64 + p) * 128 + nq * 16;
#pragma unroll
        for (int i = 0; i < 4; ++i) { const f32x4 v = *(const f32x4*)(sp + 4 * i); st[4 * i] = v[0]; st[4 * i + 1] = v[1]; st[4 * i + 2] = v[2]; st[4 * i + 3] = v[3]; } }
    else {
#pragma unroll
        for (int i = 0; i < 16; ++i) st[i] = 0.f; }
    const float a = -__expf(F.a_log[h]), dsk = F.d_skip[h], dtb = F.dt_bias[h];
#pragma unroll 1
    for (int t0 = 0; t0 < T; t0 += CH) {
        const int nst = (T - t0) < CH ? (T - t0) : CH;
        for (int idx = tid; idx < nst * 320; idx += NTHREADS) {
            const int s = idx / 320, c = idx - s * 320;
            const int ch = c < 64 ? h * 64 + c : (c < 192 ? 1024 + g * 128 + (c - 64) : 1536 + g * 128 + (c - 192));
            float accv = F.conv_b[ch];
#pragma unroll
            for (int kk = 0; kk < 4; ++kk) { const int tt = t0 + s - 3 + kk; float xv = 0.f;
                if (tt >= 0) xv = bf2f(F.U[(size_t)(row0 + tt) * LDU + U_XBC + ch]); else if (samp) xv = F.sconv[(size_t)(b * 3 + tt + 3) * 2048 + ch];
                accv += xv * F.conv_w[kk * 2048 + ch]; }
            xc[s * 320 + c] = silu_f(accv);
        }
        if (tid < nst) { const float x = F.DT[(size_t)(row0 + t0 + tid) * 16 + h] + dtb; dtv[tid] = x > 20.f ? x : log1pf(__expf(x)); }
        __syncthreads();
#pragma unroll 1
        for (int s = 0; s < nst; ++s) {
            const float dt = dtv[s], dA = __expf(dt * a), xv = xc[s * 320 + p], dtx = dt * xv;
            const LAS f32x4* Bp = (const LAS f32x4*)(xc + s * 320 + 64 + nq * 16); const LAS f32x4* Cp = (const LAS f32x4*)(xc + s * 320 + 192 + nq * 16);
            float y = 0.f;
#pragma unroll
            for (int i = 0; i < 4; ++i) { const f32x4 bv = Bp[i], cv = Cp[i];
#pragma unroll
                for (int e = 0; e < 4; ++e) { st[4 * i + e] = st[4 * i + e] * dA + dtx * bv[e]; y += cv[e] * st[4 * i + e]; } }
            y += __shfl_xor(y, 1); y += __shfl_xor(y, 2); y += __shfl_xor(y, 4);
            if (nq == 0) ybuf[s * 64 + p] = y + dsk * xv;
        }
        __syncthreads();
        for (int s = wave; s < nst; s += NWAVES) {
            const int row = row0 + t0 + s;
            const float z = bf2f(F.U[(size_t)row * LDU + U_Z + h * 64 + lane]);
            const float v = ybuf[s * 64 + lane] * silu_f(z);
            F.ACAT[(size_t)row * LDA + h * 64 + lane] = (bf16_t)f2bf(v);
            const float q = wave_sum(v * v);
            if (lane == 0) F.SSQ[(size_t)row * 16 + h] = q;
        }
        __syncthreads();
    }
#pragma unroll
    for (int i = 0; i < 4; ++i) *(f32x4*)(sout + 4 * i) = (f32x4){st[4 * i], st[4 * i + 1], st[4 * i + 2], st[4 * i + 3]};
}
__device__ __forceinline__ void p2_mixers(Frame& F) {
    constexpr int N_SSDP = 128, N_SSDS = 2048, N_ATT = RT / 8, N_MEM = RT / 8, N_ITEMS = N_SSDP + N_SSDS + N_ATT + N_MEM;
    volatile LAS int* slot = (volatile LAS int*)(F.lds + MISC_OFF + 64);
    LAS float* qs = (LAS float*)(F.lds + 112 * 1024 + F.wave * 2048);
    for (;;) {
        __syncthreads();
        if (F.tid == 0) *slot = (int)__hip_atomic_fetch_add(F.ctl + CW_Q, 1u, RLX_AGENT);
        __syncthreads();
        int it = *slot;
        if (it >= N_ITEMS) break;
        Frame Fi = F; asm volatile("" : "+v"(Fi.lane), "+v"(Fi.tid));
        LAS float* qsi = qs; asm volatile("" : "+v"(qsi));
        if (it < N_SSDP) { ssd_naive_unit(Fi, false, it >> 4, it & 15); continue; } it -= N_SSDP;
        if (it < N_SSDS) { ssd_naive_unit(Fi, true, it >> 4, it & 15); continue; } it -= N_SSDS;
        if (it < N_ATT) { for (int r = 0; r < 8; ++r) att_naive_unit(Fi, it * 8 + r, Fi.wave, qsi); continue; } it -= N_ATT;
        for (int r = 0; r < 4; ++r) mem_naive_unit(Fi, it * 8 + 2 * r + (Fi.wave >> 2), Fi.wave & 3, qsi);
    }
}
__device__ __forceinline__ void p5_final_norm(Frame& F) {
    const int gw = F.vcu * NWAVES + F.wave, NGW = F.G * NWAVES, lane = F.lane;
    f32x4 w[4];
#pragma unroll
    for (int j = 0; j < 4; ++j) w[j] = ((const f32x4*)F.norm_f_w)[lane + 64 * j];
    for (int m = gw; m < RT; m += NGW) {
        const f32x4* q = (const f32x4*)(F.RSQ + (size_t)m * 16); const f32x4 a = q[0], b = q[1], c = q[2], d = q[3];
        const float s = ((a[0] + a[1]) + (a[2] + a[3])) + ((b[0] + b[1]) + (b[2] + b[3])) + ((c[0] + c[1]) + (c[2] + c[3])) + ((d[0] + d[1]) + (d[2] + d[3]));
        const float rstd = 1.0f / sqrtf(s * (1.0f / 1024.0f) + EPS);
        f32x4* o = (f32x4*)(F.out + (size_t)m * 1024) + lane;
#pragma unroll
        for (int j = 0; j < 4; ++j) o[64 * j] = o[64 * j] * rstd * w[j];
    }
}
struct Args { const float* in[24]; float* out; unsigned char* ws; int ph_lo, ph_hi; };
__global__ void __launch_bounds__(NTHREADS, 2) fwd_kernel(Args args) {
    extern __shared__ __attribute__((aligned(16))) unsigned char lds[];
#define FRAME() Frame F; \
    F.lds = (LAS unsigned char*)lds; F.tid = threadIdx.x; F.lane = F.tid & 63; F.wave = __builtin_amdgcn_readfirstlane(F.tid >> 6); \
    F.G = gridDim.x; { const int bx = blockIdx.x; F.vcu = (F.G % 8 == 0) ? (bx % 8) * (F.G / 8) + bx / 8 : bx; } \
    unsigned char* ws = args.ws; F.ctl = (unsigned*)(ws + WS_CTL); \
    F.xp = args.in[0]; F.xs = args.in[1]; F.memp = args.in[2]; F.cw128 = args.in[3]; F.cw512 = args.in[4]; F.cw2048 = args.in[5]; F.cmem = args.in[6]; F.sconv = args.in[7]; F.sssm = args.in[8]; \
    F.norm_in_w = args.in[9]; F.w_in = args.in[10]; F.conv_w = args.in[11]; F.conv_b = args.in[12]; F.dt_bias = args.in[13]; F.a_log = args.in[14]; F.d_skip = args.in[15]; F.ssd_norm_w = args.in[16]; \
    F.mem_norm_w = args.in[17]; F.w_mem_kv = args.in[18]; F.w_br_ssd = args.in[19]; F.w_br_att = args.in[20]; F.w_br_mem = args.in[21]; F.w_out = args.in[22]; F.norm_f_w = args.in[23]; \
    F.out = args.out; \
    F.WinT = (bf16_t*)(ws + WS_WIN); F.WmemT = (bf16_t*)(ws + WS_WMEM); F.WbrT = (bf16_t*)(ws + WS_WBR); F.WoutT = (bf16_t*)(ws + WS_WOUT); \
    F.XB = (bf16_t*)(ws + WS_XB); F.MB = (bf16_t*)(ws + WS_MB); F.U = (bf16_t*)(ws + WS_U); F.MKV = (bf16_t*)(ws + WS_MKV); F.ACAT = (bf16_t*)(ws + WS_ACAT); F.MERGED = (bf16_t*)(ws + WS_MERGED); \
    F.CS = (float*)(ws + WS_CS); F.DT = (float*)(ws + WS_DT); F.SSQ = (float*)(ws + WS_SSQ); F.RSQ = (float*)(ws + WS_RSQ)
    const int tid0 = threadIdx.x;
    for (int u = tid0; u < (LDS_BYTES - LDSCTL_OFF) / 4; u += NTHREADS) ((LAS unsigned*)((LAS unsigned char*)lds + LDSCTL_OFF))[u] = 0u;
    __syncthreads();
    const int lo = args.ph_lo, hi = args.ph_hi;
#if MK_ONE_LAUNCH
    XcdBarrier bar = xcd_barrier_post((unsigned*)(args.ws + WS_CTL) + CW_BAR, (volatile LAS unsigned*)((LAS unsigned char*)lds + MISC_OFF) + 8);
#define GRID_BAR() xcd_barrier(bar)
#else
#define GRID_BAR() do { } while (0)
#endif
#ifndef PH_MASK
#define PH_MASK 63
#endif
#define IN(k) (((PH_MASK >> (k)) & 1) && lo <= (k) && (k) < hi)
#define BOTH(k) (IN(k) && IN((k) + 1))

    if (IN(0)) { { FRAME(); p0_prologue(F); } if (BOTH(0)) GRID_BAR(); }

    if (IN(1)) {
        { FRAME();
        { pg8::Gemm g{F.XB, F.WinT, 1024}; pg8::TileOrder S; S.init(RT / 256, NINP / 256, F.G, (int)blockIdx.x, 1, 16);
          EpiIn E{F.U, F.DT, F.CS, F.out};
          pg8::gemm_phase<EpiIn, pg8::TileOrder, true>(F.lds, g, S, E); }
        { pg8::Gemm g{F.MB, F.WmemT, 1024}; pg8::TileOrder S; S.init(8, 4, F.G, (int)blockIdx.x, 1, 16);
          EpiMem E{F.MKV, F.out};
          pg8::gemm_phase<EpiMem, pg8::TileOrder, true>(F.lds, g, S, E); } }
        if (BOTH(1)) GRID_BAR();
    }

    if (IN(2)) { { FRAME(); p2_mixers(F); } if (BOTH(2)) GRID_BAR(); }

    if (IN(3)) {
        { FRAME();
        pg8::Gemm g{F.ACAT, F.WbrT, 2048}; pg8::TileOrder S; S.init(RT / 256, 4, F.G, (int)blockIdx.x, 3, 0);
        EpiBr E{F.U, F.SSQ, F.MERGED};
        pg8::gemm_phase<EpiBr, pg8::TileOrder, true>(F.lds, g, S, E); }
        if (BOTH(3)) GRID_BAR();
    }

    if (IN(4)) {
        { FRAME();
        pg8::Gemm g{F.MERGED, F.WoutT, 1024}; pg8::TileOrder S; S.init(RT / 256, 4, F.G, (int)blockIdx.x, 1, 16);
        EpiOut E{F.xp, F.xs, F.out, F.RSQ};
        pg8::gemm_phase<EpiOut, pg8::TileOrder, true>(F.lds, g, S, E); }
        if (BOTH(4)) GRID_BAR();
    }

    if (IN(5)) { FRAME(); p5_final_norm(F); }
#undef IN
#undef BOTH
}

extern "C" void kernel_launch(void* const* d_in, const int* in_sizes, int n_in, void* d_out, int out_size, void* d_ws, size_t ws_size, hipStream_t stream) {
    static int grid = 0;
    if (grid == 0) {
        if (n_in != 24 || (size_t)out_size != O_TOTAL || ws_size < WS_END) { fprintf(stderr, "kernel_launch: unexpected problem shape (n_in %d, out %d, ws %zu, need %zu); nothing launched\n", n_in, out_size, ws_size, (size_t)WS_END); grid = -1; return; }
        int dev = 0, cus = 0, per_cu = 0;
        if (hipGetDevice(&dev) != hipSuccess || hipDeviceGetAttribute(&cus, hipDeviceAttributeMultiprocessorCount, dev) != hipSuccess) { grid = -1; return; }
        if (hipFuncSetAttribute((const void*)fwd_kernel, hipFuncAttributeMaxDynamicSharedMemorySize, LDS_BYTES) != hipSuccess) { fprintf(stderr, "kernel_launch: hipFuncSetAttribute failed\n"); grid = -1; return; }
        if (hipOccupancyMaxActiveBlocksPerMultiprocessor(&per_cu, (const void*)fwd_kernel, NTHREADS, LDS_BYTES) != hipSuccess || per_cu < 1)
            fprintf(stderr, "kernel_launch: note: occupancy query reports %d workgroups per CU\n", per_cu);
        (void)hipGetLastError();
        grid = cus;
    }
    if (grid < 0) return;
    if (hipMemsetAsync((char*)d_ws + WS_CTL, 0, CTL_ZERO_BYTES, stream) != hipSuccess) { fprintf(stderr, "kernel_launch: memset failed\n"); return; }
    Args a{};
    {
        static const int dict_sizes[24] = {33554432, 524288, 2097152, 16777216, 67108864, 268435456, 33554432, 786432, 16777216, 1024, 12599296, 8192, 2048, 16, 16, 16, 1024, 1024, 1048576, 1048576, 524288, 524288, 1048576, 1024};
        static const int sorted_to_dict[24] = {14, 6, 3, 5, 4, 12, 11, 15, 13, 17, 2, 23, 9, 16, 7, 8, 20, 21, 19, 10, 18, 22, 0, 1};
        bool is_dict = true, is_sorted = true;
        for (int i = 0; i < 24; ++i) { if (in_sizes[i] != dict_sizes[i]) is_dict = false; if (in_sizes[i] != dict_sizes[sorted_to_dict[i]]) is_sorted = false; }
        if (is_dict) { for (int i = 0; i < 24; ++i) a.in[i] = (const float*)d_in[i]; }
        else if (is_sorted) { for (int i = 0; i < 24; ++i) a.in[sorted_to_dict[i]] = (const float*)d_in[i]; }
        else { fprintf(stderr, "kernel_launch: input sizes match neither the dict order nor the sorted-key order; nothing launched\n"); return; }
    }
    a.out = (float*)d_out; a.ws = (unsigned char*)d_ws;
#if MK_ONE_LAUNCH
    a.ph_lo = 0; a.ph_hi = 6;
    hipLaunchKernelGGL(fwd_kernel, dim3(grid), dim3(NTHREADS), LDS_BYTES, stream, a);
#else
    for (int ph = 0; ph < 6; ++ph) { a.ph_lo = ph; a.ph_hi = ph + 1; hipLaunchKernelGGL(fwd_kernel, dim3(grid), dim3(NTHREADS), LDS_BYTES, stream, a); }
#endif
    const hipError_t le = hipPeekAtLastError();
    if (le != hipSuccess) fprintf(stderr, "kernel_launch: launch failed: %s\n", hipGetErrorName(le));
}
```

```cpp
#include <hip/hip_runtime.h>
#include <cstdio>
#include <cstdint>

#ifndef MK_ONE_LAUNCH
#define MK_ONE_LAUNCH 1
#endif

#define GAS __attribute__((address_space(1)))
#define LAS __attribute__((address_space(3)))
typedef unsigned short bf16_t;
typedef short bf16x8 __attribute__((ext_vector_type(8)));
typedef float f32x4 __attribute__((ext_vector_type(4)));
typedef float f32x2 __attribute__((ext_vector_type(2)));
typedef unsigned u32x4 __attribute__((ext_vector_type(4)));
typedef unsigned u32x2 __attribute__((ext_vector_type(2)));
#define RLX_AGENT __ATOMIC_RELAXED, __HIP_MEMORY_SCOPE_AGENT
#define LDS_WAIT() asm volatile("s_waitcnt lgkmcnt(0)" ::: "memory")
#define VM_WAIT() asm volatile("s_waitcnt vmcnt(0)" ::: "memory")

constexpr int DM = 1024;
constexpr int RP = 8 * 4096, RS = 128 * 4, RT = RP + RS;
constexpr int NINP = 12544;
constexpr int LDU = 12288;
constexpr int U_Z = 0, U_XBC = 1024, U_QKV = 3072, U_ZA = 7680, U_QM = 8192, U_ZM = 8704, U_GATE = 9216;
constexpr int LDA = 2048;
constexpr float EPS = 1e-6f;
constexpr size_t O_YP = 0, O_YS = 33554432, O_PW128 = 34078720, O_PW512 = 35127296, O_PW2048 = 39321600, O_PMEM = 56098816, O_PCONV = 58195968, O_PSSM = 58245120,
                 O_SW128 = 59293696, O_SW512 = 59817984, O_SW2048 = 60342272, O_SCONV = 60866560, O_SSSM = 61652992, O_TOTAL = 78430208;
constexpr size_t MiB = 1u << 20;
constexpr size_t WS_CTL = 0, CTL_ZERO_BYTES = 1 * MiB;
constexpr size_t WS_WIN = 1 * MiB;
constexpr size_t WS_WMEM = 26 * MiB;
constexpr size_t WS_WBR = 30 * MiB;
constexpr size_t WS_WOUT = 34 * MiB;
constexpr size_t WS_CS = 36 * MiB;
constexpr size_t WS_DT = 37 * MiB;
constexpr size_t WS_SSQ = 40 * MiB;
constexpr size_t WS_RSQ = 45 * MiB;
constexpr size_t WS_MB = 48 * MiB;
constexpr size_t WS_MKV = 52 * MiB;
constexpr size_t WS_XB = 58 * MiB;
constexpr size_t WS_MERGED = 124 * MiB;
constexpr size_t WS_ACAT = 190 * MiB;
constexpr size_t WS_U = 321 * MiB;
constexpr size_t WS_XC = WS_U + (size_t)RT * LDU * 2;
constexpr size_t WS_END = WS_XC + (size_t)RT * 2048 * 2;
static_assert(WS_WIN + (size_t)NINP * 1024 * 2 <= WS_WMEM && WS_XB + (size_t)RT * 1024 * 2 <= WS_MERGED && WS_MERGED + (size_t)RT * 1024 * 2 <= WS_ACAT && WS_ACAT + (size_t)RT * LDA * 2 <= WS_U, "d_ws map");
constexpr int CW_Q = 64;
constexpr int CW_BAR = 4096;
constexpr int RING_BYTES = 131072, LDSCTL_OFF = RING_BYTES, MISC_OFF = LDSCTL_OFF + 320, LDS_BYTES = 147456;
constexpr int NWAVES = 8, NTHREADS = 512;

__device__ __forceinline__ float bf2f(bf16_t b) { return __uint_as_float(((unsigned)b) << 16); }
__device__ __forceinline__ unsigned f2bf(float f) { unsigned u = __float_as_uint(f); return (u + 0x7fffu + ((u >> 16) & 1u)) >> 16; }
__device__ __forceinline__ unsigned pk2(float lo, float hi) { return f2bf(lo) | (f2bf(hi) << 16); }
__device__ __forceinline__ float silu_f(float x) { return x / (1.0f + __expf(-x)); }
__device__ __forceinline__ float wave_sum(float v) {
#pragma unroll
    for (int o = 1; o < 64; o <<= 1) v += __shfl_xor(v, o);
    return v;
}
__device__ __forceinline__ float wave_max(float v) {
#pragma unroll
    for (int o = 1; o < 64; o <<= 1) v = fmaxf(v, __shfl_xor(v, o));
    return v;
}
namespace pg8 {
constexpr int BM = 256, BK = 64, HALF = 128, HTB = HALF * BK * 2  , STAGE_BYTES = 8 * HTB, NXCD = 8, WGM = 8;

__host__ __device__ __forceinline__ int lds_byte(int r, int c) { const int st = (r >> 4) * 2 + (c >> 5), rr = r & 15, cc = c & 31, ob = rr * 64 + cc * 2; return st * 1024 + (ob ^ (((ob >> 9) & 1) << 5)); }
__host__ __device__ __forceinline__ void stage_rc(int b, int& R, int& C) { const int st = b / 1024, sb = b % 1024, swz = sb ^ (((sb >> 9) & 1) << 5); R = (st >> 1) * 16 + swz / 64; C = (st & 1) * 32 + (swz % 64) / 2; }
__host__ __device__ __forceinline__ int perm32(int rho) { const int n = rho >> 4, i = rho & 15; return 8 * (i >> 2) + 4 * n + (i & 3); }

struct Unit { int pm, pn, k0, nt, kind, src; };
struct Gemm { const bf16_t* A; const bf16_t* Bt; int ld; const bf16_t* A2; const bf16_t* Bt2; };

struct TileOrder {
    int nM, nN, nwg, G, c, nsub, ntfull, nM2, nN2;
    __device__ __forceinline__ void init(int nM_, int nN_, int G_, int c_, int nsub_, int ntfull_, int nM2_ = 0, int nN2_ = 0) { nM = nM_; nN = nN_; nwg = nM * nN; G = G_; c = c_; nsub = nsub_; ntfull = ntfull_; nM2 = nM2_; nN2 = nN2_; }
    __device__ __forceinline__ bool next(int i, Unit& u) const {
        int ti = i, sub = 0;
        if (nsub == 3) { ti = i / 3; sub = i - 3 * ti; }
        const long L = (long)ti * G + c; u.src = 0;
        if (L >= nwg) { const int e = (int)(L - nwg); if (e >= nM2 * nN2) return false; u.pm = e / nN2; u.pn = e - u.pm * nN2; u.kind = 0; u.k0 = 0; u.nt = ntfull; u.src = 1; return true; }
        int wgid = (int)L; { const int q = nwg / NXCD, r = nwg % NXCD, xcd = wgid % NXCD, off = wgid / NXCD; wgid = (xcd < r ? xcd * (q + 1) : r * (q + 1) + (xcd - r) * q) + off; }
        const int nig = WGM * nN, gid = wgid / nig, fm = gid * WGM, gsz = (nM - fm) < WGM ? (nM - fm) : WGM;
        u.pm = fm + ((wgid % nig) % gsz); u.pn = (wgid % nig) / gsz; u.kind = sub;
        if (nsub == 3) { u.k0 = sub == 0 ? 0 : (sub == 1 ? 1024 : 1536); u.nt = sub == 0 ? 16 : 8; } else { u.k0 = 0; u.nt = ntfull; }
        return true;
    }
};

__device__ __forceinline__ unsigned cvt_pk_bf16(float lo, float hi) { unsigned r; asm volatile("v_cvt_pk_bf16_f32 %0, %1, %2" : "=v"(r) : "v"(lo), "v"(hi)); return r; }

template <class Epi, class Sched, bool ALIGN_EPI = true>
__device__ __forceinline__ void gemm_phase(LAS unsigned char* lds, const Gemm g, const Sched& S, const Epi& E, const int tid) {
    const int wid = __builtin_amdgcn_readfirstlane(tid >> 6), lane = tid & 63, wr = wid >> 2, wc = wid & 3, fr = lane & 15, fq = lane >> 4;
    const int K = g.ld;
    unsigned voffA[2], voffB[2];
#pragma unroll
    for (int i = 0; i < 2; ++i) { int R, C; stage_rc(tid * 16 + i * 8192, R, C); const int Rb = Epi::PERM ? ((R & ~31) + perm32(R & 31)) : R;
        voffA[i] = (unsigned)(R * K + C) * 2u; voffB[i] = (unsigned)(Rb * K + C) * 2u; }
    const size_t kstep = (size_t)(BK * 2);
    const size_t hstep = (size_t)HALF * K * 2;
    const size_t tstep = 2 * hstep;
    const unsigned ldsw = (unsigned)wid * 1024u;
    const int aoff = lds_byte(wr * 64 + fr, fq * 8), boff = lds_byte(wc * 32 + fr, fq * 8);
#define PG8_SA(b, h) (((b) * 2 + (h)) * HTB)
#define PG8_SB(b, h) ((4 + (b) * 2 + (h)) * HTB)
#define PG8_STAGE(bufoff, gbase, voff) do { _Pragma("unroll") for (int _i = 0; _i < 2; ++_i) \
        __builtin_amdgcn_global_load_lds((const unsigned*)((const char*)(gbase) + (voff)[_i]), (LAS unsigned*)(lds + (bufoff) + ldsw + _i * 8192), 16, 0, 0); } while (0)
#define PG8_LDA(dst, b, h) do { _Pragma("unroll") for (int m = 0; m < 4; ++m) _Pragma("unroll") for (int k = 0; k < 2; ++k) dst[m][k] = *(const LAS bf16x8*)(lds + PG8_SA(b, h) + aoff + m * 2048 + k * 1024); } while (0)
#define PG8_LDB(dst, b, h) do { _Pragma("unroll") for (int n = 0; n < 2; ++n) _Pragma("unroll") for (int k = 0; k < 2; ++k) dst[n][k] = *(const LAS bf16x8*)(lds + PG8_SB(b, h) + boff + n * 2048 + k * 1024); } while (0)
#define PG8_MMA(ai, bj, At, Bt) do { __builtin_amdgcn_s_setprio(1); _Pragma("unroll") for (int m = 0; m < 4; ++m) _Pragma("unroll") for (int n = 0; n < 2; ++n) _Pragma("unroll") for (int k = 0; k < 2; ++k) \
        acc[ai][bj][m][n] = __builtin_amdgcn_mfma_f32_16x16x32_bf16(Bt[n][k], At[m][k], acc[ai][bj][m][n], 0, 0, 0); __builtin_amdgcn_s_setprio(0); } while (0)
#define PG8_WAIT_V(n) asm volatile("s_waitcnt vmcnt(" #n ")" ::: "memory")
#define PG8_WAIT_L(n) asm volatile("s_waitcnt lgkmcnt(" #n ")" ::: "memory")
#define PG8_BAR __builtin_amdgcn_s_barrier()
#define PG8_SCHED __builtin_amdgcn_sched_barrier(0)
    Unit cur, nxt; int ui = 0;
    if (!S.next(0, cur)) return;
    f32x4 acc[2][2][4][2];
#pragma unroll
    for (int a = 0; a < 2; ++a)
#pragma unroll
        for (int b = 0; b < 2; ++b)
#pragma unroll
            for (int m = 0; m < 4; ++m)
#pragma unroll
                for (int n = 0; n < 2; ++n) acc[a][b][m][n] = (f32x4){0.f, 0.f, 0.f, 0.f};
    bf16x8 At[4][2], B0[2][2], B1[2][2];
    const char* cA = (const char*)(cur.src ? g.A2 : g.A) + (size_t)cur.pm * tstep + (size_t)cur.k0 * 2; const char* cB = (const char*)(cur.src ? g.Bt2 : g.Bt) + (size_t)cur.pn * tstep + (size_t)cur.k0 * 2;
    PG8_STAGE(PG8_SB(0, 0), cB, voffB); PG8_STAGE(PG8_SB(0, 1), cB + hstep, voffB); PG8_STAGE(PG8_SA(0, 0), cA, voffA); PG8_STAGE(PG8_SA(0, 1), cA + hstep, voffA);
    if (wr == 1) PG8_BAR;
    PG8_WAIT_V(2); PG8_BAR;
    PG8_STAGE(PG8_SB(1, 0), cB + kstep, voffB); PG8_STAGE(PG8_SA(1, 0), cA + kstep, voffA); PG8_STAGE(PG8_SB(1, 1), cB + hstep + kstep, voffB);
    PG8_WAIT_V(6); PG8_BAR;
    for (;;) {
        const bool has_next = S.next(ui + 1, nxt);
        const char* nA = has_next ? (const char*)(nxt.src ? g.A2 : g.A) + (size_t)nxt.pm * tstep + (size_t)nxt.k0 * 2 : cA; const char* nB = has_next ? (const char*)(nxt.src ? g.Bt2 : g.Bt) + (size_t)nxt.pn * tstep + (size_t)nxt.k0 * 2 : cB;
        const int nt = cur.nt;
        for (int t = 0; t < nt; t += 2) {
            const bool last = (t == nt - 2);
            const char* a1 = cA + (size_t)(t + 1) * kstep;
            const char* a2 = last ? nA : cA + (size_t)(t + 2) * kstep; const char* b2 = last ? nB : cB + (size_t)(t + 2) * kstep;
            const char* a3 = a2 + kstep; const char* b3 = b2 + kstep;
            PG8_LDB(B0, 0, 0); PG8_LDB(B1, 0, 1); PG8_SCHED; PG8_LDA(At, 0, 0); PG8_STAGE(PG8_SA(1, 1), a1 + hstep, voffA);
            PG8_WAIT_V(8); PG8_WAIT_L(0); PG8_BAR; PG8_MMA(0, 0, At, B0); PG8_MMA(0, 1, At, B1); PG8_BAR; PG8_SCHED;
            PG8_LDA(At, 0, 1); PG8_STAGE(PG8_SB(0, 0), b2, voffB); PG8_STAGE(PG8_SB(0, 1), b2 + hstep, voffB); PG8_STAGE(PG8_SA(0, 0), a2, voffA);
            PG8_WAIT_V(8); PG8_WAIT_L(0); PG8_BAR; PG8_MMA(1, 0, At, B0); PG8_MMA(1, 1, At, B1); PG8_BAR; PG8_SCHED;
            PG8_LDB(B0, 1, 0); PG8_LDB(B1, 1, 1); PG8_SCHED; PG8_LDA(At, 1, 0); PG8_STAGE(PG8_SA(0, 1), a2 + hstep, voffA);
            PG8_WAIT_V(8); PG8_WAIT_L(0); PG8_BAR; PG8_MMA(0, 0, At, B0); PG8_MMA(0, 1, At, B1); PG8_BAR; PG8_SCHED;
            PG8_LDA(At, 1, 1); PG8_STAGE(PG8_SB(1, 0), b3, voffB); PG8_STAGE(PG8_SB(1, 1), b3 + hstep, voffB); PG8_STAGE(PG8_SA(1, 0), a3, voffA);
            PG8_WAIT_V(8); PG8_WAIT_L(0); PG8_BAR; PG8_MMA(1, 0, At, B0); PG8_MMA(1, 1, At, B1); PG8_BAR; PG8_SCHED;
        }
        if constexpr (ALIGN_EPI) { if (wr == 0) PG8_BAR; }
        E(acc, cur, wr, wc, fr, fq);
        if (!has_next) break;
        if (E.zero_after(cur)) {
#pragma unroll
        for (int a = 0; a < 2; ++a)
#pragma unroll
            for (int b = 0; b < 2; ++b)
#pragma unroll
                for (int m = 0; m < 4; ++m)
#pragma unroll
                    for (int n = 0; n < 2; ++n) acc[a][b][m][n] = (f32x4){0.f, 0.f, 0.f, 0.f};
        }
        cur = nxt; cA = nA; cB = nB; ++ui;
        if constexpr (ALIGN_EPI) { if (wr == 1) PG8_BAR; }
    }
    PG8_WAIT_V(0);
    if constexpr (!ALIGN_EPI) { if (wr == 0) PG8_BAR; }
    PG8_BAR;
#undef PG8_SA
#undef PG8_SB
#undef PG8_STAGE
#undef PG8_LDA
#undef PG8_LDB
#undef PG8_MMA
#undef PG8_WAIT_V
#undef PG8_WAIT_L
#undef PG8_BAR
#undef PG8_SCHED
}
}
#define XB_TMO      128
#define XB_XCNT(j)  (256  + 64 * (j))
#define XB_XSUB(j)  (1280 + 64 * (j))
#define XB_XGEN(j)  (2304 + 64 * (j))
#define XB_TOP      3328
#define XB_TOPGEN   3392
#define XCD_BAR_WORDS 3456
#define XB_SPIN_CAP (1u << 18)

__device__ __forceinline__ unsigned xb_ld(unsigned* p)              { return __hip_atomic_load(p, __ATOMIC_RELAXED, __HIP_MEMORY_SCOPE_AGENT); }
__device__ __forceinline__ unsigned xb_add(unsigned* p, unsigned v) { return __hip_atomic_fetch_add(p, v, __ATOMIC_RELAXED, __HIP_MEMORY_SCOPE_AGENT); }
__device__ __forceinline__ unsigned xb_xcc_id() { return (unsigned)__builtin_amdgcn_s_getreg((3 << 11) | 20) & 0xFu; }
#define XB_SPIN(cond, bar) do { unsigned _sp = 0; while (cond) { __builtin_amdgcn_s_sleep(1); \
    if ((++_sp & 255u) == 0u) { if (xb_ld(&(bar)[XB_TMO])) break; if (_sp > XB_SPIN_CAP) { atomicAdd(&(bar)[XB_TMO], 1u); break; } } } } while (0)

struct XcdBarrier {
    unsigned* bar; unsigned x;
    volatile LAS unsigned* st;
};

__device__ __forceinline__ XcdBarrier xcd_barrier_post(unsigned* bar, volatile LAS unsigned* st) {
    XcdBarrier b; b.bar = bar; b.x = xb_xcc_id(); b.st = st;
    if (threadIdx.x == 0) (void)xb_add(&bar[XB_XCNT(b.x)], 1u);
    return b;
}
__device__ __forceinline__ void xcd_barrier_complete(unsigned* bar, unsigned x, unsigned& nloc, unsigned& nx) {
    const unsigned G = gridDim.x * gridDim.y * gridDim.z;
    unsigned sum, cnt, mine, sp = 0u;
    for (;;) {
        sum = 0u; cnt = 0u; mine = 0u;
#pragma unroll
        for (unsigned j = 0; j < 16; ++j) { const unsigned c = xb_ld(&bar[XB_XCNT(j)]); sum += c; cnt += (c > 0u) ? 1u : 0u; mine = (j == x) ? c : mine; }
        if (sum == G) break;
        __builtin_amdgcn_s_sleep(1);
        if ((++sp & 255u) == 0u) { if (xb_ld(&bar[XB_TMO])) break; if (sp > XB_SPIN_CAP) { atomicAdd(&bar[XB_TMO], 1u); break; } }
    }
    nloc = mine > 0u ? mine : 1u; nx = cnt > 0u ? cnt : 1u;
}

__device__ __forceinline__ void xcd_barrier(const XcdBarrier& b) {
    asm volatile("s_waitcnt vmcnt(0)" ::: "memory");
    __syncthreads();
    if (threadIdx.x == 0) {
        unsigned* bar = b.bar;
        __builtin_amdgcn_s_waitcnt(0);
        unsigned nloc = b.st[0], nx = b.st[1];
        if (nloc == 0u) { xcd_barrier_complete(bar, b.x, nloc, nx); b.st[0] = nloc; b.st[1] = nx; }
        const unsigned old = xb_add(&bar[XB_XSUB(b.x)], 1u);
        const unsigned gen = old / nloc;
        if (old + 1u == (gen + 1u) * nloc) {
            __builtin_amdgcn_fence(__ATOMIC_RELEASE, "agent");
            asm volatile("s_waitcnt vmcnt(0)" ::: "memory");
            const unsigned og = xb_add(&bar[XB_TOP], 1u);
            const unsigned tg = og / nx;
            if (og + 1u == (tg + 1u) * nx) xb_add(&bar[XB_TOPGEN], 1u);
            else XB_SPIN(xb_ld(&bar[XB_TOPGEN]) == tg, bar);
            __builtin_amdgcn_fence(__ATOMIC_ACQUIRE, "agent");
            xb_add(&bar[XB_XGEN(b.x)], 1u);
            asm volatile("s_waitcnt vmcnt(0)" ::: "memory");
        } else {
            XB_SPIN(xb_ld(&bar[XB_XGEN(b.x)]) == gen, bar);
            __builtin_amdgcn_fence(__ATOMIC_ACQUIRE, "agent");
            asm volatile("s_waitcnt vmcnt(0)" ::: "memory");
        }
    }
    __syncthreads();
}

constexpr float L2E_ = 1.4426950408889634f;
using pg8::Unit; using pg8::cvt_pk_bf16;
__device__ __forceinline__ u32x4 pack8(const f32x4 v0, const f32x4 v1) { u32x4 w; w.x = cvt_pk_bf16(v0[0], v0[1]); w.y = cvt_pk_bf16(v0[2], v0[3]); w.z = cvt_pk_bf16(v1[0], v1[1]); w.w = cvt_pk_bf16(v1[2], v1[3]); return w; }

struct EpiIn {
    static constexpr bool PERM = true;
    bf16_t* U; bf16_t* MKV; const float* CS; float* out;
    __device__ __forceinline__ bool zero_after(const Unit&) const { return true; }
    __device__ __forceinline__ void operator()(f32x4 (&acc)[2][2][4][2], const Unit& u, int wr, int wc, int fr, int fq) const {
        const int pn = u.pn, rbase = u.pm * 256 + wr * 64 + fr, lc0 = wc * 32 + 8 * fq;
        if (u.src == 1) {
            const int c0 = u.pn * 256 + lc0;
#pragma unroll
            for (int ai = 0; ai < 2; ++ai)
#pragma unroll
                for (int m = 0; m < 4; ++m) { const int row = rbase + ai * 128 + m * 16;
#pragma unroll
                    for (int bj = 0; bj < 2; ++bj) { const f32x4 v0 = acc[ai][bj][m][0], v1 = acc[ai][bj][m][1]; const size_t o = (size_t)row * 1024 + c0 + bj * 128;
                        *(u32x4*)(MKV + o) = pack8(v0, v1); float* d = out + O_PMEM + o; *(f32x4*)d = v0; *(f32x4*)(d + 4) = v1; } }
            return;
        }
        int kind = 0, g = 0, half = 0;
        if (pn >= 4 && pn < 12) kind = 1;
        else if (pn >= 12 && pn < 30) { const int t12 = pn - 12; g = t12 / 6; const int j = (t12 - 6 * g) >> 1; half = t12 & 1; kind = 2 + j; }
        const bool rope = (kind == 2 || kind == 3) && ((wc & 1) == 0);
        const int W = g == 0 ? 128 : (g == 1 ? 512 : 2048);
        const size_t opw = g == 0 ? O_PW128 : (g == 1 ? O_PW512 : O_PW2048), osw = g == 0 ? O_SW128 : (g == 1 ? O_SW512 : O_SW2048);
#pragma unroll
        for (int ai = 0; ai < 2; ++ai)
#pragma unroll
            for (int m = 0; m < 4; ++m) {
                const int row = rbase + ai * 128 + m * 16;
                const bool samp = row >= RP;
                const int t = samp ? ((row - RP) & 3) : (row & 4095), b = samp ? ((row - RP) >> 2) : (row >> 12);
                f32x4 c0, c1, s0, s1;
                if (rope) { const float* cs = CS + (size_t)(samp ? 4096 + t : t) * 16; c0 = *(const f32x4*)cs; c1 = *(const f32x4*)(cs + 4); s0 = *(const f32x4*)(cs + 8); s1 = *(const f32x4*)(cs + 12);
                    if (fq == 0) { s0 = -s0; s1 = -s1; } }
#pragma unroll
                for (int bj = 0; bj < 2; ++bj) {
                    f32x4 v0 = acc[ai][bj][m][0], v1 = acc[ai][bj][m][1];
                    if (rope) {
                        f32x4 p0, p1;
#pragma unroll
                        for (int e = 0; e < 4; ++e) { p0[e] = __shfl_xor(v0[e], 16); p1[e] = __shfl_xor(v1[e], 16); }
                        if (fq < 2) { v0 = v0 * c0 + p0 * s0; v1 = v1 * c1 + p1 * s1; }
                    }
                    if (kind == 2) { v0 = v0 * 0.125f; v1 = v1 * 0.125f; }
                    if (kind == 5) {
#pragma unroll
                        for (int e = 0; e < 4; ++e) { v0[e] = fmaxf(__builtin_amdgcn_rcpf(1.0f + __builtin_amdgcn_exp2f(-L2E_ * v0[e])), 1e-30f); v1[e] = fmaxf(__builtin_amdgcn_rcpf(1.0f + __builtin_amdgcn_exp2f(-L2E_ * v1[e])), 1e-30f); } }
                    const int lc = bj * 128 + lc0;
                    *(u32x4*)(U + (size_t)row * LDU + pn * 256 + lc) = pack8(v0, v1);
                    if (kind == 1) {
                        const int col = (pn - 4) * 256 + lc;
                        if (samp) { if (t >= 1) { float* d = out + O_SCONV + (size_t)(b * 3 + t - 1) * 2048 + col; *(f32x4*)d = v0; *(f32x4*)(d + 4) = v1; } }
                        else if (t >= 4093) { float* d = out + O_PCONV + (size_t)(b * 3 + t - 4093) * 2048 + col; *(f32x4*)d = v0; *(f32x4*)(d + 4) = v1; }
                    } else if (kind >= 3) {
                        const int hd = half * 256 + lc, kv = kind - 3;
                        if (samp) { float* d = out + osw + ((size_t)(row - RP) * 2 + kv) * 512 + hd; *(f32x4*)d = v0; *(f32x4*)(d + 4) = v1; }
                        else if (t >= 4096 - W) { float* d = out + opw + ((size_t)(b * W + t - (4096 - W)) * 2 + kv) * 512 + hd; *(f32x4*)d = v0; *(f32x4*)(d + 4) = v1; }
                    }
                }
            }
    }
};

struct EpiMem {
    static constexpr bool PERM = true;
    bf16_t* MKV; float* out;
    __device__ __forceinline__ bool zero_after(const Unit&) const { return true; }
    __device__ __forceinline__ void operator()(f32x4 (&acc)[2][2][4][2], const Unit& u, int wr, int wc, int fr, int fq) const {
        const int rbase = u.pm * 256 + wr * 64 + fr, c0 = u.pn * 256 + wc * 32 + 8 * fq;
#pragma unroll
        for (int ai = 0; ai < 2; ++ai)
#pragma unroll
            for (int m = 0; m < 4; ++m) { const int row = rbase + ai * 128 + m * 16;
#pragma unroll
                for (int bj = 0; bj < 2; ++bj) { const f32x4 v0 = acc[ai][bj][m][0], v1 = acc[ai][bj][m][1]; const size_t o = (size_t)row * 1024 + c0 + bj * 128;
                    *(u32x4*)(MKV + o) = pack8(v0, v1); float* d = out + O_PMEM + o; *(f32x4*)d = v0; *(f32x4*)(d + 4) = v1; } }
    }
};

struct EpiBr {
    static constexpr bool PERM = true;
    const bf16_t* U; const float* SSQ; bf16_t* MERGED;
    __device__ __forceinline__ bool zero_after(const Unit& u) const { return u.kind == 2; }
    __device__ __forceinline__ void operator()(f32x4 (&acc)[2][2][4][2], const Unit& u, int wr, int wc, int fr, int fq) const {
        const int rbase = u.pm * 256 + wr * 64 + fr, c0 = u.pn * 256 + wc * 32 + 8 * fq, kind = u.kind;
        const int goffa = kind == 0 ? 0 : (kind == 1 ? 1024 : 2048), goffb = kind == 0 ? 1024 : 2048;
#pragma unroll
        for (int am = 0; am < 8; ++am) { const int ai = am >> 2, mb = am & 3;
            u32x4 ga[4][2], gb[4][2]; f32x4 q0[4], q1[4];
#pragma unroll
            for (int m = mb; m < mb + 1; ++m) { const size_t row = (size_t)(rbase + ai * 128 + m * 16);
                if (kind == 0) { q0[m] = *(const f32x4*)(SSQ + row * 32 + 8 * fq); q1[m] = *(const f32x4*)(SSQ + row * 32 + 8 * fq + 4); }
#pragma unroll
                for (int bj = 0; bj < 2; ++bj) { const bf16_t* gp = U + row * LDU + U_GATE + c0 + bj * 128; ga[m][bj] = *(const u32x4*)(gp + goffa); if (kind != 2) gb[m][bj] = *(const u32x4*)(gp + goffb); } }
#pragma unroll
            for (int m = mb; m < mb + 1; ++m) { const size_t row = (size_t)(rbase + ai * 128 + m * 16);
                float rs = 1.0f;
                if (kind == 0) { float sq = ((q0[m][0] + q0[m][1]) + (q0[m][2] + q0[m][3])) + ((q1[m][0] + q1[m][1]) + (q1[m][2] + q1[m][3]));
                    sq += __shfl_xor(sq, 16); sq += __shfl_xor(sq, 32); rs = 1.0f / sqrtf(sq * (1.0f / 1024.0f) + EPS); }
#pragma unroll
                for (int bj = 0; bj < 2; ++bj) {
                    float f[8];
                    if (kind == 2) {
#pragma unroll
                        for (int e = 0; e < 4; ++e) { f[2 * e] = __builtin_amdgcn_rcpf(1.0f + __builtin_amdgcn_exp2f(-L2E_ * __builtin_amdgcn_fmed3f(__uint_as_float(ga[m][bj][e] << 16), -60.f, 60.f))); f[2 * e + 1] = __builtin_amdgcn_rcpf(1.0f + __builtin_amdgcn_exp2f(-L2E_ * __builtin_amdgcn_fmed3f(__uint_as_float(ga[m][bj][e] & 0xffff0000u), -60.f, 60.f))); }
                    } else {
#pragma unroll
                        for (int e = 0; e < 4; ++e) {
                            const float a_lo = __builtin_amdgcn_fmed3f(__uint_as_float(ga[m][bj][e] << 16), -60.f, 60.f), a_hi = __builtin_amdgcn_fmed3f(__uint_as_float(ga[m][bj][e] & 0xffff0000u), -60.f, 60.f);
                            const float b_lo = __builtin_amdgcn_fmed3f(__uint_as_float(gb[m][bj][e] << 16), -60.f, 60.f), b_hi = __builtin_amdgcn_fmed3f(__uint_as_float(gb[m][bj][e] & 0xffff0000u), -60.f, 60.f);
                            f[2 * e] = rs * (1.0f + __builtin_amdgcn_exp2f(-L2E_ * b_lo)) * __builtin_amdgcn_rcpf(1.0f + __builtin_amdgcn_exp2f(-L2E_ * a_lo));
                            f[2 * e + 1] = rs * (1.0f + __builtin_amdgcn_exp2f(-L2E_ * b_hi)) * __builtin_amdgcn_rcpf(1.0f + __builtin_amdgcn_exp2f(-L2E_ * a_hi)); }
                    }
                    f32x4 v0 = acc[ai][bj][m][0], v1 = acc[ai][bj][m][1];
                    v0 = v0 * (f32x4){f[0], f[1], f[2], f[3]}; v1 = v1 * (f32x4){f[4], f[5], f[6], f[7]};
                    acc[ai][bj][m][0] = v0; acc[ai][bj][m][1] = v1;
                    if (kind == 2) *(u32x4*)(MERGED + row * 1024 + c0 + bj * 128) = pack8(v0, v1);
                }
            }
        }
    }
};

struct EpiOut {
    static constexpr bool PERM = false;
    const float* xp; const float* xs; float* out; float* RSQ;
    __device__ __forceinline__ bool zero_after(const Unit&) const { return true; }
    __device__ __forceinline__ void operator()(f32x4 (&acc)[2][2][4][2], const Unit& u, int wr, int wc, int fr, int fq) const {
        const int rbase = u.pm * 256 + wr * 64 + fr, c0 = u.pn * 256 + wc * 32 + 4 * fq;
#pragma unroll
        for (int am = 0; am < 4; ++am) { const int ai = am >> 1, mb = 2 * (am & 1);
            f32x4 xr[4][2][2];
#pragma unroll
            for (int m = mb; m < mb + 2; ++m) { const int row = rbase + ai * 128 + m * 16;
                const float* xq = (row < RP ? xp + (size_t)row * 1024 : xs + (size_t)(row - RP) * 1024) + c0;
#pragma unroll
                for (int bj = 0; bj < 2; ++bj)
#pragma unroll
                    for (int n = 0; n < 2; ++n) xr[m][bj][n] = *(const f32x4*)(xq + bj * 128 + n * 16); }
#pragma unroll
            for (int m = mb; m < mb + 2; ++m) { const int row = rbase + ai * 128 + m * 16;
                float* orow = out + (size_t)row * 1024 + c0;
                float s = 0.f;
#pragma unroll
                for (int bj = 0; bj < 2; ++bj)
#pragma unroll
                    for (int n = 0; n < 2; ++n) { const f32x4 r = xr[m][bj][n] + acc[ai][bj][m][n]; *(f32x4*)(orow + bj * 128 + n * 16) = r;
                        s += (r[0] * r[0] + r[1] * r[1]) + (r[2] * r[2] + r[3] * r[3]); }
                s += __shfl_xor(s, 16); s += __shfl_xor(s, 32);
                if (fq == 0) RSQ[(size_t)row * 16 + u.pn * 4 + wc] = s;
            }
        }
    }
};
struct Frame {
    LAS unsigned char* lds;
    unsigned* ctl;
    int tid, lane, wave, G, vcu;
    const float *xp, *xs, *memp, *cw128, *cw512, *cw2048, *cmem, *sconv, *sssm, *norm_in_w, *w_in, *conv_w, *conv_b, *dt_bias, *a_log, *d_skip, *ssd_norm_w, *mem_norm_w, *w_mem_kv, *w_br_ssd, *w_br_att, *w_br_mem, *w_out, *norm_f_w;
    float* out;
    bf16_t *WinT, *WmemT, *WbrT, *WoutT, *XB, *MB, *U, *MKV, *ACAT, *MERGED, *XC;
    float *CS, *DT, *SSQ, *RSQ;
};

struct Args { const float* in[24]; float* out; unsigned char* ws; int ph_lo, ph_hi; };
#define FRAME() Frame F; \
    F.lds = (LAS unsigned char*)lds; F.tid = threadIdx.x; F.lane = F.tid & 63; F.wave = __builtin_amdgcn_readfirstlane(F.tid >> 6); \
    F.G = gridDim.x; { const int bx = blockIdx.x; F.vcu = (F.G % 8 == 0) ? (bx % 8) * (F.G / 8) + bx / 8 : bx; } \
    unsigned char* ws = args.ws; F.ctl = (unsigned*)(ws + WS_CTL); \
    F.xp = args.in[0]; F.xs = args.in[1]; F.memp = args.in[2]; F.cw128 = args.in[3]; F.cw512 = args.in[4]; F.cw2048 = args.in[5]; F.cmem = args.in[6]; F.sconv = args.in[7]; F.sssm = args.in[8]; \
    F.norm_in_w = args.in[9]; F.w_in = args.in[10]; F.conv_w = args.in[11]; F.conv_b = args.in[12]; F.dt_bias = args.in[13]; F.a_log = args.in[14]; F.d_skip = args.in[15]; F.ssd_norm_w = args.in[16]; \
    F.mem_norm_w = args.in[17]; F.w_mem_kv = args.in[18]; F.w_br_ssd = args.in[19]; F.w_br_att = args.in[20]; F.w_br_mem = args.in[21]; F.w_out = args.in[22]; F.norm_f_w = args.in[23]; \
    F.out = args.out; \
    F.WinT = (bf16_t*)(ws + WS_WIN); F.WmemT = (bf16_t*)(ws + WS_WMEM); F.WbrT = (bf16_t*)(ws + WS_WBR); F.WoutT = (bf16_t*)(ws + WS_WOUT); \
    F.XB = (bf16_t*)(ws + WS_XB); F.MB = (bf16_t*)(ws + WS_MB); F.U = (bf16_t*)(ws + WS_U); F.MKV = (bf16_t*)(ws + WS_MKV); F.ACAT = (bf16_t*)(ws + WS_ACAT); F.MERGED = (bf16_t*)(ws + WS_MERGED); F.XC = (bf16_t*)(ws + WS_XC); \
    F.CS = (float*)(ws + WS_CS); F.DT = (float*)(ws + WS_DT); F.SSQ = (float*)(ws + WS_SSQ); F.RSQ = (float*)(ws + WS_RSQ)

template <int MODE>
__device__ __forceinline__ void transpose_item(const float* W, int N, const float* ksc, bf16_t* WT, int ldk, int koff, int kb, int nb, LAS float* scr, int lane) {
    const int k0 = 64 * kb, n0 = 32 * nb;
    int nsrc = n0 + (lane & 31);
    if (MODE == 1) nsrc = nsrc < 3072 ? nsrc : (nsrc < 12288 ? nsrc + 16 : (nsrc < 12304 ? 3072 + nsrc - 12288 : -1));
#pragma unroll 8
    for (int i = 0; i < 32; ++i) { const int kk = 2 * i + (lane >> 5); float v = 0.f; if (nsrc >= 0) v = W[(size_t)(k0 + kk) * N + nsrc]; if (ksc) v *= ksc[k0 + kk]; scr[kk * 33 + (lane & 31)] = v; }
    LDS_WAIT(); asm volatile("" ::: "memory");
    const int c = lane & 7;
#pragma unroll
    for (int j = 0; j < 4; ++j) { const int n = (lane >> 3) + 8 * j; const LAS float* s = scr + (8 * c) * 33 + n;
        u32x4 o; o.x = pk2(s[0 * 33], s[1 * 33]); o.y = pk2(s[2 * 33], s[3 * 33]); o.z = pk2(s[4 * 33], s[5 * 33]); o.w = pk2(s[6 * 33], s[7 * 33]);
        *(u32x4*)(WT + (size_t)(n0 + n) * ldk + koff + k0 + 8 * c) = o; }
    LDS_WAIT(); asm volatile("" ::: "memory");
}
__device__ __forceinline__ void rms_row_to_bf16(const float* xrow, bf16_t* orow, int lane) {
    const f32x4* xr = (const f32x4*)xrow + lane;
    f32x4 v[4]; float s = 0.f;
#pragma unroll
    for (int j = 0; j < 4; ++j) { v[j] = xr[64 * j]; s += (v[j][0] * v[j][0] + v[j][1] * v[j][1]) + (v[j][2] * v[j][2] + v[j][3] * v[j][3]); }
    const float rstd = 1.0f / sqrtf(wave_sum(s) * (1.0f / 1024.0f) + EPS);
    u32x2* o8 = (u32x2*)orow + lane;
#pragma unroll
    for (int j = 0; j < 4; ++j) { u32x2 w; w.x = pk2(v[j][0] * rstd, v[j][1] * rstd); w.y = pk2(v[j][2] * rstd, v[j][3] * rstd); o8[64 * j] = w; }
}
__device__ __forceinline__ void sincos_d(float angf, float& sn, float& cs) {
    const double a = (double)angf; const double k = rint(a * 0.15915494309189533577);
    double r = a - k * 6.283185307179586232; r -= k * 2.4492935982947064e-16;
    const double r2 = r * r; double ts = r, tc = 1.0, ss = r, sc = 1.0;
#pragma unroll 1
    for (int i = 1; i <= 14; ++i) { tc = -tc * r2 / (double)((2 * i - 1) * (2 * i)); ts = -ts * r2 / (double)((2 * i) * (2 * i + 1)); sc += tc; ss += ts; }
    sn = (float)ss; cs = (float)sc;
}
__device__ __forceinline__ void p0_prologue(Frame& F) {
    LAS float* scr = (LAS float*)(F.lds + F.wave * 16384);
    const int gw = F.vcu * NWAVES + F.wave, NGW = F.G * NWAVES, lane = F.lane;
    constexpr int I_IN = 16 * (NINP / 32), I_MEM = 16 * 32, I_B1 = 16 * 32, I_B2 = 8 * 32, I_B3 = 8 * 32, I_OUT = 16 * 32;
    constexpr int NITEMS = I_IN + I_MEM + I_B1 + I_B2 + I_B3 + I_OUT;
#ifndef P0_MASK
#define P0_MASK 7
#endif
    if (P0_MASK & 1)
    for (int it = gw; it < NITEMS; it += NGW) {
        int r = it;
        if (r < I_IN) { transpose_item<1>(F.w_in, 12304, F.norm_in_w, F.WinT, 1024, 0, r / (NINP / 32), r % (NINP / 32), scr, lane); continue; } r -= I_IN;
        if (r < I_MEM) { transpose_item<0>(F.w_mem_kv, 1024, F.mem_norm_w, F.WmemT, 1024, 0, r / 32, r % 32, scr, lane); continue; } r -= I_MEM;
        if (r < I_B1) { transpose_item<0>(F.w_br_ssd, 1024, F.ssd_norm_w, F.WbrT, 2048, 0, r / 32, r % 32, scr, lane); continue; } r -= I_B1;
        if (r < I_B2) { transpose_item<0>(F.w_br_att, 1024, nullptr, F.WbrT, 2048, 1024, r / 32, r % 32, scr, lane); continue; } r -= I_B2;
        if (r < I_B3) { transpose_item<0>(F.w_br_mem, 1024, nullptr, F.WbrT, 2048, 1536, r / 32, r % 32, scr, lane); continue; } r -= I_B3;
        transpose_item<0>(F.w_out, 1024, nullptr, F.WoutT, 1024, 0, r / 32, r % 32, scr, lane);
    }
    if (P0_MASK & 2)
    for (int m = gw; m < RT + 2048; m += NGW) {
        if (m < RP) rms_row_to_bf16(F.xp + (size_t)m * 1024, F.XB + (size_t)m * 1024, lane);
        else if (m < RT) rms_row_to_bf16(F.xs + (size_t)(m - RP) * 1024, F.XB + (size_t)m * 1024, lane);
        else rms_row_to_bf16(F.memp + (size_t)(m - RT) * 1024, F.MB + (size_t)(m - RT) * 1024, lane);
    }
    if (P0_MASK & 4)
    for (int idx = (F.vcu * NTHREADS + F.tid); idx < 4100 * 8; idx += F.G * NTHREADS) {
        const int pi = idx >> 3, i = idx & 7; const int pos = pi < 4096 ? pi : 8192 + (pi - 4096);
        const float inv = i == 0 ? 1.0f : i == 1 ? 0.1939227432012558f : i == 2 ? 0.03760603070259094f : i == 3 ? 0.007292664609849453f : i == 4 ? 0.0014142135623842478f : i == 5 ? 0.00027424818836152554f : i == 6 ? 5.318296098266728e-05f : 1.0313386155758053e-05f;
        const float ang = (float)pos * inv; float sn, cs; sincos_d(ang, sn, cs);
        F.CS[(size_t)pi * 16 + i] = cs; F.CS[(size_t)pi * 16 + 8 + i] = sn;
    }
}


__device__ __forceinline__ void p1c_conv(Frame& F) {
    const int gt = F.vcu * NTHREADS + F.tid, cg = gt & 255, rbi = gt >> 8, nrb = (F.G * NTHREADS) >> 8;
    f32x4 w0[4], w1[4];
#pragma unroll
    for (int kk = 0; kk < 4; ++kk) { w0[kk] = *(const f32x4*)(F.conv_w + kk * 2048 + 8 * cg); w1[kk] = *(const f32x4*)(F.conv_w + kk * 2048 + 8 * cg + 4); }
    const f32x4 b0 = *(const f32x4*)(F.conv_b + 8 * cg), b1 = *(const f32x4*)(F.conv_b + 8 * cg + 4);
    for (int rb = rbi; rb < RT / 4; rb += nrb) {
        const int row = 4 * rb; const bool samp = row >= RP;
        f32x4 x0[7], x1[7];
#pragma unroll
        for (int k = 0; k < 7; ++k) {
            x0[k] = (f32x4){0.f, 0.f, 0.f, 0.f}; x1[k] = x0[k];
            if (k >= 3 || (!samp && (row & 4095) != 0)) { const u32x4 xr = *(const u32x4*)(F.U + (size_t)(row - 3 + k) * LDU + U_XBC + 8 * cg);
                x0[k] = (f32x4){__uint_as_float(xr.x << 16), __uint_as_float(xr.x & 0xffff0000u), __uint_as_float(xr.y << 16), __uint_as_float(xr.y & 0xffff0000u)};
                x1[k] = (f32x4){__uint_as_float(xr.z << 16), __uint_as_float(xr.z & 0xffff0000u), __uint_as_float(xr.w << 16), __uint_as_float(xr.w & 0xffff0000u)}; }
            else if (samp) { const float* sp = F.sconv + (size_t)(((row - RP) >> 2) * 3 + k) * 2048 + 8 * cg; x0[k] = *(const f32x4*)sp; x1[k] = *(const f32x4*)(sp + 4); }
        }
#pragma unroll
        for (int r = 0; r < 4; ++r) { f32x4 a0 = b0, a1 = b1;
#pragma unroll
            for (int kk = 0; kk < 4; ++kk) { a0 += w0[kk] * x0[r + kk]; a1 += w1[kk] * x1[r + kk]; }
#pragma unroll
            for (int e = 0; e < 4; ++e) { a0[e] = silu_f(a0[e]); a1[e] = silu_f(a1[e]); }
            u32x4 o; o.x = pk2(a0[0], a0[1]); o.y = pk2(a0[2], a0[3]); o.z = pk2(a1[0], a1[1]); o.w = pk2(a1[2], a1[3]);
            *(u32x4*)(F.XC + (size_t)(row + r) * 2048 + 8 * cg) = o; }
    }
    const int lane = F.lane, fr = lane & 15, fq = lane >> 4;
    for (int tile = F.vcu * NWAVES + F.wave; tile < RT / 16; tile += F.G * NWAVES) {
        const bf16_t* ap = F.XB + (size_t)(16 * tile + fr) * 1024 + 8 * fq; const bf16_t* bp = F.WinT + (size_t)(12288 + fr) * 1024 + 8 * fq;
        f32x4 d = (f32x4){0.f, 0.f, 0.f, 0.f};
#pragma unroll 8
        for (int ks = 0; ks < 32; ++ks) d = __builtin_amdgcn_mfma_f32_16x16x32_bf16(*(const bf16x8*)(ap + 32 * ks), *(const bf16x8*)(bp + 32 * ks), d, 0, 0, 0);
#pragma unroll
        for (int v = 0; v < 4; ++v) F.DT[(size_t)(16 * tile + 4 * fq + v) * 16 + fr] = d[v];
    }
}

__device__ __forceinline__ float dot64_bf16(const bf16_t* kp, const LAS float* q) {
    float s = 0.f;
#pragma unroll
    for (int c = 0; c < 8; ++c) { const u32x4 w = *(const u32x4*)(kp + 8 * c); const f32x4 q0 = *(const LAS f32x4*)(q + 8 * c), q1 = *(const LAS f32x4*)(q + 8 * c + 4);
        s += __uint_as_float(w.x << 16) * q0[0] + __uint_as_float(w.x & 0xffff0000u) * q0[1] + __uint_as_float(w.y << 16) * q0[2] + __uint_as_float(w.y & 0xffff0000u) * q0[3]
           + __uint_as_float(w.z << 16) * q1[0] + __uint_as_float(w.z & 0xffff0000u) * q1[1] + __uint_as_float(w.w << 16) * q1[2] + __uint_as_float(w.w & 0xffff0000u) * q1[3]; }
    return s;
}
__device__ __forceinline__ float dot64_f32(const float* kp, const LAS float* q) {
    float s = 0.f;
#pragma unroll
    for (int c = 0; c < 16; ++c) { const f32x4 w = *(const f32x4*)(kp + 4 * c); const f32x4 q0 = *(const LAS f32x4*)(q + 4 * c); s += w[0] * q0[0] + w[1] * q0[1] + w[2] * q0[2] + w[3] * q0[3]; }
    return s;
}
typedef float f32x16 __attribute__((ext_vector_type(16)));
typedef short s16x4 __attribute__((ext_vector_type(4)));
typedef short v4i16_t __attribute__((ext_vector_type(4)));
typedef __bf16 bf16x2_t __attribute__((ext_vector_type(2)));
typedef float f32x2_t __attribute__((ext_vector_type(2)));
__device__ __forceinline__ unsigned cvtpk(float lo, float hi) { f32x2_t v = {lo, hi}; bf16x2_t b = __builtin_convertvector(v, bf16x2_t); return __builtin_bit_cast(unsigned, b); }
__device__ __forceinline__ s16x4 vtr(const LAS char* p) { return __builtin_bit_cast(s16x4, __builtin_amdgcn_ds_read_tr16_b64_v4i16((LAS v4i16_t*)p)); }
#define MFMA32(a, b, c) __builtin_amdgcn_mfma_f32_32x32x16_bf16((a), (b), (c), 0, 0, 0)
constexpr float L2E = 1.4426950408889634f;

template <int HD, bool MASK, bool DEEP>
__device__ __forceinline__ void att_tile_range(f32x16 (&o)[HD / 32], float& mrun, float& lrun, const bf16x8 (&qf)[HD / 16], const bf16_t* kp, const bf16_t* vp, size_t kstride, int ntiles, int rel0, float sl2e, LAS char* vl, int lane) {
    constexpr int NS = HD / 16, RSB = HD * 2 + 64, CPR = HD / 8, RPI = 64 / CPR;
    const int h = lane >> 5;
    const LAS char* trb = vl + (4 * h + ((lane & 15) >> 2)) * RSB + 32 * ((lane >> 4) & 1) + 8 * (lane & 3);
    LAS char* wrb = vl + (lane / CPR) * RSB + (lane % CPR) * 16;
    bf16x8 ka[NS], kb[DEEP ? NS : 1]; u32x4 va[NS];
#define ATT_LDK(dst, t_) do { const bf16_t* kq_ = kp + (size_t)(t_) * 32 * kstride; _Pragma("unroll") for (int s = 0; s < NS; ++s) dst[s] = *(const bf16x8*)(kq_ + 16 * s); } while (0)
#define ATT_LDV(dst, t_) do { const bf16_t* vq_ = vp + (size_t)(t_) * 32 * kstride; _Pragma("unroll") for (int s = 0; s < NS; ++s) dst[s] = *(const u32x4*)(vq_ + (size_t)(RPI * s) * kstride); } while (0)
#define ATT_STV(src) do { _Pragma("unroll") for (int s = 0; s < NS; ++s) *(LAS u32x4*)(wrb + (RPI * s) * RSB) = src[s]; } while (0)
#define ATT_STEP(KU, VN, VW, KAHEAD, VAHEAD) do { \
        if (kt + (VAHEAD) < ntiles) ATT_LDV(VN, kt + (VAHEAD)); \
        f32x16 sc; \
        _Pragma("unroll") for (int v = 0; v < 16; ++v) sc[v] = 0.f; \
        _Pragma("unroll") for (int s = 0; s < NS; ++s) sc = MFMA32(KU[s], qf[s], sc); \
        if (kt + (KAHEAD) < ntiles) ATT_LDK(KU, kt + (KAHEAD)); \
        float tmax = -1e30f; \
        if (MASK && (kt == 0 || kt + 1 == ntiles)) { \
            _Pragma("unroll") for (int v = 0; v < 16; ++v) { float y = sc[v] * sl2e; const int rel = rel0 - 32 * kt - ((v & 3) + 8 * (v >> 2)); if ((unsigned)rel > 128u) y = -1e30f; sc[v] = y; tmax = fmaxf(tmax, y); } \
        } else { \
            _Pragma("unroll") for (int v = 0; v < 16; ++v) { const float y = sc[v] * sl2e; sc[v] = y; tmax = fmaxf(tmax, y); } \
        } \
        tmax = fmaxf(tmax, __shfl_xor(tmax, 32)); \
        const float mnew = fmaxf(mrun, tmax); \
        if (__any(mnew > mrun)) { const float alpha = __builtin_amdgcn_exp2f(mrun - mnew); \
            _Pragma("unroll") for (int mt = 0; mt < HD / 32; ++mt) o[mt] = o[mt] * alpha; \
            lrun *= alpha; mrun = mnew; } \
        float ps = 0.f; unsigned pk[8]; \
        _Pragma("unroll") for (int v = 0; v < 16; v += 2) { const float p0 = __builtin_amdgcn_exp2f(sc[v] - mrun), p1 = __builtin_amdgcn_exp2f(sc[v + 1] - mrun); ps += p0 + p1; pk[v >> 1] = cvtpk(p0, p1); } \
        lrun += ps; \
        const bf16x8 pf0 = __builtin_bit_cast(bf16x8, (u32x4){pk[0], pk[1], pk[2], pk[3]}), pf1 = __builtin_bit_cast(bf16x8, (u32x4){pk[4], pk[5], pk[6], pk[7]}); \
        _Pragma("unroll") for (int mt = 0; mt < HD / 32; ++mt) { \
            const s16x4 a0 = vtr(trb + 64 * mt), a1 = vtr(trb + 8 * RSB + 64 * mt), a2 = vtr(trb + 16 * RSB + 64 * mt), a3 = vtr(trb + 24 * RSB + 64 * mt); \
            o[mt] = MFMA32(__builtin_shufflevector(a0, a1, 0, 1, 2, 3, 4, 5, 6, 7), pf0, o[mt]); \
            o[mt] = MFMA32(__builtin_shufflevector(a2, a3, 0, 1, 2, 3, 4, 5, 6, 7), pf1, o[mt]); } \
        if (kt + 1 < ntiles) ATT_STV(VW); } while (0)
    ATT_LDK(ka, 0); ATT_LDV(va, 0);
    ATT_STV(va);
    if (DEEP) {
        if (ntiles > 1) ATT_LDK(kb, 1);
#pragma unroll 1
        for (int kt = 0; kt < ntiles; ++kt) {
            ATT_STEP(ka, va, va, 2, 1);
            if (++kt >= ntiles) break;
            ATT_STEP(kb, va, va, 2, 1);
        }
    } else {
#pragma unroll 1
        for (int kt = 0; kt < ntiles; ++kt) ATT_STEP(ka, va, va, 1, 1);
    }
#undef ATT_LDK
#undef ATT_LDV
#undef ATT_STV
#undef ATT_STEP
}
__device__ __forceinline__ void att_tile_pair(f32x16 (&oa)[2], f32x16 (&ob)[2], float& ma, float& la, float& mb, float& lb, const bf16x8 (&qa)[4], const bf16x8 (&qb)[4],
                                              const bf16_t* kp, const bf16_t* vp, size_t kstride, int ntiles, int dq  , LAS char* vl, int lane) {
    constexpr int RSB = 192;
    const int h = lane >> 5, c = lane & 31;
    const LAS char* trb = vl + (4 * h + ((lane & 15) >> 2)) * RSB + 32 * ((lane >> 4) & 1) + 8 * (lane & 3);
    LAS char* wrb = vl + (lane >> 3) * RSB + (lane & 7) * 16;
    bf16x8 kf[4]; u32x4 vr[4];
#pragma unroll
    for (int s = 0; s < 4; ++s) { kf[s] = *(const bf16x8*)(kp + 16 * s); vr[s] = *(const u32x4*)(vp + (size_t)(8 * s) * kstride); }
#pragma unroll
    for (int s = 0; s < 4; ++s) *(LAS u32x4*)(wrb + (8 * s) * RSB) = vr[s];
#pragma unroll 1
    for (int kt = 0; kt < ntiles; ++kt) {
        const bool more = kt + 1 < ntiles;
        if (more) { const bf16_t* vq_ = vp + (size_t)(kt + 1) * 32 * kstride;
#pragma unroll
            for (int s = 0; s < 4; ++s) vr[s] = *(const u32x4*)(vq_ + (size_t)(8 * s) * kstride); }
        const int hiA = dq + 31 - 32 * kt, loA = dq - 32 * kt - 31, hiB = hiA + 32, loB = loA + 32;
        const bool useA = hiA >= 0 && loA <= 128, useB = hiB >= 0 && loB <= 128, mskA = !(loA >= 0 && hiA <= 128), mskB = !(loB >= 0 && hiB <= 128);
        f32x16 sa, sb;
#pragma unroll
        for (int v = 0; v < 16; ++v) { sa[v] = 0.f; sb[v] = 0.f; }
        if (useA) {
#pragma unroll
            for (int s = 0; s < 4; ++s) sa = MFMA32(kf[s], qa[s], sa); }
        if (useB) {
#pragma unroll
            for (int s = 0; s < 4; ++s) sb = MFMA32(kf[s], qb[s], sb); }
        if (more) { const bf16_t* kq_ = kp + (size_t)(kt + 1) * 32 * kstride;
#pragma unroll
            for (int s = 0; s < 4; ++s) kf[s] = *(const bf16x8*)(kq_ + 16 * s); }
        bf16x8 pa0, pa1, pb0, pb1;
#define ATT_SOFTMAX(SC, MSK, REL0, M, Lr, O, P0, P1) do { float tmax = -1e30f; \
            if (MSK) { _Pragma("unroll") for (int v = 0; v < 16; ++v) { float y = SC[v] * L2E; const int rel = (REL0) - ((v & 3) + 8 * (v >> 2)); if ((unsigned)rel > 128u) y = -1e30f; SC[v] = y; tmax = fmaxf(tmax, y); } } \
            else { _Pragma("unroll") for (int v = 0; v < 16; ++v) { const float y = SC[v] * L2E; SC[v] = y; tmax = fmaxf(tmax, y); } } \
            tmax = fmaxf(tmax, __shfl_xor(tmax, 32)); \
            const float mnew = fmaxf(M, tmax); \
            if (__any(mnew > M)) { const float alpha = __builtin_amdgcn_exp2f(M - mnew); O[0] = O[0] * alpha; O[1] = O[1] * alpha; Lr *= alpha; M = mnew; } \
            float ps = 0.f; unsigned pk[8]; \
            _Pragma("unroll") for (int v = 0; v < 16; v += 2) { const float p0 = __builtin_amdgcn_exp2f(SC[v] - M), p1 = __builtin_amdgcn_exp2f(SC[v + 1] - M); ps += p0 + p1; pk[v >> 1] = cvtpk(p0, p1); } \
            Lr += ps; \
            P0 = __builtin_bit_cast(bf16x8, (u32x4){pk[0], pk[1], pk[2], pk[3]}); P1 = __builtin_bit_cast(bf16x8, (u32x4){pk[4], pk[5], pk[6], pk[7]}); } while (0)
        const int relA = dq + c - 4 * h - 32 * kt;
        if (useA) ATT_SOFTMAX(sa, mskA, relA, ma, la, oa, pa0, pa1);
        if (useB) ATT_SOFTMAX(sb, mskB, relA + 32, mb, lb, ob, pb0, pb1);
#undef ATT_SOFTMAX
#pragma unroll
        for (int mt = 0; mt < 2; ++mt) {
            const s16x4 a0 = vtr(trb + 64 * mt), a1 = vtr(trb + 8 * RSB + 64 * mt), a2 = vtr(trb + 16 * RSB + 64 * mt), a3 = vtr(trb + 24 * RSB + 64 * mt);
            const bf16x8 v0 = __builtin_shufflevector(a0, a1, 0, 1, 2, 3, 4, 5, 6, 7), v1 = __builtin_shufflevector(a2, a3, 0, 1, 2, 3, 4, 5, 6, 7);
            if (useA) { oa[mt] = MFMA32(v0, pa0, oa[mt]); oa[mt] = MFMA32(v1, pa1, oa[mt]); }
            if (useB) { ob[mt] = MFMA32(v0, pb0, ob[mt]); ob[mt] = MFMA32(v1, pb1, ob[mt]); }
        }
        if (more) {
#pragma unroll
            for (int s = 0; s < 4; ++s) *(LAS u32x4*)(wrb + (8 * s) * RSB) = vr[s]; }
    }
}
template <int HD>
__device__ __forceinline__ void att_store(const f32x16 (&o)[HD / 32], float lrun, const bf16_t* zrow, bf16_t* orow, int lane) {
    const int h = lane >> 5;
    const float inv = 1.0f / (lrun + __shfl_xor(lrun, 32));
#pragma unroll
    for (int mt = 0; mt < HD / 32; ++mt)
#pragma unroll
        for (int vq = 0; vq < 4; ++vq) {
            const int d = 32 * mt + 8 * vq + 4 * h;
            const u32x2 zz = *(const u32x2*)(zrow + d);
            const float z0 = __uint_as_float(zz.x << 16), z1 = __uint_as_float(zz.x & 0xffff0000u), z2 = __uint_as_float(zz.y << 16), z3 = __uint_as_float(zz.y & 0xffff0000u);
            u32x2 w; w.x = cvtpk(o[mt][4 * vq] * inv * silu_f(z0), o[mt][4 * vq + 1] * inv * silu_f(z1)); w.y = cvtpk(o[mt][4 * vq + 2] * inv * silu_f(z2), o[mt][4 * vq + 3] * inv * silu_f(z3));
            *(u32x2*)(orow + d) = w;
        }
}
constexpr int ATT_ST_OFF = 8 * 6144, ATT_ST_PITCH = 144;
template <int PHASE  >
__device__ __forceinline__ void att_merge(Frame& F, f32x16 (&o)[2], float mrun, float lrun, LAS char* strow, const bf16_t* zrow, bf16_t* orow, int lane) {
    const int h = lane >> 5;
    float lu = lrun + __shfl_xor(lrun, 32), au = 1.0f, as = 0.f, m = mrun;
    if (PHASE > 0) { const f32x2 ml = *(const LAS f32x2*)(strow + 128); m = fmaxf(ml[0], mrun); as = __builtin_amdgcn_exp2f(ml[0] - m); au = __builtin_amdgcn_exp2f(mrun - m); lu = ml[1] * as + lu * au; }
    const float inv = 1.0f / lu;
#pragma unroll
    for (int mt = 0; mt < 2; ++mt)
#pragma unroll
        for (int vq = 0; vq < 4; ++vq) {
            const int d = 32 * mt + 8 * vq + 4 * h;
            float v0 = o[mt][4 * vq] * au, v1 = o[mt][4 * vq + 1] * au, v2 = o[mt][4 * vq + 2] * au, v3 = o[mt][4 * vq + 3] * au;
            if (PHASE > 0) { const u32x2 os = *(const LAS u32x2*)(strow + 2 * d);
                v0 += __uint_as_float(os.x << 16) * as; v1 += __uint_as_float(os.x & 0xffff0000u) * as; v2 += __uint_as_float(os.y << 16) * as; v3 += __uint_as_float(os.y & 0xffff0000u) * as; }
            if (PHASE < 2) { u32x2 w; w.x = cvtpk(v0, v1); w.y = cvtpk(v2, v3); *(LAS u32x2*)(strow + 2 * d) = w; }
            else { const u32x2 zz = *(const u32x2*)(zrow + d);
                const float z0 = __uint_as_float(zz.x << 16), z1 = __uint_as_float(zz.x & 0xffff0000u), z2 = __uint_as_float(zz.y << 16), z3 = __uint_as_float(zz.y & 0xffff0000u);
                u32x2 w; w.x = cvtpk(v0 * inv * silu_f(z0), v1 * inv * silu_f(z1)); w.y = cvtpk(v2 * inv * silu_f(z2), v3 * inv * silu_f(z3)); *(u32x2*)(orow + d) = w; }
        }
    if (PHASE < 2 && h == 0) *(LAS f32x2*)(strow + 128) = (f32x2){m, lu};
}
template <int PHASE>
__device__ __forceinline__ void att_prompt_unit(Frame& F, int b, int head, int J, int u, LAS char* vl) {
    constexpr int g = 2 - PHASE, lg = 2 * g, dil = 1 << lg;
    const int lane = F.lane, c = lane & 31, h = lane >> 5;
    const int rg = PHASE == 0 ? u : (PHASE == 1 ? (u & 3) : 0), k = PHASE == 0 ? 0 : (PHASE == 1 ? (u >> 2) : u);
    const int tl = ((32 * k + c) << lg) + rg, tc = 512 * J + tl; const size_t rowc = (size_t)b * 4096 + tc;
    const int qoff = U_QKV + g * 1536 + head * 64;
    bf16x8 qf[4];
#pragma unroll
    for (int s = 0; s < 4; ++s) qf[s] = *(const bf16x8*)(F.U + rowc * LDU + qoff + 16 * s + 8 * h);
    const int qi0 = ((512 * J) >> lg) + 32 * k, ks = qi0 >= 128 ? qi0 - 128 : 0, ntiles = ((qi0 - ks) >> 5) + 1;
    const size_t kstride = (size_t)dil * LDU;
    const bf16_t* base = F.U + ((size_t)b * 4096 + (size_t)ks * dil + rg) * LDU + qoff;
    f32x16 o[2];
#pragma unroll
    for (int v = 0; v < 16; ++v) { o[0][v] = 0.f; o[1][v] = 0.f; }
    float mrun = -1e29f, lrun = 0.f;
    att_tile_range<64, true, true>(o, mrun, lrun, qf, base + 512 + (size_t)c * kstride + 8 * h, base + 1024 + (size_t)(lane >> 3) * kstride + (lane & 7) * 8, kstride, ntiles, qi0 + c - ks - 4 * h, L2E, vl, lane);
    att_merge<PHASE>(F, o, mrun, lrun, (LAS char*)F.lds + ATT_ST_OFF + tl * ATT_ST_PITCH, F.U + rowc * LDU + U_ZA + head * 64, F.ACAT + rowc * LDA + 1024 + head * 64, lane);
}
template <int PHASE>
__device__ __forceinline__ void att_prompt_pair(Frame& F, int b, int head, int J, int u, LAS char* vl) {
    constexpr int g = 2 - PHASE, lg = 2 * g, dil = 1 << lg;
    const int lane = F.lane, c = lane & 31, h = lane >> 5;
    const int rg = PHASE == 1 ? (u & 3) : 0, kpair = PHASE == 1 ? (u >> 2) : u;
    const int tlA = ((64 * kpair + c) << lg) + rg, tlB = ((64 * kpair + 32 + c) << lg) + rg;
    const size_t rowA = (size_t)b * 4096 + 512 * J + tlA, rowB = (size_t)b * 4096 + 512 * J + tlB;
    const int qoff = U_QKV + g * 1536 + head * 64;
    bf16x8 qa[4], qb[4];
#pragma unroll
    for (int s = 0; s < 4; ++s) { qa[s] = *(const bf16x8*)(F.U + rowA * LDU + qoff + 16 * s + 8 * h); qb[s] = *(const bf16x8*)(F.U + rowB * LDU + qoff + 16 * s + 8 * h); }
    const int qi0 = ((512 * J) >> lg) + 64 * kpair, ks = qi0 >= 128 ? qi0 - 128 : 0, ntiles = ((qi0 + 32 - ks) >> 5) + 1;
    const size_t kstride = (size_t)dil * LDU;
    const bf16_t* base = F.U + ((size_t)b * 4096 + (size_t)ks * dil + rg) * LDU + qoff;
    f32x16 oa[2], ob[2];
#pragma unroll
    for (int v = 0; v < 16; ++v) { oa[0][v] = 0.f; oa[1][v] = 0.f; ob[0][v] = 0.f; ob[1][v] = 0.f; }
    float ma = -1e29f, la = 0.f, mb = -1e29f, lb = 0.f;
    att_tile_pair(oa, ob, ma, la, mb, lb, qa, qb, base + 512 + (size_t)c * kstride + 8 * h, base + 1024 + (size_t)(lane >> 3) * kstride + (lane & 7) * 8, kstride, ntiles, qi0 - ks, vl, lane);
    att_merge<PHASE>(F, oa, ma, la, (LAS char*)F.lds + ATT_ST_OFF + tlA * ATT_ST_PITCH, F.U + rowA * LDU + U_ZA + head * 64, F.ACAT + rowA * LDA + 1024 + head * 64, lane);
    att_merge<PHASE>(F, ob, mb, lb, (LAS char*)F.lds + ATT_ST_OFF + tlB * ATT_ST_PITCH, F.U + rowB * LDU + U_ZA + head * 64, F.ACAT + rowB * LDA + 1024 + head * 64, lane);
}
__device__ __forceinline__ void att_prompt_item(Frame& F, int b, int head, int J, LAS char* vl) {
#pragma unroll 1
    for (int u = 2 * F.wave; u < 2 * F.wave + 2; ++u) att_prompt_unit<0>(F, b, head, J, u, vl);
    __syncthreads();
    att_prompt_pair<1>(F, b, head, J, F.wave, vl);
    __syncthreads();
    att_prompt_pair<2>(F, b, head, J, F.wave, vl);
}
__device__ __forceinline__ void mem_prompt_item(Frame& F, int b, int head, int q0) {
    constexpr int KP = 272, VP = 320, STG = 32 * KP + 32 * VP;
    const int tid = F.tid, lane = F.lane, w = F.wave, c = lane & 31, h = lane >> 5;
    LAS char* L = (LAS char*)F.lds;
    const size_t rowc = (size_t)b * 4096 + q0 + 32 * w + c;
    bf16x8 qf[8];
#pragma unroll
    for (int s = 0; s < 8; ++s) qf[s] = *(const bf16x8*)(F.U + rowc * LDU + U_QM + head * 128 + 16 * s + 8 * h);
    const int pr = tid >> 4, pc = tid & 15;
    const bf16_t* ksrc = F.MKV + ((size_t)b * 256 + pr) * 1024 + head * 128 + 8 * pc;
    LAS char* kdst = L + pr * KP + 16 * pc; LAS char* vdst = L + 32 * KP + pr * VP + 16 * pc;
    f32x16 o[4];
#pragma unroll
    for (int v = 0; v < 16; ++v) { o[0][v] = 0.f; o[1][v] = 0.f; o[2][v] = 0.f; o[3][v] = 0.f; }
    float mrun = -1e29f, lrun = 0.f;
    const float sl2e = 0.08838834764831845f * L2E;
    u32x4 ka, va, kb, vb;
    ka = *(const u32x4*)ksrc; va = *(const u32x4*)(ksrc + 512);
    kb = *(const u32x4*)(ksrc + 32 * 1024); vb = *(const u32x4*)(ksrc + 32 * 1024 + 512);
    *(LAS u32x4*)kdst = ka; *(LAS u32x4*)vdst = va;
    __syncthreads();
    const LAS char* krd = L + c * KP + 16 * h;
    const LAS char* trb = L + 32 * KP + (4 * h + ((lane & 15) >> 2)) * VP + 32 * ((lane >> 4) & 1) + 8 * (lane & 3);
#define MEM_STEP(RN, RW_K, RW_V) do { const int so = (kt & 1) * STG; \
        if (kt + 2 < 8) { RN##a_ = *(const u32x4*)(ksrc + (size_t)(kt + 2) * 32 * 1024); RN##b_ = *(const u32x4*)(ksrc + (size_t)(kt + 2) * 32 * 1024 + 512); } \
        f32x16 sc; \
        _Pragma("unroll") for (int v = 0; v < 16; ++v) sc[v] = 0.f; \
        _Pragma("unroll") for (int s = 0; s < 8; ++s) { const bf16x8 kf = *(const LAS bf16x8*)(krd + so + 32 * s); sc = MFMA32(kf, qf[s], sc); } \
        float tmax = -1e30f; \
        _Pragma("unroll") for (int v = 0; v < 16; ++v) { const float y = sc[v] * sl2e; sc[v] = y; tmax = fmaxf(tmax, y); } \
        tmax = fmaxf(tmax, __shfl_xor(tmax, 32)); \
        const float mnew = fmaxf(mrun, tmax); \
        if (__any(mnew > mrun)) { const float alpha = __builtin_amdgcn_exp2f(mrun - mnew); \
            _Pragma("unroll") for (int mt = 0; mt < 4; ++mt) o[mt] = o[mt] * alpha; \
            lrun *= alpha; mrun = mnew; } \
        float ps = 0.f; unsigned pk[8]; \
        _Pragma("unroll") for (int v = 0; v < 16; v += 2) { const float p0 = __builtin_amdgcn_exp2f(sc[v] - mrun), p1 = __builtin_amdgcn_exp2f(sc[v + 1] - mrun); ps += p0 + p1; pk[v >> 1] = cvtpk(p0, p1); } \
        lrun += ps; \
        const bf16x8 pf0 = __builtin_bit_cast(bf16x8, (u32x4){pk[0], pk[1], pk[2], pk[3]}), pf1 = __builtin_bit_cast(bf16x8, (u32x4){pk[4], pk[5], pk[6], pk[7]}); \
        _Pragma("unroll") for (int mt = 0; mt < 4; ++mt) { \
            const s16x4 a0 = vtr(trb + so + 64 * mt), a1 = vtr(trb + so + 8 * VP + 64 * mt), a2 = vtr(trb + so + 16 * VP + 64 * mt), a3 = vtr(trb + so + 24 * VP + 64 * mt); \
            o[mt] = MFMA32(__builtin_shufflevector(a0, a1, 0, 1, 2, 3, 4, 5, 6, 7), pf0, o[mt]); \
            o[mt] = MFMA32(__builtin_shufflevector(a2, a3, 0, 1, 2, 3, 4, 5, 6, 7), pf1, o[mt]); } \
        if (kt + 1 < 8) { *(LAS u32x4*)(kdst + (STG - so)) = RW_K; *(LAS u32x4*)(vdst + (STG - so)) = RW_V; } \
        __syncthreads(); } while (0)
    u32x4 Aa_, Ab_, Ba_, Bb_;
    Ba_ = kb; Bb_ = vb;
#pragma unroll 1
    for (int kt = 0; kt < 8; kt += 2) {
        MEM_STEP(A, Ba_, Bb_);
        { const int kt_ = kt; (void)kt_; }
        { int ktn = kt + 1; const int kt = ktn; MEM_STEP(B, Aa_, Ab_); }
    }
#undef MEM_STEP
    att_store<128>(o, lrun, F.U + rowc * LDU + U_ZM + head * 128, F.ACAT + rowc * LDA + 1536 + head * 128, lane);
}
__device__ __forceinline__ void ssd_prompt_unit(Frame& F, int b, int h) {
    constexpr int XP = 192, BP = 320, CP = 272, IMG = 2 * 64 * XP + 64 * BP  , XWO = 64 * XP, BIO = 2 * 64 * XP, S0 = 2 * IMG, S1 = S0 + 64 * CP, ARR = S1 + 64 * CP;
    const int tid = F.tid, lane = F.lane, w = F.wave, g = h >> 2, c32 = lane & 31, hh = lane >> 5;
    LAS char* L = (LAS char*)F.lds;
    for (int idx = tid; idx < 64 * CP / 4; idx += NTHREADS) ((LAS unsigned*)(L + S0))[idx] = 0u;
    const float a = -__expf(F.a_log[h]), dsk = F.d_skip[h], dtb = F.dt_bias[h];
    const size_t row0 = (size_t)b * 4096;
    const int xr = tid >> 3, xc8 = tid & 7, br = tid >> 4, bc8 = tid & 15;
    const bf16_t* xsrc = F.XC + (row0 + xr) * 2048 + h * 64 + 8 * xc8;
    const bf16_t* bsrc = F.XC + (row0 + br) * 2048 + 1024 + g * 128 + 8 * bc8;
    const bf16_t* csrc = F.XC + row0 * 2048 + 1536 + g * 128 + 8 * hh;
    const int pt = (w >> 1) & 1, j = w & 1;
    const int pt2 = (w >> 1) & 1, ntb = 2 * (w & 1);
    const int q4 = (lane & 15) >> 2, p4 = lane & 3, blk = (lane >> 4) & 1;
    u32x4 rx, rb0, rb1; float dtraw; bf16x8 cf[8];
#define SSD_LOAD(cc) do { const size_t ro = (size_t)(64 * (cc)) * 2048; rx = *(const u32x4*)(xsrc + ro); rb0 = *(const u32x4*)(bsrc + ro); rb1 = *(const u32x4*)(bsrc + ro + 32 * 2048); \
        dtraw = F.DT[(row0 + 64 * (cc) + lane) * 16 + h]; \
        if (w < 4) { _Pragma("unroll") for (int ks = 0; ks < 8; ++ks) cf[ks] = *(const bf16x8*)(csrc + ro + (size_t)(32 * j + c32) * 2048 + 16 * ks); } } while (0)
#define SSD_PREP(cc) do { LAS float* arr_ = (LAS float*)(L + ARR + ((cc) & 1) * 1024); LAS char* I_ = L + ((cc) & 1) * IMG; \
        const float xx = dtraw + dtb; const float dt = xx > 20.f ? xx : log1pf(__expf(xx)); \
        float acs = dt * a; \
        _Pragma("unroll") for (int o = 1; o < 64; o <<= 1) { const float up = __shfl_up(acs, o); if (lane >= o) acs += up; } \
        const float last = __shfl(acs, 63); const float wd = dt * __expf(last - acs); \
        arr_[lane] = acs * L2E; arr_[64 + lane] = (acs - __logf(dt)) * L2E; arr_[128 + lane] = __expf(acs); \
        const float wdx = __shfl(wd, xr); \
        *(LAS u32x4*)(I_ + xr * XP + 16 * xc8) = rx; \
        { u32x4 o_; o_.x = cvtpk(__uint_as_float(rx.x << 16) * wdx, __uint_as_float(rx.x & 0xffff0000u) * wdx); o_.y = cvtpk(__uint_as_float(rx.y << 16) * wdx, __uint_as_float(rx.y & 0xffff0000u) * wdx); \
          o_.z = cvtpk(__uint_as_float(rx.z << 16) * wdx, __uint_as_float(rx.z & 0xffff0000u) * wdx); o_.w = cvtpk(__uint_as_float(rx.w << 16) * wdx, __uint_as_float(rx.w & 0xffff0000u) * wdx); \
          *(LAS u32x4*)(I_ + XWO + xr * XP + 16 * xc8) = o_; } \
        *(LAS u32x4*)(I_ + BIO + br * BP + 16 * bc8) = rb0; *(LAS u32x4*)(I_ + BIO + (32 + br) * BP + 16 * bc8) = rb1; } while (0)
    SSD_LOAD(0);
    f32x16 st0, st1;
#pragma unroll
    for (int v = 0; v < 16; ++v) { st0[v] = 0.f; st1[v] = 0.f; }
    bf16x8 cc_[8];
    SSD_PREP(0);
#pragma unroll
    for (int ks = 0; ks < 8; ++ks) cc_[ks] = cf[ks];
    __syncthreads();
#pragma unroll 1
    for (int c = 0; c < 64; ++c) {
        const LAS float* arr = (const LAS float*)(L + ARR + (c & 1) * 1024);
        const LAS char* I = L + (c & 1) * IMG;
        const LAS char* Scur = L + ((c & 1) ? S1 : S0); LAS char* Snxt = L + ((c & 1) ? S0 : S1);
        if (c + 1 < 64) SSD_LOAD(c + 1);
        if (w < 4) {
            const int l = 32 * j + c32; const size_t row = row0 + 64 * c + l;
            u32x2 zz[4];
#pragma unroll
            for (int vq = 0; vq < 4; ++vq) zz[vq] = *(const u32x2*)(F.U + row * LDU + U_Z + h * 64 + 32 * pt + 8 * vq + 4 * hh);
            f32x16 acc;
#pragma unroll
            for (int v = 0; v < 16; ++v) acc[v] = 0.f;
#pragma unroll
            for (int ks = 0; ks < 8; ++ks) { const bf16x8 sa = *(const LAS bf16x8*)(Scur + (32 * pt + c32) * CP + (16 * ks + 8 * hh) * 2); acc = MFMA32(sa, cc_[ks], acc); }
            const float al = arr[l];
            acc = acc * arr[128 + l];
#pragma unroll 1
            for (int i = 0; i <= j; ++i) {
                f32x16 cb;
#pragma unroll
                for (int v = 0; v < 16; ++v) cb[v] = 0.f;
#pragma unroll
                for (int ks = 0; ks < 8; ++ks) { const bf16x8 ba = *(const LAS bf16x8*)(I + BIO + (32 * i + c32) * BP + (16 * ks + 8 * hh) * 2); cb = MFMA32(ba, cc_[ks], cb); }
                unsigned pk[8];
#pragma unroll
                for (int vq = 0; vq < 4; ++vq) {
                    const f32x4 es = *(const LAS f32x4*)(arr + 64 + 32 * i + 8 * vq + 4 * hh);
                    float m[4];
#pragma unroll
                    for (int e = 0; e < 4; ++e) { m[e] = cb[4 * vq + e] * __builtin_amdgcn_exp2f(al - es[e]); if (i == j && (8 * vq + 4 * hh + e) > c32) m[e] = 0.f; }
                    pk[2 * vq] = cvtpk(m[0], m[1]); pk[2 * vq + 1] = cvtpk(m[2], m[3]);
                }
                const bf16x8 pf0 = __builtin_bit_cast(bf16x8, (u32x4){pk[0], pk[1], pk[2], pk[3]}), pf1 = __builtin_bit_cast(bf16x8, (u32x4){pk[4], pk[5], pk[6], pk[7]});
                const LAS char* xb = I + (32 * i + 4 * hh + q4) * XP + (32 * pt + 16 * blk + 4 * p4) * 2;
                const s16x4 a0 = vtr(xb), a1 = vtr(xb + 8 * XP), a2 = vtr(xb + 16 * XP), a3 = vtr(xb + 24 * XP);
                acc = MFMA32(__builtin_shufflevector(a0, a1, 0, 1, 2, 3, 4, 5, 6, 7), pf0, acc);
                acc = MFMA32(__builtin_shufflevector(a2, a3, 0, 1, 2, 3, 4, 5, 6, 7), pf1, acc);
            }
            float ssq = 0.f;
#pragma unroll
            for (int vq = 0; vq < 4; ++vq) {
                const int p = 32 * pt + 8 * vq + 4 * hh;
                const u32x2 xs = *(const LAS u32x2*)(I + l * XP + p * 2);
                const float x0 = __uint_as_float(xs.x << 16), x1 = __uint_as_float(xs.x & 0xffff0000u), x2 = __uint_as_float(xs.y << 16), x3 = __uint_as_float(xs.y & 0xffff0000u);
                const float z0 = __uint_as_float(zz[vq].x << 16), z1 = __uint_as_float(zz[vq].x & 0xffff0000u), z2 = __uint_as_float(zz[vq].y << 16), z3 = __uint_as_float(zz[vq].y & 0xffff0000u);
                const float v0 = (acc[4 * vq] + dsk * x0) * silu_f(z0), v1 = (acc[4 * vq + 1] + dsk * x1) * silu_f(z1), v2 = (acc[4 * vq + 2] + dsk * x2) * silu_f(z2), v3 = (acc[4 * vq + 3] + dsk * x3) * silu_f(z3);
                ssq += (v0 * v0 + v1 * v1) + (v2 * v2 + v3 * v3);
                u32x2 o; o.x = cvtpk(v0, v1); o.y = cvtpk(v2, v3);
                *(u32x2*)(F.ACAT + row * LDA + h * 64 + p) = o;
            }
            ssq += __shfl_xor(ssq, 32);
            if (hh == 0) F.SSQ[row * 32 + 2 * h + pt] = ssq;
        } else {
            const float dec = arr[128 + 63];
            st0 = st0 * dec; st1 = st1 * dec;
            const LAS char* bb = I + BIO + (8 * hh + q4) * BP + (32 * ntb + 16 * blk + 4 * p4) * 2;
            const LAS char* xw = I + XWO + (8 * hh + q4) * XP + (32 * pt2 + 16 * blk + 4 * p4) * 2;
#pragma unroll
            for (int ks = 0; ks < 4; ++ks) {
                const s16x4 x0 = vtr(xw + 16 * ks * XP), x1 = vtr(xw + (16 * ks + 4) * XP);
                const bf16x8 xf = __builtin_shufflevector(x0, x1, 0, 1, 2, 3, 4, 5, 6, 7);
                const s16x4 b0 = vtr(bb + 16 * ks * BP), b1 = vtr(bb + (16 * ks + 4) * BP), b2 = vtr(bb + 16 * ks * BP + 64), b3 = vtr(bb + (16 * ks + 4) * BP + 64);
                st0 = MFMA32(__builtin_shufflevector(b0, b1, 0, 1, 2, 3, 4, 5, 6, 7), xf, st0);
                st1 = MFMA32(__builtin_shufflevector(b2, b3, 0, 1, 2, 3, 4, 5, 6, 7), xf, st1);
            }
#pragma unroll
            for (int vq = 0; vq < 4; ++vq) { u32x2 o; o.x = cvtpk(st0[4 * vq], st0[4 * vq + 1]); o.y = cvtpk(st0[4 * vq + 2], st0[4 * vq + 3]);
                *(LAS u32x2*)(Snxt + (32 * pt2 + c32) * CP + (32 * ntb + 8 * vq + 4 * hh) * 2) = o;
                o.x = cvtpk(st1[4 * vq], st1[4 * vq + 1]); o.y = cvtpk(st1[4 * vq + 2], st1[4 * vq + 3]);
                *(LAS u32x2*)(Snxt + (32 * pt2 + c32) * CP + (32 * (ntb + 1) + 8 * vq + 4 * hh) * 2) = o; }
        }
        if (c + 1 < 64) { SSD_PREP(c + 1);
#pragma unroll
            for (int ks = 0; ks < 8; ++ks) cc_[ks] = cf[ks]; }
        __syncthreads();
    }
#undef SSD_LOAD
#undef SSD_PREP
    if (w >= 4) {
        float* sout = F.out + O_PSSM + ((size_t)(b * 16 + h) * 64 + 32 * pt2 + c32) * 128 + 32 * ntb + 4 * hh;
#pragma unroll
        for (int vq = 0; vq < 4; ++vq) { *(f32x4*)(sout + 8 * vq) = (f32x4){st0[4 * vq], st0[4 * vq + 1], st0[4 * vq + 2], st0[4 * vq + 3]};
            *(f32x4*)(sout + 32 + 8 * vq) = (f32x4){st1[4 * vq], st1[4 * vq + 1], st1[4 * vq + 2], st1[4 * vq + 3]}; }
    }
}

__device__ __forceinline__ void mini_mma(f32x16& acc, const bf16_t* wrow, const bf16_t* arow, int nks) {
#pragma unroll 8
    for (int s = 0; s < nks; ++s) acc = MFMA32(*(const bf16x8*)(wrow + 16 * s), *(const bf16x8*)(arow + 16 * s), acc);
}
__device__ __forceinline__ void p3_sample_item(Frame& F, int it) {
    const int lane = F.lane, w = F.wave, c = lane & 31, h = lane >> 5, rb = it >> 5, cb = it & 31;
    const size_t row = (size_t)RP + 32 * rb + c;
    LAS float* red = (LAS float*)F.lds;
    f32x16 a;
#pragma unroll
    for (int v = 0; v < 16; ++v) a[v] = 0.f;
    {   const bf16_t* ar = F.ACAT + row * LDA + 256 * w + 8 * h; const bf16_t* wr_ = F.WbrT + (size_t)(32 * cb + c) * 2048 + 256 * w + 8 * h;
        bf16x8 af[16], wf[16];
#pragma unroll
        for (int s = 0; s < 16; ++s) { af[s] = *(const bf16x8*)(ar + 16 * s); wf[s] = *(const bf16x8*)(wr_ + 16 * s); }
#pragma unroll
        for (int s = 0; s < 16; ++s) a = MFMA32(wf[s], af[s], a); }
#pragma unroll
    for (int v = 0; v < 16; ++v) red[(w * 16 + v) * 64 + lane] = a[v];
    __syncthreads();
    if (w < 4) {
        const int vq = w;
        float sq = 0.f;
#pragma unroll
        for (int k = 0; k < 8; ++k) { const f32x4 q = *(const f32x4*)(F.SSQ + row * 32 + 4 * k); sq += (q[0] + q[1]) + (q[2] + q[3]); }
        const float rs = 1.0f / sqrtf(sq * (1.0f / 1024.0f) + EPS);
        const int n = 32 * cb + 8 * vq + 4 * h;
        const bf16_t* gp = F.U + row * LDU + U_GATE + n;
        const u32x2 g0 = *(const u32x2*)gp, g1 = *(const u32x2*)(gp + 1024), g2 = *(const u32x2*)(gp + 2048);
        float o[4];
#pragma unroll
        for (int e = 0; e < 4; ++e) {
            const int v = 4 * vq + e;
            const float a0 = (red[(0 * 16 + v) * 64 + lane] + red[(1 * 16 + v) * 64 + lane]) + (red[(2 * 16 + v) * 64 + lane] + red[(3 * 16 + v) * 64 + lane]);
            const float a1 = red[(4 * 16 + v) * 64 + lane] + red[(5 * 16 + v) * 64 + lane], a2 = red[(6 * 16 + v) * 64 + lane] + red[(7 * 16 + v) * 64 + lane];
            const float x0 = __uint_as_float((e & 1) ? ((e >> 1 ? g0.y : g0.x) & 0xffff0000u) : ((e >> 1 ? g0.y : g0.x) << 16));
            const float x1 = __uint_as_float((e & 1) ? ((e >> 1 ? g1.y : g1.x) & 0xffff0000u) : ((e >> 1 ? g1.y : g1.x) << 16));
            const float x2 = __uint_as_float((e & 1) ? ((e >> 1 ? g2.y : g2.x) & 0xffff0000u) : ((e >> 1 ? g2.y : g2.x) << 16));
            const float s0 = 1.0f / (1.0f + __expf(-x0)), s1 = 1.0f / (1.0f + __expf(-x1)), s2 = 1.0f / (1.0f + __expf(-x2));
            o[e] = s0 * rs * a0 + s1 * a1 + s2 * a2;
        }
        u32x2 wv; wv.x = cvtpk(o[0], o[1]); wv.y = cvtpk(o[2], o[3]);
        *(u32x2*)(F.MERGED + row * 1024 + n) = wv;
    }
    __syncthreads();
}
__device__ __forceinline__ void p4_sample_item(Frame& F, int it) {
    const int lane = F.lane, w = F.wave, c = lane & 31, h = lane >> 5, rb = it >> 4, cb = it & 15;
    const size_t srow = (size_t)32 * rb + c, row = (size_t)RP + srow;
    LAS float* red = (LAS float*)F.lds;
    f32x16 a0, a1;
#pragma unroll
    for (int v = 0; v < 16; ++v) { a0[v] = 0.f; a1[v] = 0.f; }
    {   const bf16_t* ar = F.MERGED + row * 1024 + 128 * w + 8 * h; const bf16_t* w0 = F.WoutT + (size_t)(64 * cb + c) * 1024 + 128 * w + 8 * h;
        bf16x8 af[8], wf[8], wg[8];
#pragma unroll
        for (int s = 0; s < 8; ++s) { af[s] = *(const bf16x8*)(ar + 16 * s); wf[s] = *(const bf16x8*)(w0 + 16 * s); wg[s] = *(const bf16x8*)(w0 + 32 * 1024 + 16 * s); }
#pragma unroll
        for (int s = 0; s < 8; ++s) { a0 = MFMA32(wf[s], af[s], a0); a1 = MFMA32(wg[s], af[s], a1); } }
#pragma unroll
    for (int v = 0; v < 16; ++v) { red[(w * 32 + v) * 64 + lane] = a0[v]; red[(w * 32 + 16 + v) * 64 + lane] = a1[v]; }
    __syncthreads();
    const int t = w >> 2, vq = w & 3, n = 64 * cb + 32 * t + 8 * vq + 4 * h;
    const f32x4 x = *(const f32x4*)(F.xs + srow * 1024 + n);
    f32x4 r;
#pragma unroll
    for (int e = 0; e < 4; ++e) { const int v = 16 * t + 4 * vq + e; float sacc = 0.f;
#pragma unroll
        for (int k = 0; k < 8; ++k) sacc += red[(k * 32 + v) * 64 + lane];
        r[e] = x[e] + sacc; }
    *(f32x4*)(F.out + row * 1024 + n) = r;
    float ssq = (r[0] * r[0] + r[1] * r[1]) + (r[2] * r[2] + r[3] * r[3]);
    ssq += __shfl_xor(ssq, 32);
    __syncthreads();
    if (h == 0) red[w * 32 + c] = ssq;
    __syncthreads();
    if (w == 0 && h == 0) { float sacc = 0.f;
#pragma unroll
        for (int k = 0; k < 8; ++k) sacc += red[k * 32 + c];
        F.RSQ[row * 16 + cb] = sacc; }
    __syncthreads();
}
__device__ __forceinline__ void att_sample_wave(Frame& F, int srow, int head, LAS float* qs) {
    const int lane = F.lane, t = srow & 3, b = srow >> 2; const size_t row = (size_t)RP + srow;
    LAS float* sb = qs + 128;
    const int dq = lane & 15, rs = lane >> 4;
    float mrun = -1e30f, lrun = 0.f; f32x4 o = (f32x4){0.f, 0.f, 0.f, 0.f};
#pragma unroll
    for (int g = 0; g < 3; ++g) {
        const int dil = g == 0 ? 1 : (g == 1 ? 4 : 16), W = 128 * dil;
        const float* cache = (g == 0 ? F.cw128 : (g == 1 ? F.cw512 : F.cw2048)) + (size_t)b * W * 1024 + head * 64;
        const int qoff = U_QKV + g * 1536 + head * 64;
        const int jn = g == 0 ? t + 1 : 1, ncache = 129 - jn;
        LDS_WAIT(); asm volatile("" ::: "memory");
        qs[lane] = bf2f(F.U[row * LDU + qoff + lane]);
        LDS_WAIT(); asm volatile("" ::: "memory");
        float lm = -1e30f;
        if (lane < 4) { float sn = -1e30f; if (lane < jn) sn = dot64_bf16(F.U + (size_t)(RP + b * 4 + t - dil * lane) * LDU + qoff + 512, qs); sb[lane] = sn; lm = sn; }
#pragma unroll 1
        for (int p = 0; p < 2; ++p) { const int jj = p * 64 + lane; float s = -1e30f;
            if (jj < ncache) s = dot64_f32(cache + (size_t)(W + t - dil * (jn + jj)) * 1024, qs);
            sb[4 + jj] = s; lm = fmaxf(lm, s); }
        const float gm = wave_max(lm);
        const float mnew = fmaxf(mrun, gm), fsc = __expf(mrun - mnew);
        float ps = 0.f;
#pragma unroll 1
        for (int p = 0; p < 3; ++p) { const int k = p * 64 + lane; if (k < 132) { const float s = sb[k]; const float pr = s > -1e29f ? __expf(s - mnew) : 0.f; sb[k] = pr; ps += pr; } }
        lrun = lrun * fsc + wave_sum(ps); o = o * fsc; mrun = mnew;
        LDS_WAIT(); asm volatile("" ::: "memory");
        if (rs < jn) { const u32x2 vv = *(const u32x2*)(F.U + (size_t)(RP + b * 4 + t - dil * rs) * LDU + qoff + 1024 + 4 * dq); const float pj = sb[rs];
            o += pj * (f32x4){__uint_as_float(vv.x << 16), __uint_as_float(vv.x & 0xffff0000u), __uint_as_float(vv.y << 16), __uint_as_float(vv.y & 0xffff0000u)}; }
        const float* vbase = cache + 512 + 4 * dq;
#pragma unroll 1
        for (int j0 = 0; j0 < 128; j0 += 64) {
            f32x4 vv[16];
#pragma unroll
            for (int u = 0; u < 16; ++u) { int jj = j0 + 4 * u + rs; jj = jj < ncache ? jj : ncache - 1; vv[u] = *(const f32x4*)(vbase + (size_t)(W + t - dil * (jn + jj)) * 1024); }
#pragma unroll
            for (int u = 0; u < 16; ++u) o += sb[4 + j0 + 4 * u + rs] * vv[u];
        }
    }
#pragma unroll
    for (int e = 0; e < 4; ++e) { o[e] += __shfl_xor(o[e], 16); o[e] += __shfl_xor(o[e], 32); }
    if (rs == 0) { const u32x2 zz = *(const u32x2*)(F.U + row * LDU + U_ZA + head * 64 + 4 * dq); const float inv = 1.0f / lrun;
        u32x2 w; w.x = pk2(o[0] * inv * silu_f(__uint_as_float(zz.x << 16)), o[1] * inv * silu_f(__uint_as_float(zz.x & 0xffff0000u)));
        w.y = pk2(o[2] * inv * silu_f(__uint_as_float(zz.y << 16)), o[3] * inv * silu_f(__uint_as_float(zz.y & 0xffff0000u)));
        *(u32x2*)(F.ACAT + row * LDA + 1024 + head * 64 + 4 * dq) = w; }
}
__device__ __forceinline__ void mem_sample_wave(Frame& F, int srow, int head, LAS float* qs) {
    const int lane = F.lane, b = srow >> 2; const size_t row = (size_t)RP + srow;
    LAS float* sb = qs + 128;
    const float* cache = F.cmem + (size_t)b * 256 * 1024 + head * 128;
    LDS_WAIT(); asm volatile("" ::: "memory");
    qs[lane] = bf2f(F.U[row * LDU + U_QM + head * 128 + lane]) * 0.08838834764831845f;
    qs[lane + 64] = bf2f(F.U[row * LDU + U_QM + head * 128 + 64 + lane]) * 0.08838834764831845f;
    LDS_WAIT(); asm volatile("" ::: "memory");
    float lm = -1e30f;
#pragma unroll 1
    for (int p = 0; p < 4; ++p) { const int m = p * 64 + lane; const float* kp = cache + (size_t)m * 1024;
        float s = 0.f;
#pragma unroll
        for (int hf = 0; hf < 2; ++hf) { f32x4 kk[16];
#pragma unroll
            for (int cc = 0; cc < 16; ++cc) kk[cc] = *(const f32x4*)(kp + 64 * hf + 4 * cc);
#pragma unroll
            for (int cc = 0; cc < 16; ++cc) { const f32x4 q0 = *(const LAS f32x4*)(qs + 64 * hf + 4 * cc); s += kk[cc][0] * q0[0] + kk[cc][1] * q0[1] + kk[cc][2] * q0[2] + kk[cc][3] * q0[3]; } }
        sb[m] = s; lm = fmaxf(lm, s); }
    const float gm = wave_max(lm);
    float ps = 0.f;
#pragma unroll 1
    for (int p = 0; p < 4; ++p) { const float pr = __expf(sb[p * 64 + lane] - gm); sb[p * 64 + lane] = pr; ps += pr; }
    const float l = wave_sum(ps);
    LDS_WAIT(); asm volatile("" ::: "memory");
    const int dq = lane & 31, rs = lane >> 5;
    f32x4 o = (f32x4){0.f, 0.f, 0.f, 0.f};
    const float* vbase = cache + 512 + 4 * dq;
#pragma unroll 1
    for (int m0 = 0; m0 < 256; m0 += 32) {
        f32x4 vv[16];
#pragma unroll
        for (int u = 0; u < 16; ++u) vv[u] = *(const f32x4*)(vbase + (size_t)(m0 + 2 * u + rs) * 1024);
#pragma unroll
        for (int u = 0; u < 16; ++u) o += sb[m0 + 2 * u + rs] * vv[u];
    }
#pragma unroll
    for (int e = 0; e < 4; ++e) o[e] += __shfl_xor(o[e], 32);
    if (rs == 0) { const u32x2 zz = *(const u32x2*)(F.U + row * LDU + U_ZM + head * 128 + 4 * dq); const float inv = 1.0f / l;
        u32x2 w; w.x = pk2(o[0] * inv * silu_f(__uint_as_float(zz.x << 16)), o[1] * inv * silu_f(__uint_as_float(zz.x & 0xffff0000u)));
        w.y = pk2(o[2] * inv * silu_f(__uint_as_float(zz.y << 16)), o[3] * inv * silu_f(__uint_as_float(zz.y & 0xffff0000u)));
        *(u32x2*)(F.ACAT + row * LDA + 1536 + head * 128 + 4 * dq) = w; }
}
__device__ __forceinline__ void ssd_naive_unit(Frame& F, bool samp, int b, int h) {
    const int tid = F.tid, lane = F.lane, wave = F.wave;
    const int T = samp ? 4 : 4096, row0 = samp ? RP + b * 4 : b * 4096, g = h >> 2;
    constexpr int CH = 64;
    LAS float* xc = (LAS float*)F.lds;
    LAS float* dtv = xc + CH * 320;
    LAS float* ybuf = dtv + CH;
    const int p = tid >> 3, nq = tid & 7;
    float st[16];
    float* sout = F.out + (samp ? O_SSSM : O_PSSM) + ((size_t)(b * 16 + h) * 64 + p) * 128 + nq * 16;
    if (samp) { const float* sp = F.sssm + ((size_t)(b * 16 + h) * 64 + p) * 128 + nq * 16;
#pragma unroll
        for (int i = 0; i < 4; ++i) { const f32x4 v = *(const f32x4*)(sp + 4 * i); st[4 * i] = v[0]; st[4 * i + 1] = v[1]; st[4 * i + 2] = v[2]; st[4 * i + 3] = v[3]; } }
    else {
#pragma unroll
        for (int i = 0; i < 16; ++i) st[i] = 0.f; }
    const float a = -__expf(F.a_log[h]), dsk = F.d_skip[h], dtb = F.dt_bias[h];
#pragma unroll 1
    for (int t0 = 0; t0 < T; t0 += CH) {
        const int nst = (T - t0) < CH ? (T - t0) : CH;
        for (int idx = tid; idx < nst * 320; idx += NTHREADS) {
            const int s = idx / 320, c = idx - s * 320;
            const int ch = c < 64 ? h * 64 + c : (c < 192 ? 1024 + g * 128 + (c - 64) : 1536 + g * 128 + (c - 192));
            xc[s * 320 + c] = bf2f(F.XC[(size_t)(row0 + t0 + s) * 2048 + ch - 0]);
        }
        if (tid < nst) { const float x = F.DT[(size_t)(row0 + t0 + tid) * 16 + h] + dtb; dtv[tid] = x > 20.f ? x : log1pf(__expf(x)); }
        __syncthreads();
#pragma unroll 1
        for (int s = 0; s < nst; ++s) {
            const float dt = dtv[s], dA = __expf(dt * a), xv = xc[s * 320 + p], dtx = dt * xv;
            const LAS f32x4* Bp = (const LAS f32x4*)(xc + s * 320 + 64 + nq * 16); const LAS f32x4* Cp = (const LAS f32x4*)(xc + s * 320 + 192 + nq * 16);
            float y = 0.f;
#pragma unroll
            for (int i = 0; i < 4; ++i) { const f32x4 bv = Bp[i], cv = Cp[i];
#pragma unroll
                for (int e = 0; e < 4; ++e) { st[4 * i + e] = st[4 * i + e] * dA + dtx * bv[e]; y += cv[e] * st[4 * i + e]; } }
            y += __shfl_xor(y, 1); y += __shfl_xor(y, 2); y += __shfl_xor(y, 4);
            if (nq == 0) ybuf[s * 64 + p] = y + dsk * xv;
        }
        __syncthreads();
        for (int s = wave; s < nst; s += NWAVES) {
            const int row = row0 + t0 + s;
            const float z = bf2f(F.U[(size_t)row * LDU + U_Z + h * 64 + lane]);
            const float v = ybuf[s * 64 + lane] * silu_f(z);
            F.ACAT[(size_t)row * LDA + h * 64 + lane] = (bf16_t)f2bf(v);
            const float q = wave_sum(v * v);
            if (lane == 0) { F.SSQ[(size_t)row * 32 + 2 * h] = q; F.SSQ[(size_t)row * 32 + 2 * h + 1] = 0.f; }
        }
        __syncthreads();
    }
#pragma unroll
    for (int i = 0; i < 4; ++i) *(f32x4*)(sout + 4 * i) = (f32x4){st[4 * i], st[4 * i + 1], st[4 * i + 2], st[4 * i + 3]};
}
__device__ __forceinline__ void ssd_sample_item(Frame& F, int b, int h0) {
    const int lane = F.lane, w = F.wave, h = h0 + (w >> 2), pq = w & 3, g = h >> 2, p = 16 * pq + (lane >> 2), nc = lane & 3;
    LAS float* sq = (LAS float*)F.lds;
    const size_t so = ((size_t)(b * 16 + h) * 64 + p) * 128 + 32 * nc;
    float st[32];
#pragma unroll
    for (int i = 0; i < 8; ++i) { const f32x4 v = *(const f32x4*)(F.sssm + so + 4 * i); st[4 * i] = v[0]; st[4 * i + 1] = v[1]; st[4 * i + 2] = v[2]; st[4 * i + 3] = v[3]; }
    const float a = -__expf(F.a_log[h]), dsk = F.d_skip[h], dtb = F.dt_bias[h];
#pragma unroll 1
    for (int t = 0; t < 4; ++t) {
        const size_t row = (size_t)RP + 4 * b + t;
        const float xx = F.DT[row * 16 + h] + dtb; const float dt = xx > 20.f ? xx : log1pf(__expf(xx));
        const float dA = __expf(dt * a), xv = bf2f(F.XC[row * 2048 + h * 64 + p]), dtx = dt * xv;
        const bf16_t* bp = F.XC + row * 2048 + 1024 + g * 128 + 32 * nc;
        float y = 0.f;
#pragma unroll
        for (int i = 0; i < 4; ++i) { const u32x4 bv = *(const u32x4*)(bp + 8 * i), cv = *(const u32x4*)(bp + 512 + 8 * i);
#pragma unroll
            for (int e = 0; e < 4; ++e) { const float b0 = __uint_as_float(bv[e] << 16), b1 = __uint_as_float(bv[e] & 0xffff0000u), c0 = __uint_as_float(cv[e] << 16), c1 = __uint_as_float(cv[e] & 0xffff0000u);
                st[8 * i + 2 * e] = st[8 * i + 2 * e] * dA + dtx * b0; y += c0 * st[8 * i + 2 * e];
                st[8 * i + 2 * e + 1] = st[8 * i + 2 * e + 1] * dA + dtx * b1; y += c1 * st[8 * i + 2 * e + 1]; } }
        y += __shfl_xor(y, 1); y += __shfl_xor(y, 2);
        const float z = bf2f(F.U[row * LDU + U_Z + h * 64 + p]);
        const float v = (y + dsk * xv) * silu_f(z);
        if (nc == 0) F.ACAT[row * LDA + h * 64 + p] = (bf16_t)f2bf(v);
        const float q = wave_sum(nc == 0 ? v * v : 0.f);
        if (lane == 0) sq[(w >> 2) * 16 + t * 4 + pq] = q;
    }
#pragma unroll
    for (int i = 0; i < 8; ++i) *(f32x4*)(F.out + O_SSSM + so + 4 * i) = (f32x4){st[4 * i], st[4 * i + 1], st[4 * i + 2], st[4 * i + 3]};
    __syncthreads();
    if (F.tid < 8) { const int hl = F.tid >> 2, t = F.tid & 3; const LAS float* q4 = sq + hl * 16 + t * 4;
        const size_t row = (size_t)RP + 4 * b + t; F.SSQ[row * 32 + 2 * (h0 + hl)] = (q4[0] + q4[1]) + (q4[2] + q4[3]); F.SSQ[row * 32 + 2 * (h0 + hl) + 1] = 0.f; }
}
__device__ __forceinline__ void p2_mixers(const Args& args, unsigned char* lds, int qword, int it_lo = 0, int it_hi = 1 << 30) {
    Frame F0; F0.lds = (LAS unsigned char*)lds; F0.tid = threadIdx.x; F0.wave = __builtin_amdgcn_readfirstlane(F0.tid >> 6); F0.ctl = (unsigned*)(args.ws + WS_CTL);
#define F F0
    constexpr int N_SSDP = 128, N_ATTP = 512, N_MEMP = 512, N_ATTS = 512, N_MEMS = 256, N_SSDS = 1024, N_ITEMS = N_SSDP + N_ATTP + N_MEMP + N_ATTS + N_MEMS + N_SSDS;
    volatile LAS int* slot = (volatile LAS int*)(F.lds + MISC_OFF + 64);
    LAS float* qs = (LAS float*)(F.lds + 112 * 1024 + F.wave * 2048);
    LAS char* vl = (LAS char*)(F.lds + F.wave * 10240);
    int nxt = 0;
    if (F.tid == 0) nxt = (int)__hip_atomic_fetch_add(F.ctl + qword, 1u, RLX_AGENT);
    for (;;) {
        __syncthreads();
        if (F.tid == 0) *slot = nxt;
        __syncthreads();
        int it = *slot + it_lo;
        if (it >= N_ITEMS || it >= it_hi) break;
        if (F.tid == 0) nxt = (int)__hip_atomic_fetch_add(F.ctl + qword, 1u, RLX_AGENT);
#define P2_FRAME() FRAME(); asm volatile("" : "+v"(F.lane), "+v"(F.tid))
#undef F
        if (it < N_SSDP) { P2_FRAME(); ssd_prompt_unit(F, it >> 4, it & 15); continue; } it -= N_SSDP;
        const int grp = it / 11, r = it - 11 * grp;
        if (r < 2) { const int i = 2 * grp + r; P2_FRAME(); att_prompt_item(F, i >> 6, i & 7, (i >> 3) & 7, (LAS char*)F.lds + F.wave * 6144); continue; }
        if (r < 4) { const int i = 2 * grp + r - 2; P2_FRAME(); mem_prompt_item(F, i >> 6, i & 3, ((i >> 2) & 15) * 256); continue; }
        if (r < 6) { const int i = 2 * grp + r - 4; P2_FRAME(); att_sample_wave(F, i, F.wave, (LAS float*)(F.lds + 112 * 1024 + F.wave * 2048)); continue; }
        if (r == 6) { const int i = grp; P2_FRAME(); mem_sample_wave(F, i * 2 + (F.wave >> 2), F.wave & 3, (LAS float*)(F.lds + 112 * 1024 + F.wave * 2048)); continue; }
        { const int i = 4 * grp + r - 7; P2_FRAME(); ssd_sample_item(F, i >> 3, 2 * (i & 7)); }
#define F F0
    }
#undef F
#undef P2_FRAME
}
__device__ __forceinline__ void p5_final_norm(Frame& F) {
    const int gw = F.vcu * NWAVES + F.wave, NGW = F.G * NWAVES, lane = F.lane;
    f32x4 w[4];
#pragma unroll
    for (int j = 0; j < 4; ++j) w[j] = ((const f32x4*)F.norm_f_w)[lane + 64 * j];
    for (int m = gw; m < RT; m += NGW) {
        const f32x4* q = (const f32x4*)(F.RSQ + (size_t)m * 16); const f32x4 a = q[0], b = q[1], c = q[2], d = q[3];
        const float s = ((a[0] + a[1]) + (a[2] + a[3])) + ((b[0] + b[1]) + (b[2] + b[3])) + ((c[0] + c[1]) + (c[2] + c[3])) + ((d[0] + d[1]) + (d[2] + d[3]));
        const float rstd = 1.0f / sqrtf(s * (1.0f / 1024.0f) + EPS);
        f32x4* o = (f32x4*)(F.out + (size_t)m * 1024) + lane;
#pragma unroll
        for (int j = 0; j < 4; ++j) o[64 * j] = o[64 * j] * rstd * w[j];
    }
}
__global__ void __launch_bounds__(NTHREADS, 2) fwd_kernel(Args args) {
    extern __shared__ __attribute__((aligned(16))) unsigned char lds[];
    const int tid0 = threadIdx.x; const int wave0 = __builtin_amdgcn_readfirstlane(tid0 >> 6);
    for (int u = tid0; u < (LDS_BYTES - LDSCTL_OFF) / 4; u += NTHREADS) ((LAS unsigned*)((LAS unsigned char*)lds + LDSCTL_OFF))[u] = 0u;
    __syncthreads();
    const int lo = args.ph_lo, hi = args.ph_hi;
#if MK_ONE_LAUNCH
    XcdBarrier bar = xcd_barrier_post((unsigned*)(args.ws + WS_CTL) + CW_BAR, (volatile LAS unsigned*)((LAS unsigned char*)lds + MISC_OFF) + 8);
#define GRID_BAR() xcd_barrier(bar)
#else
#define GRID_BAR() do { } while (0)
#endif
#ifndef PH_MASK
#define PH_MASK 63
#endif
#define IN(k) (((PH_MASK >> (k)) & 1) && lo <= (k) && (k) < hi)
#define BOTH(k) (IN(k) && IN((k) + 1))

#ifndef PX_REPEAT
#define PX_REPEAT -1
#endif
    if (IN(0)) { { FRAME(); p0_prologue(F); }
#if PX_REPEAT == 0
        GRID_BAR(); { FRAME(); p0_prologue(F); }
#endif
        if (BOTH(0)) GRID_BAR(); }

#ifndef P1_REPEAT
#define P1_REPEAT 1
#endif
#ifndef P2_REPEAT
#define P2_REPEAT 1
#endif
#define P1_BODY() do { FRAME(); \
        pg8::Gemm g{F.XB, F.WinT, 1024, F.MB, F.WmemT}; pg8::TileOrder S; S.init(RT / 256, 48, F.G, (int)blockIdx.x, 1, 16, 8, 4); \
        EpiIn E{F.U, F.MKV, F.CS, F.out}; \
        pg8::gemm_phase<EpiIn, pg8::TileOrder, true>(F.lds, g, S, E, F.tid); } while (0)
    if (IN(1)) {
        P1_BODY();
#if P1_REPEAT == 2
        GRID_BAR(); P1_BODY();
#endif
        GRID_BAR();
        { FRAME(); p1c_conv(F); }
        if (BOTH(1)) GRID_BAR();
    }

    if (IN(2)) {
#pragma unroll 1
        for (int rep = 0; rep < P2_REPEAT; ++rep) { p2_mixers(args, lds, CW_Q + 64 * rep); if (rep + 1 < P2_REPEAT) GRID_BAR(); }
#ifdef P2_EXTRA_LO
        GRID_BAR(); p2_mixers(args, lds, CW_Q + 192, P2_EXTRA_LO, P2_EXTRA_HI);
#endif
        if (BOTH(2)) GRID_BAR(); }

    if (IN(3)) {
        { FRAME();
        for (int it = (int)blockIdx.x; it < 512; it += F.G) p3_sample_item(F, it);
        pg8::Gemm g{F.ACAT, F.WbrT, 2048, nullptr, nullptr}; pg8::TileOrder S; S.init(RP / 256, 4, F.G, (int)blockIdx.x, 3, 0);
        EpiBr E{F.U, F.SSQ, F.MERGED};
        pg8::gemm_phase<EpiBr, pg8::TileOrder, true>(F.lds, g, S, E, F.tid); }
#if PX_REPEAT == 3
        GRID_BAR();
        { FRAME();
        pg8::Gemm g{F.ACAT, F.WbrT, 2048, nullptr, nullptr}; pg8::TileOrder S; S.init(RT / 256, 4, F.G, (int)blockIdx.x, 3, 0);
        EpiBr E{F.U, F.SSQ, F.MERGED};
        pg8::gemm_phase<EpiBr, pg8::TileOrder, true>(F.lds, g, S, E, F.tid); }
#endif
        if (BOTH(3)) GRID_BAR();
    }

    if (IN(4)) {
        { FRAME();
        for (int it = (int)blockIdx.x; it < 256; it += F.G) p4_sample_item(F, it);
        pg8::Gemm g{F.MERGED, F.WoutT, 1024, nullptr, nullptr}; pg8::TileOrder S; S.init(RP / 256, 4, F.G, (int)blockIdx.x, 1, 16);
        EpiOut E{F.xp, F.xs, F.out, F.RSQ};
        pg8::gemm_phase<EpiOut, pg8::TileOrder, true>(F.lds, g, S, E, F.tid); }
#if PX_REPEAT == 4
        GRID_BAR();
        { FRAME();
        pg8::Gemm g{F.MERGED, F.WoutT, 1024, nullptr, nullptr}; pg8::TileOrder S; S.init(RT / 256, 4, F.G, (int)blockIdx.x, 1, 16);
        EpiOut E{F.xp, F.xs, F.out, F.RSQ};
        pg8::gemm_phase<EpiOut, pg8::TileOrder, true>(F.lds, g, S, E, F.tid); }
#endif
        if (BOTH(4)) GRID_BAR();
    }

    if (IN(5)) { FRAME(); p5_final_norm(F); }
#undef IN
#undef BOTH
}

extern "C" void kernel_launch(void* const* d_in, const int* in_sizes, int n_in, void* d_out, int out_size, void* d_ws, size_t ws_size, hipStream_t stream) {
    static int grid = 0;
    if (grid == 0) {
        if (n_in != 24 || (size_t)out_size != O_TOTAL || ws_size < WS_END) { fprintf(stderr, "kernel_launch: unexpected problem shape (n_in %d, out %d, ws %zu, need %zu); nothing launched\n", n_in, out_size, ws_size, (size_t)WS_END); grid = -1; return; }
        int dev = 0, cus = 0, per_cu = 0;
        if (hipGetDevice(&dev) != hipSuccess || hipDeviceGetAttribute(&cus, hipDeviceAttributeMultiprocessorCount, dev) != hipSuccess) { grid = -1; return; }
        if (hipFuncSetAttribute((const void*)fwd_kernel, hipFuncAttributeMaxDynamicSharedMemorySize, LDS_BYTES) != hipSuccess) { fprintf(stderr, "kernel_launch: hipFuncSetAttribute failed\n"); grid = -1; return; }
        if (hipOccupancyMaxActiveBlocksPerMultiprocessor(&per_cu, (const void*)fwd_kernel, NTHREADS, LDS_BYTES) != hipSuccess || per_cu < 1)
            fprintf(stderr, "kernel_launch: note: occupancy query reports %d workgroups per CU\n", per_cu);
        (void)hipGetLastError();
        grid = cus;
    }
    if (grid < 0) return;
    if (hipMemsetAsync((char*)d_ws + WS_CTL, 0, CTL_ZERO_BYTES, stream) != hipSuccess) { fprintf(stderr, "kernel_launch: memset failed\n"); return; }
    Args a{};
    {
        static const int dict_sizes[24] = {33554432, 524288, 2097152, 16777216, 67108864, 268435456, 33554432, 786432, 16777216, 1024, 12599296, 8192, 2048, 16, 16, 16, 1024, 1024, 1048576, 1048576, 524288, 524288, 1048576, 1024};
        static const int sorted_to_dict[24] = {14, 6, 3, 5, 4, 12, 11, 15, 13, 17, 2, 23, 9, 16, 7, 8, 20, 21, 19, 10, 18, 22, 0, 1};
        bool is_dict = true, is_sorted = true;
        for (int i = 0; i < 24; ++i) { if (in_sizes[i] != dict_sizes[i]) is_dict = false; if (in_sizes[i] != dict_sizes[sorted_to_dict[i]]) is_sorted = false; }
        if (is_dict) { for (int i = 0; i < 24; ++i) a.in[i] = (const float*)d_in[i]; }
        else if (is_sorted) { for (int i = 0; i < 24; ++i) a.in[sorted_to_dict[i]] = (const float*)d_in[i]; }
        else { fprintf(stderr, "kernel_launch: input sizes match neither the dict order nor the sorted-key order; nothing launched\n"); return; }
    }
    a.out = (float*)d_out; a.ws = (unsigned char*)d_ws;
#if MK_ONE_LAUNCH
    a.ph_lo = 0; a.ph_hi = 6;
    hipLaunchKernelGGL(fwd_kernel, dim3(grid), dim3(NTHREADS), LDS_BYTES, stream, a);
#else
    for (int ph = 0; ph < 6; ++ph) { a.ph_lo = ph; a.ph_hi = ph + 1; hipLaunchKernelGGL(fwd_kernel, dim3(grid), dim3(NTHREADS), LDS_BYTES, stream, a); }
#endif
    const hipError_t le = hipPeekAtLastError();
    if (le != hipSuccess) fprintf(stderr, "kernel_launch: launch failed: %s\n", hipGetErrorName(le));
}
```

```cpp
#include <hip/hip_runtime.h>
#include <cstdio>
#include <cstdint>

#ifndef MK_ONE_LAUNCH
#define MK_ONE_LAUNCH 1
#endif

#define GAS __attribute__((address_space(1)))
#define LAS __attribute__((address_space(3)))
typedef unsigned short bf16_t;
typedef short bf16x8 __attribute__((ext_vector_type(8)));
typedef float f32x4 __attribute__((ext_vector_type(4)));
typedef float f32x2 __attribute__((ext_vector_type(2)));
typedef unsigned u32x4 __attribute__((ext_vector_type(4)));
typedef unsigned u32x2 __attribute__((ext_vector_type(2)));
#define RLX_AGENT __ATOMIC_RELAXED, __HIP_MEMORY_SCOPE_AGENT
#define LDS_WAIT() asm volatile("s_waitcnt lgkmcnt(0)" ::: "memory")
#define VM_WAIT() asm volatile("s_waitcnt vmcnt(0)" ::: "memory")

constexpr int DM = 1024;
constexpr int RP = 8 * 4096, RS = 128 * 4, RT = RP + RS;
constexpr int NINP = 12544;
constexpr int LDU = 12288;
constexpr int U_Z = 0, U_XBC = 1024, U_QKV = 3072, U_ZA = 7680, U_QM = 8192, U_ZM = 8704, U_GATE = 9216;
constexpr int LDA = 2048;
constexpr float EPS = 1e-6f;
constexpr size_t O_YP = 0, O_YS = 33554432, O_PW128 = 34078720, O_PW512 = 35127296, O_PW2048 = 39321600, O_PMEM = 56098816, O_PCONV = 58195968, O_PSSM = 58245120,
                 O_SW128 = 59293696, O_SW512 = 59817984, O_SW2048 = 60342272, O_SCONV = 60866560, O_SSSM = 61652992, O_TOTAL = 78430208;
constexpr size_t MiB = 1u << 20;
constexpr size_t WS_CTL = 0, CTL_ZERO_BYTES = 1 * MiB;
constexpr size_t WS_WIN = 1 * MiB;
constexpr size_t WS_WMEM = 26 * MiB;
constexpr size_t WS_WBR = 30 * MiB;
constexpr size_t WS_WOUT = 34 * MiB;
constexpr size_t WS_CS = 36 * MiB;
constexpr size_t WS_DT = 37 * MiB;
constexpr size_t WS_SSQ = 40 * MiB;
constexpr size_t WS_RSQ = 45 * MiB;
constexpr size_t WS_MB = 48 * MiB;
constexpr size_t WS_MKV = 52 * MiB;
constexpr size_t WS_XB = 58 * MiB;
constexpr size_t WS_MERGED = 124 * MiB;
constexpr size_t WS_ACAT = 190 * MiB;
constexpr size_t WS_U = 321 * MiB;
constexpr size_t WS_XC = WS_U + (size_t)RT * LDU * 2;
constexpr size_t WS_END = WS_XC + (size_t)RT * 2048 * 2;
static_assert(WS_WIN + (size_t)NINP * 1024 * 2 <= WS_WMEM && WS_XB + (size_t)RT * 1024 * 2 <= WS_MERGED && WS_MERGED + (size_t)RT * 1024 * 2 <= WS_ACAT && WS_ACAT + (size_t)RT * LDA * 2 <= WS_U, "d_ws map");
constexpr int CW_Q = 64;
constexpr int CW_BAR = 4096;
constexpr int RING_BYTES = 131072, LDSCTL_OFF = RING_BYTES, MISC_OFF = LDSCTL_OFF + 320, LDS_BYTES = 147456;
constexpr int NWAVES = 8, NTHREADS = 512;

__device__ __forceinline__ float bf2f(bf16_t b) { return __uint_as_float(((unsigned)b) << 16); }
__device__ __forceinline__ unsigned f2bf(float f) { unsigned u = __float_as_uint(f); return (u + 0x7fffu + ((u >> 16) & 1u)) >> 16; }
__device__ __forceinline__ unsigned pk2(float lo, float hi) { return f2bf(lo) | (f2bf(hi) << 16); }
__device__ __forceinline__ float silu_f(float x) { return x / (1.0f + __expf(-x)); }
__device__ __forceinline__ float wave_sum(float v) {
#pragma unroll
    for (int o = 1; o < 64; o <<= 1) v += __shfl_xor(v, o);
    return v;
}
__device__ __forceinline__ float wave_max(float v) {
#pragma unroll
    for (int o = 1; o < 64; o <<= 1) v = fmaxf(v, __shfl_xor(v, o));
    return v;
}
namespace pg8 {
constexpr int BM = 256, BK = 64, HALF = 128, HTB = HALF * BK * 2  , STAGE_BYTES = 8 * HTB, NXCD = 8, WGM = 8;

__host__ __device__ __forceinline__ int lds_byte(int r, int c) { const int st = (r >> 4) * 2 + (c >> 5), rr = r & 15, cc = c & 31, ob = rr * 64 + cc * 2; return st * 1024 + (ob ^ (((ob >> 9) & 1) << 5)); }
__host__ __device__ __forceinline__ void stage_rc(int b, int& R, int& C) { const int st = b / 1024, sb = b % 1024, swz = sb ^ (((sb >> 9) & 1) << 5); R = (st >> 1) * 16 + swz / 64; C = (st & 1) * 32 + (swz % 64) / 2; }
__host__ __device__ __forceinline__ int perm32(int rho) { const int n = rho >> 4, i = rho & 15; return 8 * (i >> 2) + 4 * n + (i & 3); }

struct Unit { int pm, pn, k0, nt, kind, src; };
struct Gemm { const bf16_t* A; const bf16_t* Bt; int ld; const bf16_t* A2; const bf16_t* Bt2; };

struct TileOrder {
    int nM, nN, nwg, G, c, nsub, ntfull, nM2, nN2;
    __device__ __forceinline__ void init(int nM_, int nN_, int G_, int c_, int nsub_, int ntfull_, int nM2_ = 0, int nN2_ = 0) { nM = nM_; nN = nN_; nwg = nM * nN; G = G_; c = c_; nsub = nsub_; ntfull = ntfull_; nM2 = nM2_; nN2 = nN2_; }
    __device__ __forceinline__ bool next(int i, Unit& u) const {
        int ti = i, sub = 0;
        if (nsub == 3) { ti = i / 3; sub = i - 3 * ti; }
        const long L = (long)ti * G + c; u.src = 0;
        if (L >= nwg) { const int e = (int)(L - nwg); if (e >= nM2 * nN2) return false; u.pm = e / nN2; u.pn = e - u.pm * nN2; u.kind = 0; u.k0 = 0; u.nt = ntfull; u.src = 1; return true; }
        int wgid = (int)L; { const int q = nwg / NXCD, r = nwg % NXCD, xcd = wgid % NXCD, off = wgid / NXCD; wgid = (xcd < r ? xcd * (q + 1) : r * (q + 1) + (xcd - r) * q) + off; }
        const int nig = WGM * nN, gid = wgid / nig, fm = gid * WGM, gsz = (nM - fm) < WGM ? (nM - fm) : WGM;
        u.pm = fm + ((wgid % nig) % gsz); u.pn = (wgid % nig) / gsz; u.kind = sub;
        if (nsub == 3) { u.k0 = sub == 0 ? 0 : (sub == 1 ? 1024 : 1536); u.nt = sub == 0 ? 16 : 8; } else { u.k0 = 0; u.nt = ntfull; }
        return true;
    }
};

__device__ __forceinline__ unsigned cvt_pk_bf16(float lo, float hi) { unsigned r; asm volatile("v_cvt_pk_bf16_f32 %0, %1, %2" : "=v"(r) : "v"(lo), "v"(hi)); return r; }

template <class Epi, class Sched, bool ALIGN_EPI = true>
__device__ __forceinline__ void gemm_phase(LAS unsigned char* lds, const Gemm g, const Sched& S, const Epi& E, const int tid) {
    const int wid = __builtin_amdgcn_readfirstlane(tid >> 6), lane = tid & 63, wr = wid >> 2, wc = wid & 3, fr = lane & 15, fq = lane >> 4;
    const int K = g.ld;
    unsigned voffA[2], voffB[2];
#pragma unroll
    for (int i = 0; i < 2; ++i) { int R, C; stage_rc(tid * 16 + i * 8192, R, C); const int Rb = Epi::PERM ? ((R & ~31) + perm32(R & 31)) : R;
        voffA[i] = (unsigned)(R * K + C) * 2u; voffB[i] = (unsigned)(Rb * K + C) * 2u; }
    const size_t kstep = (size_t)(BK * 2);
    const size_t hstep = (size_t)HALF * K * 2;
    const size_t tstep = 2 * hstep;
    const unsigned ldsw = (unsigned)wid * 1024u;
    const int aoff = lds_byte(wr * 64 + fr, fq * 8), boff = lds_byte(wc * 32 + fr, fq * 8);
#define PG8_SA(b, h) (((b) * 2 + (h)) * HTB)
#define PG8_SB(b, h) ((4 + (b) * 2 + (h)) * HTB)
#define PG8_STAGE(bufoff, gbase, voff) do { _Pragma("unroll") for (int _i = 0; _i < 2; ++_i) \
        __builtin_amdgcn_global_load_lds((const unsigned*)((const char*)(gbase) + (voff)[_i]), (LAS unsigned*)(lds + (bufoff) + ldsw + _i * 8192), 16, 0, 0); } while (0)
#define PG8_LDA(dst, b, h) do { _Pragma("unroll") for (int m = 0; m < 4; ++m) _Pragma("unroll") for (int k = 0; k < 2; ++k) dst[m][k] = *(const LAS bf16x8*)(lds + PG8_SA(b, h) + aoff + m * 2048 + k * 1024); } while (0)
#define PG8_LDB(dst, b, h) do { _Pragma("unroll") for (int n = 0; n < 2; ++n) _Pragma("unroll") for (int k = 0; k < 2; ++k) dst[n][k] = *(const LAS bf16x8*)(lds + PG8_SB(b, h) + boff + n * 2048 + k * 1024); } while (0)
#define PG8_MMA(ai, bj, At, Bt) do { __builtin_amdgcn_s_setprio(1); _Pragma("unroll") for (int m = 0; m < 4; ++m) _Pragma("unroll") for (int n = 0; n < 2; ++n) _Pragma("unroll") for (int k = 0; k < 2; ++k) \
        acc[ai][bj][m][n] = __builtin_amdgcn_mfma_f32_16x16x32_bf16(Bt[n][k], At[m][k], acc[ai][bj][m][n], 0, 0, 0); __builtin_amdgcn_s_setprio(0); } while (0)
#define PG8_WAIT_V(n) asm volatile("s_waitcnt vmcnt(" #n ")" ::: "memory")
#define PG8_WAIT_L(n) asm volatile("s_waitcnt lgkmcnt(" #n ")" ::: "memory")
#define PG8_BAR __builtin_amdgcn_s_barrier()
#define PG8_SCHED __builtin_amdgcn_sched_barrier(0)
    Unit cur, nxt; int ui = 0;
    if (!S.next(0, cur)) return;
    f32x4 acc[2][2][4][2];
#pragma unroll
    for (int a = 0; a < 2; ++a)
#pragma unroll
        for (int b = 0; b < 2; ++b)
#pragma unroll
            for (int m = 0; m < 4; ++m)
#pragma unroll
                for (int n = 0; n < 2; ++n) acc[a][b][m][n] = (f32x4){0.f, 0.f, 0.f, 0.f};
    bf16x8 At[4][2], B0[2][2], B1[2][2];
    const char* cA = (const char*)(cur.src ? g.A2 : g.A) + (size_t)cur.pm * tstep + (size_t)cur.k0 * 2; const char* cB = (const char*)(cur.src ? g.Bt2 : g.Bt) + (size_t)cur.pn * tstep + (size_t)cur.k0 * 2;
    PG8_STAGE(PG8_SB(0, 0), cB, voffB); PG8_STAGE(PG8_SB(0, 1), cB + hstep, voffB); PG8_STAGE(PG8_SA(0, 0), cA, voffA); PG8_STAGE(PG8_SA(0, 1), cA + hstep, voffA);
    if (wr == 1) PG8_BAR;
    PG8_WAIT_V(2); PG8_BAR;
    PG8_STAGE(PG8_SB(1, 0), cB + kstep, voffB); PG8_STAGE(PG8_SA(1, 0), cA + kstep, voffA); PG8_STAGE(PG8_SB(1, 1), cB + hstep + kstep, voffB);
    PG8_WAIT_V(6); PG8_BAR;
    for (;;) {
        const bool has_next = S.next(ui + 1, nxt);
        const char* nA = has_next ? (const char*)(nxt.src ? g.A2 : g.A) + (size_t)nxt.pm * tstep + (size_t)nxt.k0 * 2 : cA; const char* nB = has_next ? (const char*)(nxt.src ? g.Bt2 : g.Bt) + (size_t)nxt.pn * tstep + (size_t)nxt.k0 * 2 : cB;
        const int nt = cur.nt;
        for (int t = 0; t < nt; t += 2) {
            const bool last = (t == nt - 2);
            const char* a1 = cA + (size_t)(t + 1) * kstep;
            const char* a2 = last ? nA : cA + (size_t)(t + 2) * kstep; const char* b2 = last ? nB : cB + (size_t)(t + 2) * kstep;
            const char* a3 = a2 + kstep; const char* b3 = b2 + kstep;
            PG8_LDB(B0, 0, 0); PG8_LDB(B1, 0, 1); PG8_SCHED; PG8_LDA(At, 0, 0); PG8_STAGE(PG8_SA(1, 1), a1 + hstep, voffA);
            PG8_WAIT_V(8); PG8_WAIT_L(0); PG8_BAR; PG8_MMA(0, 0, At, B0); PG8_MMA(0, 1, At, B1); PG8_BAR; PG8_SCHED;
            PG8_LDA(At, 0, 1); PG8_STAGE(PG8_SB(0, 0), b2, voffB); PG8_STAGE(PG8_SB(0, 1), b2 + hstep, voffB); PG8_STAGE(PG8_SA(0, 0), a2, voffA);
            PG8_WAIT_V(8); PG8_WAIT_L(0); PG8_BAR; PG8_MMA(1, 0, At, B0); PG8_MMA(1, 1, At, B1); PG8_BAR; PG8_SCHED;
            PG8_LDB(B0, 1, 0); PG8_LDB(B1, 1, 1); PG8_SCHED; PG8_LDA(At, 1, 0); PG8_STAGE(PG8_SA(0, 1), a2 + hstep, voffA);
            PG8_WAIT_V(8); PG8_WAIT_L(0); PG8_BAR; PG8_MMA(0, 0, At, B0); PG8_MMA(0, 1, At, B1); PG8_BAR; PG8_SCHED;
            PG8_LDA(At, 1, 1); PG8_STAGE(PG8_SB(1, 0), b3, voffB); PG8_STAGE(PG8_SB(1, 1), b3 + hstep, voffB); PG8_STAGE(PG8_SA(1, 0), a3, voffA);
            PG8_WAIT_V(8); PG8_WAIT_L(0); PG8_BAR; PG8_MMA(1, 0, At, B0); PG8_MMA(1, 1, At, B1); PG8_BAR; PG8_SCHED;
        }
        if constexpr (ALIGN_EPI) { if (wr == 0) PG8_BAR; }
        E(acc, cur, wr, wc, fr, fq);
        if (!has_next) break;
        if (E.zero_after(cur)) {
#pragma unroll
        for (int a = 0; a < 2; ++a)
#pragma unroll
            for (int b = 0; b < 2; ++b)
#pragma unroll
                for (int m = 0; m < 4; ++m)
#pragma unroll
                    for (int n = 0; n < 2; ++n) acc[a][b][m][n] = (f32x4){0.f, 0.f, 0.f, 0.f};
        }
        cur = nxt; cA = nA; cB = nB; ++ui;
        if constexpr (ALIGN_EPI) { if (wr == 1) PG8_BAR; }
    }
    PG8_WAIT_V(0);
    if constexpr (!ALIGN_EPI) { if (wr == 0) PG8_BAR; }
    PG8_BAR;
#undef PG8_SA
#undef PG8_SB
#undef PG8_STAGE
#undef PG8_LDA
#undef PG8_LDB
#undef PG8_MMA
#undef PG8_WAIT_V
#undef PG8_WAIT_L
#undef PG8_BAR
#undef PG8_SCHED
}
}
#define XB_TMO      128
#define XB_XCNT(j)  (256  + 64 * (j))
#define XB_XSUB(j)  (1280 + 64 * (j))
#define XB_XGEN(j)  (2304 + 64 * (j))
#define XB_TOP      3328
#define XB_TOPGEN   3392
#define XCD_BAR_WORDS 3456
#define XB_SPIN_CAP (1u << 18)

__device__ __forceinline__ unsigned xb_ld(unsigned* p)              { return __hip_atomic_load(p, __ATOMIC_RELAXED, __HIP_MEMORY_SCOPE_AGENT); }
__device__ __forceinline__ unsigned xb_add(unsigned* p, unsigned v) { return __hip_atomic_fetch_add(p, v, __ATOMIC_RELAXED, __HIP_MEMORY_SCOPE_AGENT); }
__device__ __forceinline__ unsigned xb_xcc_id() { return (unsigned)__builtin_amdgcn_s_getreg((3 << 11) | 20) & 0xFu; }
#define XB_SPIN(cond, bar) do { unsigned _sp = 0; while (cond) { __builtin_amdgcn_s_sleep(1); \
    if ((++_sp & 255u) == 0u) { if (xb_ld(&(bar)[XB_TMO])) break; if (_sp > XB_SPIN_CAP) { atomicAdd(&(bar)[XB_TMO], 1u); break; } } } } while (0)

struct XcdBarrier {
    unsigned* bar; unsigned x;
    volatile LAS unsigned* st;
};

__device__ __forceinline__ XcdBarrier xcd_barrier_post(unsigned* bar, volatile LAS unsigned* st) {
    XcdBarrier b; b.bar = bar; b.x = xb_xcc_id(); b.st = st;
    if (threadIdx.x == 0) (void)xb_add(&bar[XB_XCNT(b.x)], 1u);
    return b;
}
__device__ __forceinline__ void xcd_barrier_complete(unsigned* bar, unsigned x, unsigned& nloc, unsigned& nx) {
    const unsigned G = gridDim.x * gridDim.y * gridDim.z;
    unsigned sum, cnt, mine, sp = 0u;
    for (;;) {
        sum = 0u; cnt = 0u; mine = 0u;
#pragma unroll
        for (unsigned j = 0; j < 16; ++j) { const unsigned c = xb_ld(&bar[XB_XCNT(j)]); sum += c; cnt += (c > 0u) ? 1u : 0u; mine = (j == x) ? c : mine; }
        if (sum == G) break;
        __builtin_amdgcn_s_sleep(1);
        if ((++sp & 255u) == 0u) { if (xb_ld(&bar[XB_TMO])) break; if (sp > XB_SPIN_CAP) { atomicAdd(&bar[XB_TMO], 1u); break; } }
    }
    nloc = mine > 0u ? mine : 1u; nx = cnt > 0u ? cnt : 1u;
}

__device__ __forceinline__ void xcd_barrier(const XcdBarrier& b) {
    asm volatile("s_waitcnt vmcnt(0)" ::: "memory");
    __syncthreads();
    if (threadIdx.x == 0) {
        unsigned* bar = b.bar;
        __builtin_amdgcn_s_waitcnt(0);
        unsigned nloc = b.st[0], nx = b.st[1];
        if (nloc == 0u) { xcd_barrier_complete(bar, b.x, nloc, nx); b.st[0] = nloc; b.st[1] = nx; }
        const unsigned old = xb_add(&bar[XB_XSUB(b.x)], 1u);
        const unsigned gen = old / nloc;
        if (old + 1u == (gen + 1u) * nloc) {
            __builtin_amdgcn_fence(__ATOMIC_RELEASE, "agent");
            asm volatile("s_waitcnt vmcnt(0)" ::: "memory");
            const unsigned og = xb_add(&bar[XB_TOP], 1u);
            const unsigned tg = og / nx;
            if (og + 1u == (tg + 1u) * nx) xb_add(&bar[XB_TOPGEN], 1u);
            else XB_SPIN(xb_ld(&bar[XB_TOPGEN]) == tg, bar);
            __builtin_amdgcn_fence(__ATOMIC_ACQUIRE, "agent");
            xb_add(&bar[XB_XGEN(b.x)], 1u);
            asm volatile("s_waitcnt vmcnt(0)" ::: "memory");
        } else {
            XB_SPIN(xb_ld(&bar[XB_XGEN(b.x)]) == gen, bar);
            __builtin_amdgcn_fence(__ATOMIC_ACQUIRE, "agent");
            asm volatile("s_waitcnt vmcnt(0)" ::: "memory");
        }
    }
    __syncthreads();
}

constexpr float L2E_ = 1.4426950408889634f;
using pg8::Unit; using pg8::cvt_pk_bf16;
__device__ __forceinline__ u32x4 pack8(const f32x4 v0, const f32x4 v1) { u32x4 w; w.x = cvt_pk_bf16(v0[0], v0[1]); w.y = cvt_pk_bf16(v0[2], v0[3]); w.z = cvt_pk_bf16(v1[0], v1[1]); w.w = cvt_pk_bf16(v1[2], v1[3]); return w; }

struct EpiIn {
    static constexpr bool PERM = true;
    bf16_t* U; bf16_t* MKV; const float* CS; float* out;
    __device__ __forceinline__ bool zero_after(const Unit&) const { return true; }
    __device__ __forceinline__ void operator()(f32x4 (&acc)[2][2][4][2], const Unit& u, int wr, int wc, int fr, int fq) const {
        const int pn = u.pn, rbase = u.pm * 256 + wr * 64 + fr, lc0 = wc * 32 + 8 * fq;
        if (u.src == 1) {
            const int c0 = u.pn * 256 + lc0;
#pragma unroll
            for (int ai = 0; ai < 2; ++ai)
#pragma unroll
                for (int m = 0; m < 4; ++m) { const int row = rbase + ai * 128 + m * 16;
#pragma unroll
                    for (int bj = 0; bj < 2; ++bj) { const f32x4 v0 = acc[ai][bj][m][0], v1 = acc[ai][bj][m][1]; const size_t o = (size_t)row * 1024 + c0 + bj * 128;
                        *(u32x4*)(MKV + o) = pack8(v0, v1); float* d = out + O_PMEM + o; *(f32x4*)d = v0; *(f32x4*)(d + 4) = v1; } }
            return;
        }
        int kind = 0, g = 0, half = 0;
        if (pn >= 4 && pn < 12) kind = 1;
        else if (pn >= 12 && pn < 30) { const int t12 = pn - 12; g = t12 / 6; const int j = (t12 - 6 * g) >> 1; half = t12 & 1; kind = 2 + j; }
        const bool rope = (kind == 2 || kind == 3) && ((wc & 1) == 0);
        const int W = g == 0 ? 128 : (g == 1 ? 512 : 2048);
        const size_t opw = g == 0 ? O_PW128 : (g == 1 ? O_PW512 : O_PW2048), osw = g == 0 ? O_SW128 : (g == 1 ? O_SW512 : O_SW2048);
#pragma unroll
        for (int ai = 0; ai < 2; ++ai)
#pragma unroll
            for (int m = 0; m < 4; ++m) {
                const int row = rbase + ai * 128 + m * 16;
                const bool samp = row >= RP;
                const int t = samp ? ((row - RP) & 3) : (row & 4095), b = samp ? ((row - RP) >> 2) : (row >> 12);
                f32x4 c0, c1, s0, s1;
                if (rope) { const float* cs = CS + (size_t)(samp ? 4096 + t : t) * 16; c0 = *(const f32x4*)cs; c1 = *(const f32x4*)(cs + 4); s0 = *(const f32x4*)(cs + 8); s1 = *(const f32x4*)(cs + 12);
                    if (fq == 0) { s0 = -s0; s1 = -s1; } }
#pragma unroll
                for (int bj = 0; bj < 2; ++bj) {
                    f32x4 v0 = acc[ai][bj][m][0], v1 = acc[ai][bj][m][1];
                    if (rope) {
                        f32x4 p0, p1;
#pragma unroll
                        for (int e = 0; e < 4; ++e) { p0[e] = __shfl_xor(v0[e], 16); p1[e] = __shfl_xor(v1[e], 16); }
                        if (fq < 2) { v0 = v0 * c0 + p0 * s0; v1 = v1 * c1 + p1 * s1; }
                    }
                    if (kind == 2) { v0 = v0 * 0.125f; v1 = v1 * 0.125f; }
                    if (kind == 5) {
#pragma unroll
                        for (int e = 0; e < 4; ++e) { v0[e] = fmaxf(__builtin_amdgcn_rcpf(1.0f + __builtin_amdgcn_exp2f(-L2E_ * v0[e])), 1e-30f); v1[e] = fmaxf(__builtin_amdgcn_rcpf(1.0f + __builtin_amdgcn_exp2f(-L2E_ * v1[e])), 1e-30f); } }
                    const int lc = bj * 128 + lc0;
                    *(u32x4*)(U + (size_t)row * LDU + pn * 256 + lc) = pack8(v0, v1);
                    if (kind == 1) {
                        const int col = (pn - 4) * 256 + lc;
                        if (samp) { if (t >= 1) { float* d = out + O_SCONV + (size_t)(b * 3 + t - 1) * 2048 + col; *(f32x4*)d = v0; *(f32x4*)(d + 4) = v1; } }
                        else if (t >= 4093) { float* d = out + O_PCONV + (size_t)(b * 3 + t - 4093) * 2048 + col; *(f32x4*)d = v0; *(f32x4*)(d + 4) = v1; }
                    } else if (kind >= 3) {
                        const int hd = half * 256 + lc, kv = kind - 3;
                        if (samp) { float* d = out + osw + ((size_t)(row - RP) * 2 + kv) * 512 + hd; *(f32x4*)d = v0; *(f32x4*)(d + 4) = v1; }
                        else if (t >= 4096 - W) { float* d = out + opw + ((size_t)(b * W + t - (4096 - W)) * 2 + kv) * 512 + hd; *(f32x4*)d = v0; *(f32x4*)(d + 4) = v1; }
                    }
                }
            }
    }
};

struct EpiMem {
    static constexpr bool PERM = true;
    bf16_t* MKV; float* out;
    __device__ __forceinline__ bool zero_after(const Unit&) const { return true; }
    __device__ __forceinline__ void operator()(f32x4 (&acc)[2][2][4][2], const Unit& u, int wr, int wc, int fr, int fq) const {
        const int rbase = u.pm * 256 + wr * 64 + fr, c0 = u.pn * 256 + wc * 32 + 8 * fq;
#pragma unroll
        for (int ai = 0; ai < 2; ++ai)
#pragma unroll
            for (int m = 0; m < 4; ++m) { const int row = rbase + ai * 128 + m * 16;
#pragma unroll
                for (int bj = 0; bj < 2; ++bj) { const f32x4 v0 = acc[ai][bj][m][0], v1 = acc[ai][bj][m][1]; const size_t o = (size_t)row * 1024 + c0 + bj * 128;
                    *(u32x4*)(MKV + o) = pack8(v0, v1); float* d = out + O_PMEM + o; *(f32x4*)d = v0; *(f32x4*)(d + 4) = v1; } }
    }
};

struct EpiBr {
    static constexpr bool PERM = true;
    const bf16_t* U; const float* SSQ; bf16_t* MERGED;
    __device__ __forceinline__ bool zero_after(const Unit& u) const { return u.kind == 2; }
    __device__ __forceinline__ void operator()(f32x4 (&acc)[2][2][4][2], const Unit& u, int wr, int wc, int fr, int fq) const {
        const int rbase = u.pm * 256 + wr * 64 + fr, c0 = u.pn * 256 + wc * 32 + 8 * fq, kind = u.kind;
        const int goffa = kind == 0 ? 0 : (kind == 1 ? 1024 : 2048), goffb = kind == 0 ? 1024 : 2048;
#pragma unroll
        for (int am = 0; am < 8; ++am) { const int ai = am >> 2, mb = am & 3;
            u32x4 ga[4][2], gb[4][2]; f32x4 q0[4], q1[4];
#pragma unroll
            for (int m = mb; m < mb + 1; ++m) { const size_t row = (size_t)(rbase + ai * 128 + m * 16);
                if (kind == 0) { q0[m] = *(const f32x4*)(SSQ + row * 32 + 8 * fq); q1[m] = *(const f32x4*)(SSQ + row * 32 + 8 * fq + 4); }
#pragma unroll
                for (int bj = 0; bj < 2; ++bj) { const bf16_t* gp = U + row * LDU + U_GATE + c0 + bj * 128; ga[m][bj] = *(const u32x4*)(gp + goffa); if (kind != 2) gb[m][bj] = *(const u32x4*)(gp + goffb); } }
#pragma unroll
            for (int m = mb; m < mb + 1; ++m) { const size_t row = (size_t)(rbase + ai * 128 + m * 16);
                float rs = 1.0f;
                if (kind == 0) { float sq = ((q0[m][0] + q0[m][1]) + (q0[m][2] + q0[m][3])) + ((q1[m][0] + q1[m][1]) + (q1[m][2] + q1[m][3]));
                    sq += __shfl_xor(sq, 16); sq += __shfl_xor(sq, 32); rs = 1.0f / sqrtf(sq * (1.0f / 1024.0f) + EPS); }
#pragma unroll
                for (int bj = 0; bj < 2; ++bj) {
                    float f[8];
                    if (kind == 2) {
#pragma unroll
                        for (int e = 0; e < 4; ++e) { f[2 * e] = __builtin_amdgcn_rcpf(1.0f + __builtin_amdgcn_exp2f(-L2E_ * __builtin_amdgcn_fmed3f(__uint_as_float(ga[m][bj][e] << 16), -60.f, 60.f))); f[2 * e + 1] = __builtin_amdgcn_rcpf(1.0f + __builtin_amdgcn_exp2f(-L2E_ * __builtin_amdgcn_fmed3f(__uint_as_float(ga[m][bj][e] & 0xffff0000u), -60.f, 60.f))); }
                    } else {
#pragma unroll
                        for (int e = 0; e < 4; ++e) {
                            const float a_lo = __builtin_amdgcn_fmed3f(__uint_as_float(ga[m][bj][e] << 16), -60.f, 60.f), a_hi = __builtin_amdgcn_fmed3f(__uint_as_float(ga[m][bj][e] & 0xffff0000u), -60.f, 60.f);
                            const float b_lo = __builtin_amdgcn_fmed3f(__uint_as_float(gb[m][bj][e] << 16), -60.f, 60.f), b_hi = __builtin_amdgcn_fmed3f(__uint_as_float(gb[m][bj][e] & 0xffff0000u), -60.f, 60.f);
                            f[2 * e] = rs * (1.0f + __builtin_amdgcn_exp2f(-L2E_ * b_lo)) * __builtin_amdgcn_rcpf(1.0f + __builtin_amdgcn_exp2f(-L2E_ * a_lo));
                            f[2 * e + 1] = rs * (1.0f + __builtin_amdgcn_exp2f(-L2E_ * b_hi)) * __builtin_amdgcn_rcpf(1.0f + __builtin_amdgcn_exp2f(-L2E_ * a_hi)); }
                    }
                    f32x4 v0 = acc[ai][bj][m][0], v1 = acc[ai][bj][m][1];
                    v0 = v0 * (f32x4){f[0], f[1], f[2], f[3]}; v1 = v1 * (f32x4){f[4], f[5], f[6], f[7]};
                    acc[ai][bj][m][0] = v0; acc[ai][bj][m][1] = v1;
                    if (kind == 2) *(u32x4*)(MERGED + row * 1024 + c0 + bj * 128) = pack8(v0, v1);
                }
            }
        }
    }
};

struct EpiOut {
    static constexpr bool PERM = false;
    const float* xp; const float* xs; float* out; float* RSQ;
    __device__ __forceinline__ bool zero_after(const Unit&) const { return true; }
    __device__ __forceinline__ void operator()(f32x4 (&acc)[2][2][4][2], const Unit& u, int wr, int wc, int fr, int fq) const {
        const int rbase = u.pm * 256 + wr * 64 + fr, c0 = u.pn * 256 + wc * 32 + 4 * fq;
#pragma unroll
        for (int am = 0; am < 4; ++am) { const int ai = am >> 1, mb = 2 * (am & 1);
            f32x4 xr[4][2][2];
#pragma unroll
            for (int m = mb; m < mb + 2; ++m) { const int row = rbase + ai * 128 + m * 16;
                const float* xq = (row < RP ? xp + (size_t)row * 1024 : xs + (size_t)(row - RP) * 1024) + c0;
#pragma unroll
                for (int bj = 0; bj < 2; ++bj)
#pragma unroll
                    for (int n = 0; n < 2; ++n) xr[m][bj][n] = *(const f32x4*)(xq + bj * 128 + n * 16); }
#pragma unroll
            for (int m = mb; m < mb + 2; ++m) { const int row = rbase + ai * 128 + m * 16;
                float* orow = out + (size_t)row * 1024 + c0;
                float s = 0.f;
#pragma unroll
                for (int bj = 0; bj < 2; ++bj)
#pragma unroll
                    for (int n = 0; n < 2; ++n) { const f32x4 r = xr[m][bj][n] + acc[ai][bj][m][n]; *(f32x4*)(orow + bj * 128 + n * 16) = r;
                        s += (r[0] * r[0] + r[1] * r[1]) + (r[2] * r[2] + r[3] * r[3]); }
                s += __shfl_xor(s, 16); s += __shfl_xor(s, 32);
                if (fq == 0) RSQ[(size_t)row * 16 + u.pn * 4 + wc] = s;
            }
        }
    }
};
struct Frame {
    LAS unsigned char* lds;
    unsigned* ctl;
    int tid, lane, wave, G, vcu;
    const float *xp, *xs, *memp, *cw128, *cw512, *cw2048, *cmem, *sconv, *sssm, *norm_in_w, *w_in, *conv_w, *conv_b, *dt_bias, *a_log, *d_skip, *ssd_norm_w, *mem_norm_w, *w_mem_kv, *w_br_ssd, *w_br_att, *w_br_mem, *w_out, *norm_f_w;
    float* out;
    bf16_t *WinT, *WmemT, *WbrT, *WoutT, *XB, *MB, *U, *MKV, *ACAT, *MERGED, *XC;
    float *CS, *DT, *SSQ, *RSQ;
};

struct Args { const float* in[24]; float* out; unsigned char* ws; int ph_lo, ph_hi; };
#define FRAME() Frame F; \
    F.lds = (LAS unsigned char*)lds; F.tid = threadIdx.x; F.lane = F.tid & 63; F.wave = __builtin_amdgcn_readfirstlane(F.tid >> 6); \
    F.G = gridDim.x; { const int bx = blockIdx.x; F.vcu = (F.G % 8 == 0) ? (bx % 8) * (F.G / 8) + bx / 8 : bx; } \
    unsigned char* ws = args.ws; F.ctl = (unsigned*)(ws + WS_CTL); \
    F.xp = args.in[0]; F.xs = args.in[1]; F.memp = args.in[2]; F.cw128 = args.in[3]; F.cw512 = args.in[4]; F.cw2048 = args.in[5]; F.cmem = args.in[6]; F.sconv = args.in[7]; F.sssm = args.in[8]; \
    F.norm_in_w = args.in[9]; F.w_in = args.in[10]; F.conv_w = args.in[11]; F.conv_b = args.in[12]; F.dt_bias = args.in[13]; F.a_log = args.in[14]; F.d_skip = args.in[15]; F.ssd_norm_w = args.in[16]; \
    F.mem_norm_w = args.in[17]; F.w_mem_kv = args.in[18]; F.w_br_ssd = args.in[19]; F.w_br_att = args.in[20]; F.w_br_mem = args.in[21]; F.w_out = args.in[22]; F.norm_f_w = args.in[23]; \
    F.out = args.out; \
    F.WinT = (bf16_t*)(ws + WS_WIN); F.WmemT = (bf16_t*)(ws + WS_WMEM); F.WbrT = (bf16_t*)(ws + WS_WBR); F.WoutT = (bf16_t*)(ws + WS_WOUT); \
    F.XB = (bf16_t*)(ws + WS_XB); F.MB = (bf16_t*)(ws + WS_MB); F.U = (bf16_t*)(ws + WS_U); F.MKV = (bf16_t*)(ws + WS_MKV); F.ACAT = (bf16_t*)(ws + WS_ACAT); F.MERGED = (bf16_t*)(ws + WS_MERGED); F.XC = (bf16_t*)(ws + WS_XC); \
    F.CS = (float*)(ws + WS_CS); F.DT = (float*)(ws + WS_DT); F.SSQ = (float*)(ws + WS_SSQ); F.RSQ = (float*)(ws + WS_RSQ)

template <int MODE>
__device__ __forceinline__ void transpose_item(const float* W, int N, const float* ksc, bf16_t* WT, int ldk, int koff, int kb, int nb, LAS float* scr, int lane) {
    const int k0 = 64 * kb, n0 = 32 * nb;
    int nsrc = n0 + (lane & 31);
    if (MODE == 1) nsrc = nsrc < 3072 ? nsrc : (nsrc < 12288 ? nsrc + 16 : (nsrc < 12304 ? 3072 + nsrc - 12288 : -1));
#pragma unroll 16
    for (int i = 0; i < 32; ++i) { const int kk = 2 * i + (lane >> 5); float v = 0.f; if (nsrc >= 0) v = W[(size_t)(k0 + kk) * N + nsrc]; if (ksc) v *= ksc[k0 + kk]; scr[kk * 33 + (lane & 31)] = v; }
    LDS_WAIT(); asm volatile("" ::: "memory");
    const int c = lane & 7;
#pragma unroll
    for (int j = 0; j < 4; ++j) { const int n = (lane >> 3) + 8 * j; const LAS float* s = scr + (8 * c) * 33 + n;
        u32x4 o; o.x = pk2(s[0 * 33], s[1 * 33]); o.y = pk2(s[2 * 33], s[3 * 33]); o.z = pk2(s[4 * 33], s[5 * 33]); o.w = pk2(s[6 * 33], s[7 * 33]);
        *(u32x4*)(WT + (size_t)(n0 + n) * ldk + koff + k0 + 8 * c) = o; }
    LDS_WAIT(); asm volatile("" ::: "memory");
}
template <int NR>
__device__ __forceinline__ void rms_rows_to_bf16(const float* const (&xrow)[NR], bf16_t* const (&orow)[NR], int lane) {
    f32x4 v[NR][4];
#pragma unroll
    for (int r = 0; r < NR; ++r)
#pragma unroll
        for (int j = 0; j < 4; ++j) v[r][j] = ((const f32x4*)xrow[r])[lane + 64 * j];
#pragma unroll
    for (int r = 0; r < NR; ++r) { float s = 0.f;
#pragma unroll
        for (int j = 0; j < 4; ++j) s += (v[r][j][0] * v[r][j][0] + v[r][j][1] * v[r][j][1]) + (v[r][j][2] * v[r][j][2] + v[r][j][3] * v[r][j][3]);
        const float rstd = 1.0f / sqrtf(wave_sum(s) * (1.0f / 1024.0f) + EPS);
        u32x2* o8 = (u32x2*)orow[r] + lane;
#pragma unroll
        for (int j = 0; j < 4; ++j) { u32x2 w; w.x = pk2(v[r][j][0] * rstd, v[r][j][1] * rstd); w.y = pk2(v[r][j][2] * rstd, v[r][j][3] * rstd); o8[64 * j] = w; } }
}
__device__ __forceinline__ void sincos_d(float angf, float& sn, float& cs) {
    const double a = (double)angf; const double k = rint(a * 0.15915494309189533577);
    double r = a - k * 6.283185307179586232; r -= k * 2.4492935982947064e-16;
    const double r2 = r * r; double ts = r, tc = 1.0, ss = r, sc = 1.0;
#pragma unroll 1
    for (int i = 1; i <= 14; ++i) { tc = -tc * r2 / (double)((2 * i - 1) * (2 * i)); ts = -ts * r2 / (double)((2 * i) * (2 * i + 1)); sc += tc; ss += ts; }
    sn = (float)ss; cs = (float)sc;
}
__device__ __forceinline__ void p0_prologue(Frame& F) {
    LAS float* scr = (LAS float*)(F.lds + F.wave * 16384);
    const int gw = F.vcu * NWAVES + F.wave, NGW = F.G * NWAVES, lane = F.lane;
    constexpr int I_IN = 16 * (NINP / 32), I_MEM = 16 * 32, I_B1 = 16 * 32, I_B2 = 8 * 32, I_B3 = 8 * 32, I_OUT = 16 * 32;
    constexpr int NITEMS = I_IN + I_MEM + I_B1 + I_B2 + I_B3 + I_OUT;
#ifndef P0_MASK
#define P0_MASK 7
#endif
    if (P0_MASK & 1)
    for (int it = gw; it < NITEMS; it += NGW) {
        int r = it;
        if (r < I_IN) { transpose_item<1>(F.w_in, 12304, F.norm_in_w, F.WinT, 1024, 0, r / (NINP / 32), r % (NINP / 32), scr, lane); continue; } r -= I_IN;
        if (r < I_MEM) { transpose_item<0>(F.w_mem_kv, 1024, F.mem_norm_w, F.WmemT, 1024, 0, r / 32, r % 32, scr, lane); continue; } r -= I_MEM;
        if (r < I_B1) { transpose_item<0>(F.w_br_ssd, 1024, F.ssd_norm_w, F.WbrT, 2048, 0, r / 32, r % 32, scr, lane); continue; } r -= I_B1;
        if (r < I_B2) { transpose_item<0>(F.w_br_att, 1024, nullptr, F.WbrT, 2048, 1024, r / 32, r % 32, scr, lane); continue; } r -= I_B2;
        if (r < I_B3) { transpose_item<0>(F.w_br_mem, 1024, nullptr, F.WbrT, 2048, 1536, r / 32, r % 32, scr, lane); continue; } r -= I_B3;
        transpose_item<0>(F.w_out, 1024, nullptr, F.WoutT, 1024, 0, r / 32, r % 32, scr, lane);
    }
    if (P0_MASK & 2)
    for (int m4 = gw; m4 < (RT + 2048) / 4; m4 += NGW) {
        const int m = 4 * m4; const float* xr[4]; bf16_t* orw[4];
#pragma unroll
        for (int r = 0; r < 4; ++r) {
            if (m < RP) { xr[r] = F.xp + (size_t)(m + r) * 1024; orw[r] = F.XB + (size_t)(m + r) * 1024; }
            else if (m < RT) { xr[r] = F.xs + (size_t)(m + r - RP) * 1024; orw[r] = F.XB + (size_t)(m + r) * 1024; }
            else { xr[r] = F.memp + (size_t)(m + r - RT) * 1024; orw[r] = F.MB + (size_t)(m + r - RT) * 1024; } }
        rms_rows_to_bf16<4>(xr, orw, lane);
    }
    if (P0_MASK & 4)
    for (int idx = (F.vcu * NTHREADS + F.tid); idx < 4100 * 8; idx += F.G * NTHREADS) {
        const int pi = idx >> 3, i = idx & 7; const int pos = pi < 4096 ? pi : 8192 + (pi - 4096);
        const float inv = i == 0 ? 1.0f : i == 1 ? 0.1939227432012558f : i == 2 ? 0.03760603070259094f : i == 3 ? 0.007292664609849453f : i == 4 ? 0.0014142135623842478f : i == 5 ? 0.00027424818836152554f : i == 6 ? 5.318296098266728e-05f : 1.0313386155758053e-05f;
        const float ang = (float)pos * inv; float sn, cs; sincos_d(ang, sn, cs);
        F.CS[(size_t)pi * 16 + i] = cs; F.CS[(size_t)pi * 16 + 8 + i] = sn;
    }
}


__device__ __forceinline__ void p1c_conv(Frame& F) {
    const int gt = F.vcu * NTHREADS + F.tid, cg = gt & 255, rbi = gt >> 8, nrb = (F.G * NTHREADS) >> 8;
    f32x4 w0[4], w1[4];
#pragma unroll
    for (int kk = 0; kk < 4; ++kk) { w0[kk] = *(const f32x4*)(F.conv_w + kk * 2048 + 8 * cg); w1[kk] = *(const f32x4*)(F.conv_w + kk * 2048 + 8 * cg + 4); }
    const f32x4 b0 = *(const f32x4*)(F.conv_b + 8 * cg), b1 = *(const f32x4*)(F.conv_b + 8 * cg + 4);
    for (int rb = rbi; rb < RT / 4; rb += nrb) {
        const int row = 4 * rb; const bool samp = row >= RP;
        f32x4 x0[7], x1[7];
#pragma unroll
        for (int k = 0; k < 7; ++k) {
            x0[k] = (f32x4){0.f, 0.f, 0.f, 0.f}; x1[k] = x0[k];
            if (k >= 3 || (!samp && (row & 4095) != 0)) { const u32x4 xr = *(const u32x4*)(F.U + (size_t)(row - 3 + k) * LDU + U_XBC + 8 * cg);
                x0[k] = (f32x4){__uint_as_float(xr.x << 16), __uint_as_float(xr.x & 0xffff0000u), __uint_as_float(xr.y << 16), __uint_as_float(xr.y & 0xffff0000u)};
                x1[k] = (f32x4){__uint_as_float(xr.z << 16), __uint_as_float(xr.z & 0xffff0000u), __uint_as_float(xr.w << 16), __uint_as_float(xr.w & 0xffff0000u)}; }
            else if (samp) { const float* sp = F.sconv + (size_t)(((row - RP) >> 2) * 3 + k) * 2048 + 8 * cg; x0[k] = *(const f32x4*)sp; x1[k] = *(const f32x4*)(sp + 4); }
        }
#pragma unroll
        for (int r = 0; r < 4; ++r) { f32x4 a0 = b0, a1 = b1;
#pragma unroll
            for (int kk = 0; kk < 4; ++kk) { a0 += w0[kk] * x0[r + kk]; a1 += w1[kk] * x1[r + kk]; }
#pragma unroll
            for (int e = 0; e < 4; ++e) { a0[e] = silu_f(a0[e]); a1[e] = silu_f(a1[e]); }
            u32x4 o; o.x = pk2(a0[0], a0[1]); o.y = pk2(a0[2], a0[3]); o.z = pk2(a1[0], a1[1]); o.w = pk2(a1[2], a1[3]);
            *(u32x4*)(F.XC + (size_t)(row + r) * 2048 + 8 * cg) = o; }
    }
    const int lane = F.lane, fr = lane & 15, fq = lane >> 4;
    for (int tile = F.vcu * NWAVES + F.wave; tile < RT / 16; tile += F.G * NWAVES) {
        const bf16_t* ap = F.XB + (size_t)(16 * tile + fr) * 1024 + 8 * fq; const bf16_t* bp = F.WinT + (size_t)(12288 + fr) * 1024 + 8 * fq;
        f32x4 d = (f32x4){0.f, 0.f, 0.f, 0.f};
#pragma unroll 8
        for (int ks = 0; ks < 32; ++ks) d = __builtin_amdgcn_mfma_f32_16x16x32_bf16(*(const bf16x8*)(ap + 32 * ks), *(const bf16x8*)(bp + 32 * ks), d, 0, 0, 0);
#pragma unroll
        for (int v = 0; v < 4; ++v) F.DT[(size_t)(16 * tile + 4 * fq + v) * 16 + fr] = d[v];
    }
}

__device__ __forceinline__ float dot64_bf16(const bf16_t* kp, const LAS float* q) {
    float s = 0.f;
#pragma unroll
    for (int c = 0; c < 8; ++c) { const u32x4 w = *(const u32x4*)(kp + 8 * c); const f32x4 q0 = *(const LAS f32x4*)(q + 8 * c), q1 = *(const LAS f32x4*)(q + 8 * c + 4);
        s += __uint_as_float(w.x << 16) * q0[0] + __uint_as_float(w.x & 0xffff0000u) * q0[1] + __uint_as_float(w.y << 16) * q0[2] + __uint_as_float(w.y & 0xffff0000u) * q0[3]
           + __uint_as_float(w.z << 16) * q1[0] + __uint_as_float(w.z & 0xffff0000u) * q1[1] + __uint_as_float(w.w << 16) * q1[2] + __uint_as_float(w.w & 0xffff0000u) * q1[3]; }
    return s;
}
__device__ __forceinline__ float dot64_f32(const float* kp, const LAS float* q) {
    float s = 0.f;
#pragma unroll
    for (int c = 0; c < 16; ++c) { const f32x4 w = *(const f32x4*)(kp + 4 * c); const f32x4 q0 = *(const LAS f32x4*)(q + 4 * c); s += w[0] * q0[0] + w[1] * q0[1] + w[2] * q0[2] + w[3] * q0[3]; }
    return s;
}
typedef float f32x16 __attribute__((ext_vector_type(16)));
typedef short s16x4 __attribute__((ext_vector_type(4)));
typedef short v4i16_t __attribute__((ext_vector_type(4)));
typedef __bf16 bf16x2_t __attribute__((ext_vector_type(2)));
typedef float f32x2_t __attribute__((ext_vector_type(2)));
__device__ __forceinline__ unsigned cvtpk(float lo, float hi) { f32x2_t v = {lo, hi}; bf16x2_t b = __builtin_convertvector(v, bf16x2_t); return __builtin_bit_cast(unsigned, b); }
__device__ __forceinline__ s16x4 vtr(const LAS char* p) { return __builtin_bit_cast(s16x4, __builtin_amdgcn_ds_read_tr16_b64_v4i16((LAS v4i16_t*)p)); }
#define MFMA32(a, b, c) __builtin_amdgcn_mfma_f32_32x32x16_bf16((a), (b), (c), 0, 0, 0)
constexpr float L2E = 1.4426950408889634f;

template <int HD, bool MASK, bool DEEP>
__device__ __forceinline__ void att_tile_range(f32x16 (&o)[HD / 32], float& mrun, float& lrun, const bf16x8 (&qf)[HD / 16], const bf16_t* kp, const bf16_t* vp, size_t kstride, int ntiles, int rel0, float sl2e, LAS char* vl, int lane) {
    constexpr int NS = HD / 16, RSB = HD * 2 + 64, CPR = HD / 8, RPI = 64 / CPR;
    const int h = lane >> 5;
    const LAS char* trb = vl + (4 * h + ((lane & 15) >> 2)) * RSB + 32 * ((lane >> 4) & 1) + 8 * (lane & 3);
    LAS char* wrb = vl + (lane / CPR) * RSB + (lane % CPR) * 16;
    bf16x8 ka[NS], kb[DEEP ? NS : 1]; u32x4 va[NS];
#define ATT_LDK(dst, t_) do { const bf16_t* kq_ = kp + (size_t)(t_) * 32 * kstride; _Pragma("unroll") for (int s = 0; s < NS; ++s) dst[s] = *(const bf16x8*)(kq_ + 16 * s); } while (0)
#define ATT_LDV(dst, t_) do { const bf16_t* vq_ = vp + (size_t)(t_) * 32 * kstride; _Pragma("unroll") for (int s = 0; s < NS; ++s) dst[s] = *(const u32x4*)(vq_ + (size_t)(RPI * s) * kstride); } while (0)
#define ATT_STV(src) do { _Pragma("unroll") for (int s = 0; s < NS; ++s) *(LAS u32x4*)(wrb + (RPI * s) * RSB) = src[s]; } while (0)
#define ATT_STEP(KU, VN, VW, KAHEAD, VAHEAD) do { \
        if (kt + (VAHEAD) < ntiles) ATT_LDV(VN, kt + (VAHEAD)); \
        f32x16 sc; \
        _Pragma("unroll") for (int v = 0; v < 16; ++v) sc[v] = 0.f; \
        _Pragma("unroll") for (int s = 0; s < NS; ++s) sc = MFMA32(KU[s], qf[s], sc); \
        if (kt + (KAHEAD) < ntiles) ATT_LDK(KU, kt + (KAHEAD)); \
        float tmax = -1e30f; \
        if (MASK && (kt == 0 || kt + 1 == ntiles)) { \
            _Pragma("unroll") for (int v = 0; v < 16; ++v) { float y = sc[v] * sl2e; const int rel = rel0 - 32 * kt - ((v & 3) + 8 * (v >> 2)); if ((unsigned)rel > 128u) y = -1e30f; sc[v] = y; tmax = fmaxf(tmax, y); } \
        } else { \
            _Pragma("unroll") for (int v = 0; v < 16; ++v) { const float y = sc[v] * sl2e; sc[v] = y; tmax = fmaxf(tmax, y); } \
        } \
        tmax = fmaxf(tmax, __shfl_xor(tmax, 32)); \
        const float mnew = fmaxf(mrun, tmax); \
        if (__any(mnew > mrun)) { const float alpha = __builtin_amdgcn_exp2f(mrun - mnew); \
            _Pragma("unroll") for (int mt = 0; mt < HD / 32; ++mt) o[mt] = o[mt] * alpha; \
            lrun *= alpha; mrun = mnew; } \
        float ps = 0.f; unsigned pk[8]; \
        _Pragma("unroll") for (int v = 0; v < 16; v += 2) { const float p0 = __builtin_amdgcn_exp2f(sc[v] - mrun), p1 = __builtin_amdgcn_exp2f(sc[v + 1] - mrun); ps += p0 + p1; pk[v >> 1] = cvtpk(p0, p1); } \
        lrun += ps; \
        const bf16x8 pf0 = __builtin_bit_cast(bf16x8, (u32x4){pk[0], pk[1], pk[2], pk[3]}), pf1 = __builtin_bit_cast(bf16x8, (u32x4){pk[4], pk[5], pk[6], pk[7]}); \
        _Pragma("unroll") for (int mt = 0; mt < HD / 32; ++mt) { \
            const s16x4 a0 = vtr(trb + 64 * mt), a1 = vtr(trb + 8 * RSB + 64 * mt), a2 = vtr(trb + 16 * RSB + 64 * mt), a3 = vtr(trb + 24 * RSB + 64 * mt); \
            o[mt] = MFMA32(__builtin_shufflevector(a0, a1, 0, 1, 2, 3, 4, 5, 6, 7), pf0, o[mt]); \
            o[mt] = MFMA32(__builtin_shufflevector(a2, a3, 0, 1, 2, 3, 4, 5, 6, 7), pf1, o[mt]); } \
        if (kt + 1 < ntiles) ATT_STV(VW); } while (0)
    ATT_LDK(ka, 0); ATT_LDV(va, 0);
    ATT_STV(va);
    if (DEEP) {
        if (ntiles > 1) ATT_LDK(kb, 1);
#pragma unroll 1
        for (int kt = 0; kt < ntiles; ++kt) {
            ATT_STEP(ka, va, va, 2, 1);
            if (++kt >= ntiles) break;
            ATT_STEP(kb, va, va, 2, 1);
        }
    } else {
#pragma unroll 1
        for (int kt = 0; kt < ntiles; ++kt) ATT_STEP(ka, va, va, 1, 1);
    }
#undef ATT_LDK
#undef ATT_LDV
#undef ATT_STV
#undef ATT_STEP
}
__device__ __forceinline__ void att_tile_pair(f32x16 (&oa)[2], f32x16 (&ob)[2], float& ma, float& la, float& mb, float& lb, const bf16x8 (&qa)[4], const bf16x8 (&qb)[4],
                                              const bf16_t* kp, const bf16_t* vp, size_t kstride, int ntiles, int dq  , LAS char* vl, int lane) {
    constexpr int RSB = 192;
    const int h = lane >> 5, c = lane & 31;
    const LAS char* trb = vl + (4 * h + ((lane & 15) >> 2)) * RSB + 32 * ((lane >> 4) & 1) + 8 * (lane & 3);
    LAS char* wrb = vl + (lane >> 3) * RSB + (lane & 7) * 16;
    bf16x8 kf[4]; u32x4 vr[4];
#pragma unroll
    for (int s = 0; s < 4; ++s) { kf[s] = *(const bf16x8*)(kp + 16 * s); vr[s] = *(const u32x4*)(vp + (size_t)(8 * s) * kstride); }
#pragma unroll
    for (int s = 0; s < 4; ++s) *(LAS u32x4*)(wrb + (8 * s) * RSB) = vr[s];
#pragma unroll 1
    for (int kt = 0; kt < ntiles; ++kt) {
        const bool more = kt + 1 < ntiles;
        if (more) { const bf16_t* vq_ = vp + (size_t)(kt + 1) * 32 * kstride;
#pragma unroll
            for (int s = 0; s < 4; ++s) vr[s] = *(const u32x4*)(vq_ + (size_t)(8 * s) * kstride); }
        const int hiA = dq + 31 - 32 * kt, loA = dq - 32 * kt - 31, hiB = hiA + 32, loB = loA + 32;
        const bool useA = hiA >= 0 && loA <= 128, useB = hiB >= 0 && loB <= 128, mskA = !(loA >= 0 && hiA <= 128), mskB = !(loB >= 0 && hiB <= 128);
        f32x16 sa, sb;
#pragma unroll
        for (int v = 0; v < 16; ++v) { sa[v] = 0.f; sb[v] = 0.f; }
        if (useA) {
#pragma unroll
            for (int s = 0; s < 4; ++s) sa = MFMA32(kf[s], qa[s], sa); }
        if (useB) {
#pragma unroll
            for (int s = 0; s < 4; ++s) sb = MFMA32(kf[s], qb[s], sb); }
        if (more) { const bf16_t* kq_ = kp + (size_t)(kt + 1) * 32 * kstride;
#pragma unroll
            for (int s = 0; s < 4; ++s) kf[s] = *(const bf16x8*)(kq_ + 16 * s); }
        bf16x8 pa0, pa1, pb0, pb1;
#define ATT_SOFTMAX(SC, MSK, REL0, M, Lr, O, P0, P1) do { float tmax = -1e30f; \
            if (MSK) { _Pragma("unroll") for (int v = 0; v < 16; ++v) { float y = SC[v] * L2E; const int rel = (REL0) - ((v & 3) + 8 * (v >> 2)); if ((unsigned)rel > 128u) y = -1e30f; SC[v] = y; tmax = fmaxf(tmax, y); } } \
            else { _Pragma("unroll") for (int v = 0; v < 16; ++v) { const float y = SC[v] * L2E; SC[v] = y; tmax = fmaxf(tmax, y); } } \
            tmax = fmaxf(tmax, __shfl_xor(tmax, 32)); \
            const float mnew = fmaxf(M, tmax); \
            if (__any(mnew > M)) { const float alpha = __builtin_amdgcn_exp2f(M - mnew); O[0] = O[0] * alpha; O[1] = O[1] * alpha; Lr *= alpha; M = mnew; } \
            float ps = 0.f; unsigned pk[8]; \
            _Pragma("unroll") for (int v = 0; v < 16; v += 2) { const float p0 = __builtin_amdgcn_exp2f(SC[v] - M), p1 = __builtin_amdgcn_exp2f(SC[v + 1] - M); ps += p0 + p1; pk[v >> 1] = cvtpk(p0, p1); } \
            Lr += ps; \
            P0 = __builtin_bit_cast(bf16x8, (u32x4){pk[0], pk[1], pk[2], pk[3]}); P1 = __builtin_bit_cast(bf16x8, (u32x4){pk[4], pk[5], pk[6], pk[7]}); } while (0)
        const int relA = dq + c - 4 * h - 32 * kt;
        if (useA) ATT_SOFTMAX(sa, mskA, relA, ma, la, oa, pa0, pa1);
        if (useB) ATT_SOFTMAX(sb, mskB, relA + 32, mb, lb, ob, pb0, pb1);
#undef ATT_SOFTMAX
#pragma unroll
        for (int mt = 0; mt < 2; ++mt) {
            const s16x4 a0 = vtr(trb + 64 * mt), a1 = vtr(trb + 8 * RSB + 64 * mt), a2 = vtr(trb + 16 * RSB + 64 * mt), a3 = vtr(trb + 24 * RSB + 64 * mt);
            const bf16x8 v0 = __builtin_shufflevector(a0, a1, 0, 1, 2, 3, 4, 5, 6, 7), v1 = __builtin_shufflevector(a2, a3, 0, 1, 2, 3, 4, 5, 6, 7);
            if (useA) { oa[mt] = MFMA32(v0, pa0, oa[mt]); oa[mt] = MFMA32(v1, pa1, oa[mt]); }
            if (useB) { ob[mt] = MFMA32(v0, pb0, ob[mt]); ob[mt] = MFMA32(v1, pb1, ob[mt]); }
        }
        if (more) {
#pragma unroll
            for (int s = 0; s < 4; ++s) *(LAS u32x4*)(wrb + (8 * s) * RSB) = vr[s]; }
    }
}
template <int HD>
__device__ __forceinline__ void att_store(const f32x16 (&o)[HD / 32], float lrun, const bf16_t* zrow, bf16_t* orow, int lane) {
    const int h = lane >> 5;
    const float inv = 1.0f / (lrun + __shfl_xor(lrun, 32));
#pragma unroll
    for (int mt = 0; mt < HD / 32; ++mt)
#pragma unroll
        for (int vq = 0; vq < 4; ++vq) {
            const int d = 32 * mt + 8 * vq + 4 * h;
            const u32x2 zz = *(const u32x2*)(zrow + d);
            const float z0 = __uint_as_float(zz.x << 16), z1 = __uint_as_float(zz.x & 0xffff0000u), z2 = __uint_as_float(zz.y << 16), z3 = __uint_as_float(zz.y & 0xffff0000u);
            u32x2 w; w.x = cvtpk(o[mt][4 * vq] * inv * silu_f(z0), o[mt][4 * vq + 1] * inv * silu_f(z1)); w.y = cvtpk(o[mt][4 * vq + 2] * inv * silu_f(z2), o[mt][4 * vq + 3] * inv * silu_f(z3));
            *(u32x2*)(orow + d) = w;
        }
}
constexpr int ATT_ST_OFF = 8 * 6144, ATT_ST_PITCH = 144;
template <int PHASE  >
__device__ __forceinline__ void att_merge(Frame& F, f32x16 (&o)[2], float mrun, float lrun, LAS char* strow, const bf16_t* zrow, bf16_t* orow, int lane) {
    const int h = lane >> 5;
    float lu = lrun + __shfl_xor(lrun, 32), au = 1.0f, as = 0.f, m = mrun;
    if (PHASE > 0) { const f32x2 ml = *(const LAS f32x2*)(strow + 128); m = fmaxf(ml[0], mrun); as = __builtin_amdgcn_exp2f(ml[0] - m); au = __builtin_amdgcn_exp2f(mrun - m); lu = ml[1] * as + lu * au; }
    const float inv = 1.0f / lu;
#pragma unroll
    for (int mt = 0; mt < 2; ++mt)
#pragma unroll
        for (int vq = 0; vq < 4; ++vq) {
            const int d = 32 * mt + 8 * vq + 4 * h;
            float v0 = o[mt][4 * vq] * au, v1 = o[mt][4 * vq + 1] * au, v2 = o[mt][4 * vq + 2] * au, v3 = o[mt][4 * vq + 3] * au;
            if (PHASE > 0) { const u32x2 os = *(const LAS u32x2*)(strow + 2 * d);
                v0 += __uint_as_float(os.x << 16) * as; v1 += __uint_as_float(os.x & 0xffff0000u) * as; v2 += __uint_as_float(os.y << 16) * as; v3 += __uint_as_float(os.y & 0xffff0000u) * as; }
            if (PHASE < 2) { u32x2 w; w.x = cvtpk(v0, v1); w.y = cvtpk(v2, v3); *(LAS u32x2*)(strow + 2 * d) = w; }
            else { const u32x2 zz = *(const u32x2*)(zrow + d);
                const float z0 = __uint_as_float(zz.x << 16), z1 = __uint_as_float(zz.x & 0xffff0000u), z2 = __uint_as_float(zz.y << 16), z3 = __uint_as_float(zz.y & 0xffff0000u);
                u32x2 w; w.x = cvtpk(v0 * inv * silu_f(z0), v1 * inv * silu_f(z1)); w.y = cvtpk(v2 * inv * silu_f(z2), v3 * inv * silu_f(z3)); *(u32x2*)(orow + d) = w; }
        }
    if (PHASE < 2 && h == 0) *(LAS f32x2*)(strow + 128) = (f32x2){m, lu};
}
template <int PHASE>
__device__ __forceinline__ void att_prompt_unit(Frame& F, int b, int head, int J, int u, LAS char* vl) {
    constexpr int g = 2 - PHASE, lg = 2 * g, dil = 1 << lg;
    const int lane = F.lane, c = lane & 31, h = lane >> 5;
    const int rg = PHASE == 0 ? u : (PHASE == 1 ? (u & 3) : 0), k = PHASE == 0 ? 0 : (PHASE == 1 ? (u >> 2) : u);
    const int tl = ((32 * k + c) << lg) + rg, tc = 512 * J + tl; const size_t rowc = (size_t)b * 4096 + tc;
    const int qoff = U_QKV + g * 1536 + head * 64;
    bf16x8 qf[4];
#pragma unroll
    for (int s = 0; s < 4; ++s) qf[s] = *(const bf16x8*)(F.U + rowc * LDU + qoff + 16 * s + 8 * h);
    const int qi0 = ((512 * J) >> lg) + 32 * k, ks = qi0 >= 128 ? qi0 - 128 : 0, ntiles = ((qi0 - ks) >> 5) + 1;
    const size_t kstride = (size_t)dil * LDU;
    const bf16_t* base = F.U + ((size_t)b * 4096 + (size_t)ks * dil + rg) * LDU + qoff;
    f32x16 o[2];
#pragma unroll
    for (int v = 0; v < 16; ++v) { o[0][v] = 0.f; o[1][v] = 0.f; }
    float mrun = -1e29f, lrun = 0.f;
    att_tile_range<64, true, true>(o, mrun, lrun, qf, base + 512 + (size_t)c * kstride + 8 * h, base + 1024 + (size_t)(lane >> 3) * kstride + (lane & 7) * 8, kstride, ntiles, qi0 + c - ks - 4 * h, L2E, vl, lane);
    att_merge<PHASE>(F, o, mrun, lrun, (LAS char*)F.lds + ATT_ST_OFF + tl * ATT_ST_PITCH, F.U + rowc * LDU + U_ZA + head * 64, F.ACAT + rowc * LDA + 1024 + head * 64, lane);
}
template <int PHASE>
__device__ __forceinline__ void att_prompt_pair(Frame& F, int b, int head, int J, int u, LAS char* vl) {
    constexpr int g = 2 - PHASE, lg = 2 * g, dil = 1 << lg;
    const int lane = F.lane, c = lane & 31, h = lane >> 5;
    const int rg = PHASE == 1 ? (u & 3) : 0, kpair = PHASE == 1 ? (u >> 2) : u;
    const int tlA = ((64 * kpair + c) << lg) + rg, tlB = ((64 * kpair + 32 + c) << lg) + rg;
    const size_t rowA = (size_t)b * 4096 + 512 * J + tlA, rowB = (size_t)b * 4096 + 512 * J + tlB;
    const int qoff = U_QKV + g * 1536 + head * 64;
    bf16x8 qa[4], qb[4];
#pragma unroll
    for (int s = 0; s < 4; ++s) { qa[s] = *(const bf16x8*)(F.U + rowA * LDU + qoff + 16 * s + 8 * h); qb[s] = *(const bf16x8*)(F.U + rowB * LDU + qoff + 16 * s + 8 * h); }
    const int qi0 = ((512 * J) >> lg) + 64 * kpair, ks = qi0 >= 128 ? qi0 - 128 : 0, ntiles = ((qi0 + 32 - ks) >> 5) + 1;
    const size_t kstride = (size_t)dil * LDU;
    const bf16_t* base = F.U + ((size_t)b * 4096 + (size_t)ks * dil + rg) * LDU + qoff;
    f32x16 oa[2], ob[2];
#pragma unroll
    for (int v = 0; v < 16; ++v) { oa[0][v] = 0.f; oa[1][v] = 0.f; ob[0][v] = 0.f; ob[1][v] = 0.f; }
    float ma = -1e29f, la = 0.f, mb = -1e29f, lb = 0.f;
    att_tile_pair(oa, ob, ma, la, mb, lb, qa, qb, base + 512 + (size_t)c * kstride + 8 * h, base + 1024 + (size_t)(lane >> 3) * kstride + (lane & 7) * 8, kstride, ntiles, qi0 - ks, vl, lane);
    att_merge<PHASE>(F, oa, ma, la, (LAS char*)F.lds + ATT_ST_OFF + tlA * ATT_ST_PITCH, F.U + rowA * LDU + U_ZA + head * 64, F.ACAT + rowA * LDA + 1024 + head * 64, lane);
    att_merge<PHASE>(F, ob, mb, lb, (LAS char*)F.lds + ATT_ST_OFF + tlB * ATT_ST_PITCH, F.U + rowB * LDU + U_ZA + head * 64, F.ACAT + rowB * LDA + 1024 + head * 64, lane);
}
__device__ __forceinline__ void att_prompt_item(Frame& F, int b, int head, int J, LAS char* vl) {
#pragma unroll 1
    for (int u = 2 * F.wave; u < 2 * F.wave + 2; ++u) att_prompt_unit<0>(F, b, head, J, u, vl);
    __syncthreads();
    att_prompt_pair<1>(F, b, head, J, F.wave, vl);
    __syncthreads();
    att_prompt_pair<2>(F, b, head, J, F.wave, vl);
}
__device__ __forceinline__ void mem_prompt_item(Frame& F, int b, int head, int q0) {
    constexpr int KP = 272, VP = 320, STG = 32 * KP + 32 * VP;
    const int tid = F.tid, lane = F.lane, w = F.wave, c = lane & 31, h = lane >> 5;
    LAS char* L = (LAS char*)F.lds;
    const size_t rowc = (size_t)b * 4096 + q0 + 32 * w + c;
    bf16x8 qf[8];
#pragma unroll
    for (int s = 0; s < 8; ++s) qf[s] = *(const bf16x8*)(F.U + rowc * LDU + U_QM + head * 128 + 16 * s + 8 * h);
    const int pr = tid >> 4, pc = tid & 15;
    const bf16_t* ksrc = F.MKV + ((size_t)b * 256 + pr) * 1024 + head * 128 + 8 * pc;
    LAS char* kdst = L + pr * KP + 16 * pc; LAS char* vdst = L + 32 * KP + pr * VP + 16 * pc;
    f32x16 o[4];
#pragma unroll
    for (int v = 0; v < 16; ++v) { o[0][v] = 0.f; o[1][v] = 0.f; o[2][v] = 0.f; o[3][v] = 0.f; }
    float mrun = -1e29f, lrun = 0.f;
    const float sl2e = 0.08838834764831845f * L2E;
    u32x4 ka, va, kb, vb;
    ka = *(const u32x4*)ksrc; va = *(const u32x4*)(ksrc + 512);
    kb = *(const u32x4*)(ksrc + 32 * 1024); vb = *(const u32x4*)(ksrc + 32 * 1024 + 512);
    *(LAS u32x4*)kdst = ka; *(LAS u32x4*)vdst = va;
    __syncthreads();
    const LAS char* krd = L + c * KP + 16 * h;
    const LAS char* trb = L + 32 * KP + (4 * h + ((lane & 15) >> 2)) * VP + 32 * ((lane >> 4) & 1) + 8 * (lane & 3);
#define MEM_STEP(RN, RW_K, RW_V) do { const int so = (kt & 1) * STG; \
        if (kt + 2 < 8) { RN##a_ = *(const u32x4*)(ksrc + (size_t)(kt + 2) * 32 * 1024); RN##b_ = *(const u32x4*)(ksrc + (size_t)(kt + 2) * 32 * 1024 + 512); } \
        f32x16 sc; \
        _Pragma("unroll") for (int v = 0; v < 16; ++v) sc[v] = 0.f; \
        _Pragma("unroll") for (int s = 0; s < 8; ++s) { const bf16x8 kf = *(const LAS bf16x8*)(krd + so + 32 * s); sc = MFMA32(kf, qf[s], sc); } \
        float tmax = -1e30f; \
        _Pragma("unroll") for (int v = 0; v < 16; ++v) { const float y = sc[v] * sl2e; sc[v] = y; tmax = fmaxf(tmax, y); } \
        tmax = fmaxf(tmax, __shfl_xor(tmax, 32)); \
        const float mnew = fmaxf(mrun, tmax); \
        if (__any(mnew > mrun)) { const float alpha = __builtin_amdgcn_exp2f(mrun - mnew); \
            _Pragma("unroll") for (int mt = 0; mt < 4; ++mt) o[mt] = o[mt] * alpha; \
            lrun *= alpha; mrun = mnew; } \
        float ps = 0.f; unsigned pk[8]; \
        _Pragma("unroll") for (int v = 0; v < 16; v += 2) { const float p0 = __builtin_amdgcn_exp2f(sc[v] - mrun), p1 = __builtin_amdgcn_exp2f(sc[v + 1] - mrun); ps += p0 + p1; pk[v >> 1] = cvtpk(p0, p1); } \
        lrun += ps; \
        const bf16x8 pf0 = __builtin_bit_cast(bf16x8, (u32x4){pk[0], pk[1], pk[2], pk[3]}), pf1 = __builtin_bit_cast(bf16x8, (u32x4){pk[4], pk[5], pk[6], pk[7]}); \
        _Pragma("unroll") for (int mt = 0; mt < 4; ++mt) { \
            const s16x4 a0 = vtr(trb + so + 64 * mt), a1 = vtr(trb + so + 8 * VP + 64 * mt), a2 = vtr(trb + so + 16 * VP + 64 * mt), a3 = vtr(trb + so + 24 * VP + 64 * mt); \
            o[mt] = MFMA32(__builtin_shufflevector(a0, a1, 0, 1, 2, 3, 4, 5, 6, 7), pf0, o[mt]); \
            o[mt] = MFMA32(__builtin_shufflevector(a2, a3, 0, 1, 2, 3, 4, 5, 6, 7), pf1, o[mt]); } \
        if (kt + 1 < 8) { *(LAS u32x4*)(kdst + (STG - so)) = RW_K; *(LAS u32x4*)(vdst + (STG - so)) = RW_V; } \
        __syncthreads(); } while (0)
    u32x4 Aa_, Ab_, Ba_, Bb_;
    Ba_ = kb; Bb_ = vb;
#pragma unroll 1
    for (int kt = 0; kt < 8; kt += 2) {
        MEM_STEP(A, Ba_, Bb_);
        { const int kt_ = kt; (void)kt_; }
        { int ktn = kt + 1; const int kt = ktn; MEM_STEP(B, Aa_, Ab_); }
    }
#undef MEM_STEP
    att_store<128>(o, lrun, F.U + rowc * LDU + U_ZM + head * 128, F.ACAT + rowc * LDA + 1536 + head * 128, lane);
}
__device__ __forceinline__ void ssd_prompt_unit(Frame& F, int b, int h) {
    constexpr int XP = 192, BP = 320, CP = 272, IMG = 2 * 64 * XP + 64 * BP  , XWO = 64 * XP, BIO = 2 * 64 * XP, S0 = 2 * IMG, S1 = S0 + 64 * CP, ARR = S1 + 64 * CP;
    const int tid = F.tid, lane = F.lane, w = F.wave, g = h >> 2, c32 = lane & 31, hh = lane >> 5;
    LAS char* L = (LAS char*)F.lds;
    for (int idx = tid; idx < 64 * CP / 4; idx += NTHREADS) ((LAS unsigned*)(L + S0))[idx] = 0u;
    const float a = -__expf(F.a_log[h]), dsk = F.d_skip[h], dtb = F.dt_bias[h];
    const size_t row0 = (size_t)b * 4096;
    const int xr = tid >> 3, xc8 = tid & 7, br = tid >> 4, bc8 = tid & 15;
    const bf16_t* xsrc = F.XC + (row0 + xr) * 2048 + h * 64 + 8 * xc8;
    const bf16_t* bsrc = F.XC + (row0 + br) * 2048 + 1024 + g * 128 + 8 * bc8;
    const bf16_t* csrc = F.XC + row0 * 2048 + 1536 + g * 128 + 8 * hh;
    const int pt = (w >> 1) & 1, j = w & 1;
    const int pt2 = (w >> 1) & 1, ntb = 2 * (w & 1);
    const int q4 = (lane & 15) >> 2, p4 = lane & 3, blk = (lane >> 4) & 1;
    u32x4 rx, rb0, rb1; float dtraw; bf16x8 cf[8];
#define SSD_LOAD(cc) do { const size_t ro = (size_t)(64 * (cc)) * 2048; rx = *(const u32x4*)(xsrc + ro); rb0 = *(const u32x4*)(bsrc + ro); rb1 = *(const u32x4*)(bsrc + ro + 32 * 2048); \
        dtraw = F.DT[(row0 + 64 * (cc) + lane) * 16 + h]; \
        if (w < 4) { _Pragma("unroll") for (int ks = 0; ks < 8; ++ks) cf[ks] = *(const bf16x8*)(csrc + ro + (size_t)(32 * j + c32) * 2048 + 16 * ks); } } while (0)
#define SSD_PREP(cc) do { LAS float* arr_ = (LAS float*)(L + ARR + ((cc) & 1) * 1024); LAS char* I_ = L + ((cc) & 1) * IMG; \
        const float xx = dtraw + dtb; const float dt = xx > 20.f ? xx : log1pf(__expf(xx)); \
        float acs = dt * a; \
        _Pragma("unroll") for (int o = 1; o < 64; o <<= 1) { const float up = __shfl_up(acs, o); if (lane >= o) acs += up; } \
        const float last = __shfl(acs, 63); const float wd = dt * __expf(last - acs); \
        arr_[lane] = acs * L2E; arr_[64 + lane] = (acs - __logf(dt)) * L2E; arr_[128 + lane] = __expf(acs); \
        const float wdx = __shfl(wd, xr); \
        *(LAS u32x4*)(I_ + xr * XP + 16 * xc8) = rx; \
        { u32x4 o_; o_.x = cvtpk(__uint_as_float(rx.x << 16) * wdx, __uint_as_float(rx.x & 0xffff0000u) * wdx); o_.y = cvtpk(__uint_as_float(rx.y << 16) * wdx, __uint_as_float(rx.y & 0xffff0000u) * wdx); \
          o_.z = cvtpk(__uint_as_float(rx.z << 16) * wdx, __uint_as_float(rx.z & 0xffff0000u) * wdx); o_.w = cvtpk(__uint_as_float(rx.w << 16) * wdx, __uint_as_float(rx.w & 0xffff0000u) * wdx); \
          *(LAS u32x4*)(I_ + XWO + xr * XP + 16 * xc8) = o_; } \
        *(LAS u32x4*)(I_ + BIO + br * BP + 16 * bc8) = rb0; *(LAS u32x4*)(I_ + BIO + (32 + br) * BP + 16 * bc8) = rb1; } while (0)
    SSD_LOAD(0);
    f32x16 st0, st1;
#pragma unroll
    for (int v = 0; v < 16; ++v) { st0[v] = 0.f; st1[v] = 0.f; }
    bf16x8 cc_[8];
    SSD_PREP(0);
#pragma unroll
    for (int ks = 0; ks < 8; ++ks) cc_[ks] = cf[ks];
    __syncthreads();
#pragma unroll 1
    for (int c = 0; c < 64; ++c) {
        const LAS float* arr = (const LAS float*)(L + ARR + (c & 1) * 1024);
        const LAS char* I = L + (c & 1) * IMG;
        const LAS char* Scur = L + ((c & 1) ? S1 : S0); LAS char* Snxt = L + ((c & 1) ? S0 : S1);
        if (c + 1 < 64) SSD_LOAD(c + 1);
        if (w < 4) {
            const int l = 32 * j + c32; const size_t row = row0 + 64 * c + l;
            u32x2 zz[4];
#pragma unroll
            for (int vq = 0; vq < 4; ++vq) zz[vq] = *(const u32x2*)(F.U + row * LDU + U_Z + h * 64 + 32 * pt + 8 * vq + 4 * hh);
            f32x16 acc;
#pragma unroll
            for (int v = 0; v < 16; ++v) acc[v] = 0.f;
#pragma unroll
            for (int ks = 0; ks < 8; ++ks) { const bf16x8 sa = *(const LAS bf16x8*)(Scur + (32 * pt + c32) * CP + (16 * ks + 8 * hh) * 2); acc = MFMA32(sa, cc_[ks], acc); }
            const float al = arr[l];
            acc = acc * arr[128 + l];
#pragma unroll 1
            for (int i = 0; i <= j; ++i) {
                f32x16 cb;
#pragma unroll
                for (int v = 0; v < 16; ++v) cb[v] = 0.f;
#pragma unroll
                for (int ks = 0; ks < 8; ++ks) { const bf16x8 ba = *(const LAS bf16x8*)(I + BIO + (32 * i + c32) * BP + (16 * ks + 8 * hh) * 2); cb = MFMA32(ba, cc_[ks], cb); }
                unsigned pk[8];
#pragma unroll
                for (int vq = 0; vq < 4; ++vq) {
                    const f32x4 es = *(const LAS f32x4*)(arr + 64 + 32 * i + 8 * vq + 4 * hh);
                    float m[4];
#pragma unroll
                    for (int e = 0; e < 4; ++e) { m[e] = cb[4 * vq + e] * __builtin_amdgcn_exp2f(al - es[e]); if (i == j && (8 * vq + 4 * hh + e) > c32) m[e] = 0.f; }
                    pk[2 * vq] = cvtpk(m[0], m[1]); pk[2 * vq + 1] = cvtpk(m[2], m[3]);
                }
                const bf16x8 pf0 = __builtin_bit_cast(bf16x8, (u32x4){pk[0], pk[1], pk[2], pk[3]}), pf1 = __builtin_bit_cast(bf16x8, (u32x4){pk[4], pk[5], pk[6], pk[7]});
                const LAS char* xb = I + (32 * i + 4 * hh + q4) * XP + (32 * pt + 16 * blk + 4 * p4) * 2;
                const s16x4 a0 = vtr(xb), a1 = vtr(xb + 8 * XP), a2 = vtr(xb + 16 * XP), a3 = vtr(xb + 24 * XP);
                acc = MFMA32(__builtin_shufflevector(a0, a1, 0, 1, 2, 3, 4, 5, 6, 7), pf0, acc);
                acc = MFMA32(__builtin_shufflevector(a2, a3, 0, 1, 2, 3, 4, 5, 6, 7), pf1, acc);
            }
            float ssq = 0.f;
#pragma unroll
            for (int vq = 0; vq < 4; ++vq) {
                const int p = 32 * pt + 8 * vq + 4 * hh;
                const u32x2 xs = *(const LAS u32x2*)(I + l * XP + p * 2);
                const float x0 = __uint_as_float(xs.x << 16), x1 = __uint_as_float(xs.x & 0xffff0000u), x2 = __uint_as_float(xs.y << 16), x3 = __uint_as_float(xs.y & 0xffff0000u);
                const float z0 = __uint_as_float(zz[vq].x << 16), z1 = __uint_as_float(zz[vq].x & 0xffff0000u), z2 = __uint_as_float(zz[vq].y << 16), z3 = __uint_as_float(zz[vq].y & 0xffff0000u);
                const float v0 = (acc[4 * vq] + dsk * x0) * silu_f(z0), v1 = (acc[4 * vq + 1] + dsk * x1) * silu_f(z1), v2 = (acc[4 * vq + 2] + dsk * x2) * silu_f(z2), v3 = (acc[4 * vq + 3] + dsk * x3) * silu_f(z3);
                ssq += (v0 * v0 + v1 * v1) + (v2 * v2 + v3 * v3);
                u32x2 o; o.x = cvtpk(v0, v1); o.y = cvtpk(v2, v3);
                *(u32x2*)(F.ACAT + row * LDA + h * 64 + p) = o;
            }
            ssq += __shfl_xor(ssq, 32);
            if (hh == 0) F.SSQ[row * 32 + 2 * h + pt] = ssq;
        } else {
            const float dec = arr[128 + 63];
            st0 = st0 * dec; st1 = st1 * dec;
            const LAS char* bb = I + BIO + (8 * hh + q4) * BP + (32 * ntb + 16 * blk + 4 * p4) * 2;
            const LAS char* xw = I + XWO + (8 * hh + q4) * XP + (32 * pt2 + 16 * blk + 4 * p4) * 2;
#pragma unroll
            for (int ks = 0; ks < 4; ++ks) {
                const s16x4 x0 = vtr(xw + 16 * ks * XP), x1 = vtr(xw + (16 * ks + 4) * XP);
                const bf16x8 xf = __builtin_shufflevector(x0, x1, 0, 1, 2, 3, 4, 5, 6, 7);
                const s16x4 b0 = vtr(bb + 16 * ks * BP), b1 = vtr(bb + (16 * ks + 4) * BP), b2 = vtr(bb + 16 * ks * BP + 64), b3 = vtr(bb + (16 * ks + 4) * BP + 64);
                st0 = MFMA32(__builtin_shufflevector(b0, b1, 0, 1, 2, 3, 4, 5, 6, 7), xf, st0);
                st1 = MFMA32(__builtin_shufflevector(b2, b3, 0, 1, 2, 3, 4, 5, 6, 7), xf, st1);
            }
#pragma unroll
            for (int vq = 0; vq < 4; ++vq) { u32x2 o; o.x = cvtpk(st0[4 * vq], st0[4 * vq + 1]); o.y = cvtpk(st0[4 * vq + 2], st0[4 * vq + 3]);
                *(LAS u32x2*)(Snxt + (32 * pt2 + c32) * CP + (32 * ntb + 8 * vq + 4 * hh) * 2) = o;
                o.x = cvtpk(st1[4 * vq], st1[4 * vq + 1]); o.y = cvtpk(st1[4 * vq + 2], st1[4 * vq + 3]);
                *(LAS u32x2*)(Snxt + (32 * pt2 + c32) * CP + (32 * (ntb + 1) + 8 * vq + 4 * hh) * 2) = o; }
        }
        if (c + 1 < 64) { SSD_PREP(c + 1);
#pragma unroll
            for (int ks = 0; ks < 8; ++ks) cc_[ks] = cf[ks]; }
        __syncthreads();
    }
#undef SSD_LOAD
#undef SSD_PREP
    if (w >= 4) {
        float* sout = F.out + O_PSSM + ((size_t)(b * 16 + h) * 64 + 32 * pt2 + c32) * 128 + 32 * ntb + 4 * hh;
#pragma unroll
        for (int vq = 0; vq < 4; ++vq) { *(f32x4*)(sout + 8 * vq) = (f32x4){st0[4 * vq], st0[4 * vq + 1], st0[4 * vq + 2], st0[4 * vq + 3]};
            *(f32x4*)(sout + 32 + 8 * vq) = (f32x4){st1[4 * vq], st1[4 * vq + 1], st1[4 * vq + 2], st1[4 * vq + 3]}; }
    }
}

__device__ __forceinline__ void mini_mma(f32x16& acc, const bf16_t* wrow, const bf16_t* arow, int nks) {
#pragma unroll 8
    for (int s = 0; s < nks; ++s) acc = MFMA32(*(const bf16x8*)(wrow + 16 * s), *(const bf16x8*)(arow + 16 * s), acc);
}
__device__ __forceinline__ void p3_sample_item(Frame& F, int it) {
    const int lane = F.lane, w = F.wave, c = lane & 31, h = lane >> 5, rb = it >> 5, cb = it & 31;
    const size_t row = (size_t)RP + 32 * rb + c;
    LAS float* red = (LAS float*)F.lds;
    f32x16 a;
#pragma unroll
    for (int v = 0; v < 16; ++v) a[v] = 0.f;
    {   const bf16_t* ar = F.ACAT + row * LDA + 256 * w + 8 * h; const bf16_t* wr_ = F.WbrT + (size_t)(32 * cb + c) * 2048 + 256 * w + 8 * h;
        bf16x8 af[16], wf[16];
#pragma unroll
        for (int s = 0; s < 16; ++s) { af[s] = *(const bf16x8*)(ar + 16 * s); wf[s] = *(const bf16x8*)(wr_ + 16 * s); }
#pragma unroll
        for (int s = 0; s < 16; ++s) a = MFMA32(wf[s], af[s], a); }
#pragma unroll
    for (int v = 0; v < 16; ++v) red[(w * 16 + v) * 64 + lane] = a[v];
    __syncthreads();
    if (w < 4) {
        const int vq = w;
        float sq = 0.f;
#pragma unroll
        for (int k = 0; k < 8; ++k) { const f32x4 q = *(const f32x4*)(F.SSQ + row * 32 + 4 * k); sq += (q[0] + q[1]) + (q[2] + q[3]); }
        const float rs = 1.0f / sqrtf(sq * (1.0f / 1024.0f) + EPS);
        const int n = 32 * cb + 8 * vq + 4 * h;
        const bf16_t* gp = F.U + row * LDU + U_GATE + n;
        const u32x2 g0 = *(const u32x2*)gp, g1 = *(const u32x2*)(gp + 1024), g2 = *(const u32x2*)(gp + 2048);
        float o[4];
#pragma unroll
        for (int e = 0; e < 4; ++e) {
            const int v = 4 * vq + e;
            const float a0 = (red[(0 * 16 + v) * 64 + lane] + red[(1 * 16 + v) * 64 + lane]) + (red[(2 * 16 + v) * 64 + lane] + red[(3 * 16 + v) * 64 + lane]);
            const float a1 = red[(4 * 16 + v) * 64 + lane] + red[(5 * 16 + v) * 64 + lane], a2 = red[(6 * 16 + v) * 64 + lane] + red[(7 * 16 + v) * 64 + lane];
            const float x0 = __uint_as_float((e & 1) ? ((e >> 1 ? g0.y : g0.x) & 0xffff0000u) : ((e >> 1 ? g0.y : g0.x) << 16));
            const float x1 = __uint_as_float((e & 1) ? ((e >> 1 ? g1.y : g1.x) & 0xffff0000u) : ((e >> 1 ? g1.y : g1.x) << 16));
            const float x2 = __uint_as_float((e & 1) ? ((e >> 1 ? g2.y : g2.x) & 0xffff0000u) : ((e >> 1 ? g2.y : g2.x) << 16));
            const float s0 = 1.0f / (1.0f + __expf(-x0)), s1 = 1.0f / (1.0f + __expf(-x1)), s2 = 1.0f / (1.0f + __expf(-x2));
            o[e] = s0 * rs * a0 + s1 * a1 + s2 * a2;
        }
        u32x2 wv; wv.x = cvtpk(o[0], o[1]); wv.y = cvtpk(o[2], o[3]);
        *(u32x2*)(F.MERGED + row * 1024 + n) = wv;
    }
    __syncthreads();
}
__device__ __forceinline__ void p4_sample_item(Frame& F, int it) {
    const int lane = F.lane, w = F.wave, c = lane & 31, h = lane >> 5, rb = it >> 4, cb = it & 15;
    const size_t srow = (size_t)32 * rb + c, row = (size_t)RP + srow;
    LAS float* red = (LAS float*)F.lds;
    f32x16 a0, a1;
#pragma unroll
    for (int v = 0; v < 16; ++v) { a0[v] = 0.f; a1[v] = 0.f; }
    {   const bf16_t* ar = F.MERGED + row * 1024 + 128 * w + 8 * h; const bf16_t* w0 = F.WoutT + (size_t)(64 * cb + c) * 1024 + 128 * w + 8 * h;
        bf16x8 af[8], wf[8], wg[8];
#pragma unroll
        for (int s = 0; s < 8; ++s) { af[s] = *(const bf16x8*)(ar + 16 * s); wf[s] = *(const bf16x8*)(w0 + 16 * s); wg[s] = *(const bf16x8*)(w0 + 32 * 1024 + 16 * s); }
#pragma unroll
        for (int s = 0; s < 8; ++s) { a0 = MFMA32(wf[s], af[s], a0); a1 = MFMA32(wg[s], af[s], a1); } }
#pragma unroll
    for (int v = 0; v < 16; ++v) { red[(w * 32 + v) * 64 + lane] = a0[v]; red[(w * 32 + 16 + v) * 64 + lane] = a1[v]; }
    __syncthreads();
    const int t = w >> 2, vq = w & 3, n = 64 * cb + 32 * t + 8 * vq + 4 * h;
    const f32x4 x = *(const f32x4*)(F.xs + srow * 1024 + n);
    f32x4 r;
#pragma unroll
    for (int e = 0; e < 4; ++e) { const int v = 16 * t + 4 * vq + e; float sacc = 0.f;
#pragma unroll
        for (int k = 0; k < 8; ++k) sacc += red[(k * 32 + v) * 64 + lane];
        r[e] = x[e] + sacc; }
    *(f32x4*)(F.out + row * 1024 + n) = r;
    float ssq = (r[0] * r[0] + r[1] * r[1]) + (r[2] * r[2] + r[3] * r[3]);
    ssq += __shfl_xor(ssq, 32);
    __syncthreads();
    if (h == 0) red[w * 32 + c] = ssq;
    __syncthreads();
    if (w == 0 && h == 0) { float sacc = 0.f;
#pragma unroll
        for (int k = 0; k < 8; ++k) sacc += red[k * 32 + c];
        F.RSQ[row * 16 + cb] = sacc; }
    __syncthreads();
}
__device__ __forceinline__ void att_sample_wave(Frame& F, int srow, int head, LAS float* qs) {
    const int lane = F.lane, t = srow & 3, b = srow >> 2; const size_t row = (size_t)RP + srow;
    LAS float* sb = qs + 128;
    const int dq = lane & 15, rs = lane >> 4;
    float mrun = -1e30f, lrun = 0.f; f32x4 o = (f32x4){0.f, 0.f, 0.f, 0.f};
#pragma unroll
    for (int g = 0; g < 3; ++g) {
        const int dil = g == 0 ? 1 : (g == 1 ? 4 : 16), W = 128 * dil;
        const float* cache = (g == 0 ? F.cw128 : (g == 1 ? F.cw512 : F.cw2048)) + (size_t)b * W * 1024 + head * 64;
        const int qoff = U_QKV + g * 1536 + head * 64;
        const int jn = g == 0 ? t + 1 : 1, ncache = 129 - jn;
        LDS_WAIT(); asm volatile("" ::: "memory");
        qs[lane] = bf2f(F.U[row * LDU + qoff + lane]);
        LDS_WAIT(); asm volatile("" ::: "memory");
        float lm = -1e30f;
        if (lane < 4) { float sn = -1e30f; if (lane < jn) sn = dot64_bf16(F.U + (size_t)(RP + b * 4 + t - dil * lane) * LDU + qoff + 512, qs); sb[lane] = sn; lm = sn; }
#pragma unroll 1
        for (int p = 0; p < 2; ++p) { const int jj = p * 64 + lane; float s = -1e30f;
            if (jj < ncache) s = dot64_f32(cache + (size_t)(W + t - dil * (jn + jj)) * 1024, qs);
            sb[4 + jj] = s; lm = fmaxf(lm, s); }
        const float gm = wave_max(lm);
        const float mnew = fmaxf(mrun, gm), fsc = __expf(mrun - mnew);
        float ps = 0.f;
#pragma unroll 1
        for (int p = 0; p < 3; ++p) { const int k = p * 64 + lane; if (k < 132) { const float s = sb[k]; const float pr = s > -1e29f ? __expf(s - mnew) : 0.f; sb[k] = pr; ps += pr; } }
        lrun = lrun * fsc + wave_sum(ps); o = o * fsc; mrun = mnew;
        LDS_WAIT(); asm volatile("" ::: "memory");
        if (rs < jn) { const u32x2 vv = *(const u32x2*)(F.U + (size_t)(RP + b * 4 + t - dil * rs) * LDU + qoff + 1024 + 4 * dq); const float pj = sb[rs];
            o += pj * (f32x4){__uint_as_float(vv.x << 16), __uint_as_float(vv.x & 0xffff0000u), __uint_as_float(vv.y << 16), __uint_as_float(vv.y & 0xffff0000u)}; }
        const float* vbase = cache + 512 + 4 * dq;
#pragma unroll 1
        for (int j0 = 0; j0 < 128; j0 += 64) {
            f32x4 vv[16];
#pragma unroll
            for (int u = 0; u < 16; ++u) { int jj = j0 + 4 * u + rs; jj = jj < ncache ? jj : ncache - 1; vv[u] = *(const f32x4*)(vbase + (size_t)(W + t - dil * (jn + jj)) * 1024); }
#pragma unroll
            for (int u = 0; u < 16; ++u) o += sb[4 + j0 + 4 * u + rs] * vv[u];
        }
    }
#pragma unroll
    for (int e = 0; e < 4; ++e) { o[e] += __shfl_xor(o[e], 16); o[e] += __shfl_xor(o[e], 32); }
    if (rs == 0) { const u32x2 zz = *(const u32x2*)(F.U + row * LDU + U_ZA + head * 64 + 4 * dq); const float inv = 1.0f / lrun;
        u32x2 w; w.x = pk2(o[0] * inv * silu_f(__uint_as_float(zz.x << 16)), o[1] * inv * silu_f(__uint_as_float(zz.x & 0xffff0000u)));
        w.y = pk2(o[2] * inv * silu_f(__uint_as_float(zz.y << 16)), o[3] * inv * silu_f(__uint_as_float(zz.y & 0xffff0000u)));
        *(u32x2*)(F.ACAT + row * LDA + 1024 + head * 64 + 4 * dq) = w; }
}
__device__ __forceinline__ void mem_sample_wave(Frame& F, int srow, int head, LAS float* qs) {
    const int lane = F.lane, b = srow >> 2; const size_t row = (size_t)RP + srow;
    LAS float* sb = qs + 128;
    const float* cache = F.cmem + (size_t)b * 256 * 1024 + head * 128;
    LDS_WAIT(); asm volatile("" ::: "memory");
    qs[lane] = bf2f(F.U[row * LDU + U_QM + head * 128 + lane]) * 0.08838834764831845f;
    qs[lane + 64] = bf2f(F.U[row * LDU + U_QM + head * 128 + 64 + lane]) * 0.08838834764831845f;
    LDS_WAIT(); asm volatile("" ::: "memory");
    float lm = -1e30f;
#pragma unroll 1
    for (int p = 0; p < 4; ++p) { const int m = p * 64 + lane; const float* kp = cache + (size_t)m * 1024;
        float s = 0.f;
#pragma unroll
        for (int hf = 0; hf < 2; ++hf) { f32x4 kk[16];
#pragma unroll
            for (int cc = 0; cc < 16; ++cc) kk[cc] = *(const f32x4*)(kp + 64 * hf + 4 * cc);
#pragma unroll
            for (int cc = 0; cc < 16; ++cc) { const f32x4 q0 = *(const LAS f32x4*)(qs + 64 * hf + 4 * cc); s += kk[cc][0] * q0[0] + kk[cc][1] * q0[1] + kk[cc][2] * q0[2] + kk[cc][3] * q0[3]; } }
        sb[m] = s; lm = fmaxf(lm, s); }
    const float gm = wave_max(lm);
    float ps = 0.f;
#pragma unroll 1
    for (int p = 0; p < 4; ++p) { const float pr = __expf(sb[p * 64 + lane] - gm); sb[p * 64 + lane] = pr; ps += pr; }
    const float l = wave_sum(ps);
    LDS_WAIT(); asm volatile("" ::: "memory");
    const int dq = lane & 31, rs = lane >> 5;
    f32x4 o = (f32x4){0.f, 0.f, 0.f, 0.f};
    const float* vbase = cache + 512 + 4 * dq;
#pragma unroll 1
    for (int m0 = 0; m0 < 256; m0 += 32) {
        f32x4 vv[16];
#pragma unroll
        for (int u = 0; u < 16; ++u) vv[u] = *(const f32x4*)(vbase + (size_t)(m0 + 2 * u + rs) * 1024);
#pragma unroll
        for (int u = 0; u < 16; ++u) o += sb[m0 + 2 * u + rs] * vv[u];
    }
#pragma unroll
    for (int e = 0; e < 4; ++e) o[e] += __shfl_xor(o[e], 32);
    if (rs == 0) { const u32x2 zz = *(const u32x2*)(F.U + row * LDU + U_ZM + head * 128 + 4 * dq); const float inv = 1.0f / l;
        u32x2 w; w.x = pk2(o[0] * inv * silu_f(__uint_as_float(zz.x << 16)), o[1] * inv * silu_f(__uint_as_float(zz.x & 0xffff0000u)));
        w.y = pk2(o[2] * inv * silu_f(__uint_as_float(zz.y << 16)), o[3] * inv * silu_f(__uint_as_float(zz.y & 0xffff0000u)));
        *(u32x2*)(F.ACAT + row * LDA + 1536 + head * 128 + 4 * dq) = w; }
}
__device__ __forceinline__ void ssd_naive_unit(Frame& F, bool samp, int b, int h) {
    const int tid = F.tid, lane = F.lane, wave = F.wave;
    const int T = samp ? 4 : 4096, row0 = samp ? RP + b * 4 : b * 4096, g = h >> 2;
    constexpr int CH = 64;
    LAS float* xc = (LAS float*)F.lds;
    LAS float* dtv = xc + CH * 320;
    LAS float* ybuf = dtv + CH;
    const int p = tid >> 3, nq = tid & 7;
    float st[16];
    float* sout = F.out + (samp ? O_SSSM : O_PSSM) + ((size_t)(b * 16 + h) * 64 + p) * 128 + nq * 16;
    if (samp) { const float* sp = F.sssm + ((size_t)(b * 16 + h) * 64 + p) * 128 + nq * 16;
#pragma unroll
        for (int i = 0; i < 4; ++i) { const f32x4 v = *(const f32x4*)(sp + 4 * i); st[4 * i] = v[0]; st[4 * i + 1] = v[1]; st[4 * i + 2] = v[2]; st[4 * i + 3] = v[3]; } }
    else {
#pragma unroll
        for (int i = 0; i < 16; ++i) st[i] = 0.f; }
    const float a = -__expf(F.a_log[h]), dsk = F.d_skip[h], dtb = F.dt_bias[h];
#pragma unroll 1
    for (int t0 = 0; t0 < T; t0 += CH) {
        const int nst = (T - t0) < CH ? (T - t0) : CH;
        for (int idx = tid; idx < nst * 320; idx += NTHREADS) {
            const int s = idx / 320, c = idx - s * 320;
            const int ch = c < 64 ? h * 64 + c : (c < 192 ? 1024 + g * 128 + (c - 64) : 1536 + g * 128 + (c - 192));
            xc[s * 320 + c] = bf2f(F.XC[(size_t)(row0 + t0 + s) * 2048 + ch - 0]);
        }
        if (tid < nst) { const float x = F.DT[(size_t)(row0 + t0 + tid) * 16 + h] + dtb; dtv[tid] = x > 20.f ? x : log1pf(__expf(x)); }
        __syncthreads();
#pragma unroll 1
        for (int s = 0; s < nst; ++s) {
            const float dt = dtv[s], dA = __expf(dt * a), xv = xc[s * 320 + p], dtx = dt * xv;
            const LAS f32x4* Bp = (const LAS f32x4*)(xc + s * 320 + 64 + nq * 16); const LAS f32x4* Cp = (const LAS f32x4*)(xc + s * 320 + 192 + nq * 16);
            float y = 0.f;
#pragma unroll
            for (int i = 0; i < 4; ++i) { const f32x4 bv = Bp[i], cv = Cp[i];
#pragma unroll
                for (int e = 0; e < 4; ++e) { st[4 * i + e] = st[4 * i + e] * dA + dtx * bv[e]; y += cv[e] * st[4 * i + e]; } }
            y += __shfl_xor(y, 1); y += __shfl_xor(y, 2); y += __shfl_xor(y, 4);
            if (nq == 0) ybuf[s * 64 + p] = y + dsk * xv;
        }
        __syncthreads();
        for (int s = wave; s < nst; s += NWAVES) {
            const int row = row0 + t0 + s;
            const float z = bf2f(F.U[(size_t)row * LDU + U_Z + h * 64 + lane]);
            const float v = ybuf[s * 64 + lane] * silu_f(z);
            F.ACAT[(size_t)row * LDA + h * 64 + lane] = (bf16_t)f2bf(v);
            const float q = wave_sum(v * v);
            if (lane == 0) { F.SSQ[(size_t)row * 32 + 2 * h] = q; F.SSQ[(size_t)row * 32 + 2 * h + 1] = 0.f; }
        }
        __syncthreads();
    }
#pragma unroll
    for (int i = 0; i < 4; ++i) *(f32x4*)(sout + 4 * i) = (f32x4){st[4 * i], st[4 * i + 1], st[4 * i + 2], st[4 * i + 3]};
}
__device__ __forceinline__ void ssd_sample_item(Frame& F, int b, int h0) {
    const int lane = F.lane, w = F.wave, h = h0 + (w >> 2), pq = w & 3, g = h >> 2, p = 16 * pq + (lane >> 2), nc = lane & 3;
    LAS float* sq = (LAS float*)F.lds;
    const size_t so = ((size_t)(b * 16 + h) * 64 + p) * 128 + 32 * nc;
    float st[32];
#pragma unroll
    for (int i = 0; i < 8; ++i) { const f32x4 v = *(const f32x4*)(F.sssm + so + 4 * i); st[4 * i] = v[0]; st[4 * i + 1] = v[1]; st[4 * i + 2] = v[2]; st[4 * i + 3] = v[3]; }
    const float a = -__expf(F.a_log[h]), dsk = F.d_skip[h], dtb = F.dt_bias[h];
#pragma unroll 1
    for (int t = 0; t < 4; ++t) {
        const size_t row = (size_t)RP + 4 * b + t;
        const float xx = F.DT[row * 16 + h] + dtb; const float dt = xx > 20.f ? xx : log1pf(__expf(xx));
        const float dA = __expf(dt * a), xv = bf2f(F.XC[row * 2048 + h * 64 + p]), dtx = dt * xv;
        const bf16_t* bp = F.XC + row * 2048 + 1024 + g * 128 + 32 * nc;
        float y = 0.f;
#pragma unroll
        for (int i = 0; i < 4; ++i) { const u32x4 bv = *(const u32x4*)(bp + 8 * i), cv = *(const u32x4*)(bp + 512 + 8 * i);
#pragma unroll
            for (int e = 0; e < 4; ++e) { const float b0 = __uint_as_float(bv[e] << 16), b1 = __uint_as_float(bv[e] & 0xffff0000u), c0 = __uint_as_float(cv[e] << 16), c1 = __uint_as_float(cv[e] & 0xffff0000u);
                st[8 * i + 2 * e] = st[8 * i + 2 * e] * dA + dtx * b0; y += c0 * st[8 * i + 2 * e];
                st[8 * i + 2 * e + 1] = st[8 * i + 2 * e + 1] * dA + dtx * b1; y += c1 * st[8 * i + 2 * e + 1]; } }
        y += __shfl_xor(y, 1); y += __shfl_xor(y, 2);
        const float z = bf2f(F.U[row * LDU + U_Z + h * 64 + p]);
        const float v = (y + dsk * xv) * silu_f(z);
        if (nc == 0) F.ACAT[row * LDA + h * 64 + p] = (bf16_t)f2bf(v);
        const float q = wave_sum(nc == 0 ? v * v : 0.f);
        if (lane == 0) sq[(w >> 2) * 16 + t * 4 + pq] = q;
    }
#pragma unroll
    for (int i = 0; i < 8; ++i) *(f32x4*)(F.out + O_SSSM + so + 4 * i) = (f32x4){st[4 * i], st[4 * i + 1], st[4 * i + 2], st[4 * i + 3]};
    __syncthreads();
    if (F.tid < 8) { const int hl = F.tid >> 2, t = F.tid & 3; const LAS float* q4 = sq + hl * 16 + t * 4;
        const size_t row = (size_t)RP + 4 * b + t; F.SSQ[row * 32 + 2 * (h0 + hl)] = (q4[0] + q4[1]) + (q4[2] + q4[3]); F.SSQ[row * 32 + 2 * (h0 + hl) + 1] = 0.f; }
}
__device__ __forceinline__ void p2_mixers(const Args& args, unsigned char* lds, int qword, int it_lo = 0, int it_hi = 1 << 30) {
    Frame F0; F0.lds = (LAS unsigned char*)lds; F0.tid = threadIdx.x; F0.wave = __builtin_amdgcn_readfirstlane(F0.tid >> 6); F0.ctl = (unsigned*)(args.ws + WS_CTL);
#define F F0
    constexpr int N_SSDP = 128, N_ATTP = 512, N_MEMP = 512, N_ATTS = 512, N_MEMS = 256, N_SSDS = 1024, N_ITEMS = N_SSDP + N_ATTP + N_MEMP + N_ATTS + N_MEMS + N_SSDS;
    volatile LAS int* slot = (volatile LAS int*)(F.lds + MISC_OFF + 64);
    LAS float* qs = (LAS float*)(F.lds + 112 * 1024 + F.wave * 2048);
    LAS char* vl = (LAS char*)(F.lds + F.wave * 10240);
    for (;;) {
        __syncthreads();
        if (F.tid == 0) *slot = (int)__hip_atomic_fetch_add(F.ctl + qword, 1u, RLX_AGENT);
        __syncthreads();
        int it = *slot + it_lo;
        if (it >= N_ITEMS || it >= it_hi) break;
#define P2_FRAME() FRAME(); asm volatile("" : "+v"(F.lane), "+v"(F.tid))
#undef F
        if (it < N_SSDP) { P2_FRAME(); ssd_prompt_unit(F, it >> 4, it & 15); continue; } it -= N_SSDP;
        const int grp = it / 11, r = it - 11 * grp;
        if (r < 2) { const int i = 2 * grp + r; P2_FRAME(); att_prompt_item(F, i >> 6, i & 7, (i >> 3) & 7, (LAS char*)F.lds + F.wave * 6144); continue; }
        if (r < 4) { const int i = 2 * grp + r - 2; P2_FRAME(); mem_prompt_item(F, i >> 6, i & 3, ((i >> 2) & 15) * 256); continue; }
        if (r < 6) { const int i = 2 * grp + r - 4; P2_FRAME(); att_sample_wave(F, i, F.wave, (LAS float*)(F.lds + 112 * 1024 + F.wave * 2048)); continue; }
        if (r == 6) { const int i = grp; P2_FRAME(); mem_sample_wave(F, i * 2 + (F.wave >> 2), F.wave & 3, (LAS float*)(F.lds + 112 * 1024 + F.wave * 2048)); continue; }
        { const int i = 4 * grp + r - 7; P2_FRAME(); ssd_sample_item(F, i >> 3, 2 * (i & 7)); }
#define F F0
    }
#undef F
#undef P2_FRAME
}
__device__ __forceinline__ void p5_final_norm(Frame& F) {
    const int gw = F.vcu * NWAVES + F.wave, NGW = F.G * NWAVES, lane = F.lane;
    f32x4 w[4];
#pragma unroll
    for (int j = 0; j < 4; ++j) w[j] = ((const f32x4*)F.norm_f_w)[lane + 64 * j];
    for (int m = gw; m < RT; m += NGW) {
        const f32x4* q = (const f32x4*)(F.RSQ + (size_t)m * 16); const f32x4 a = q[0], b = q[1], c = q[2], d = q[3];
        const float s = ((a[0] + a[1]) + (a[2] + a[3])) + ((b[0] + b[1]) + (b[2] + b[3])) + ((c[0] + c[1]) + (c[2] + c[3])) + ((d[0] + d[1]) + (d[2] + d[3]));
        const float rstd = 1.0f / sqrtf(s * (1.0f / 1024.0f) + EPS);
        f32x4* o = (f32x4*)(F.out + (size_t)m * 1024) + lane;
#pragma unroll
        for (int j = 0; j < 4; ++j) o[64 * j] = o[64 * j] * rstd * w[j];
    }
}
__global__ void __launch_bounds__(NTHREADS, 2) fwd_kernel(Args args) {
    extern __shared__ __attribute__((aligned(16))) unsigned char lds[];
    const int tid0 = threadIdx.x; const int wave0 = __builtin_amdgcn_readfirstlane(tid0 >> 6);
    for (int u = tid0; u < (LDS_BYTES - LDSCTL_OFF) / 4; u += NTHREADS) ((LAS unsigned*)((LAS unsigned char*)lds + LDSCTL_OFF))[u] = 0u;
    __syncthreads();
    const int lo = args.ph_lo, hi = args.ph_hi;
#if MK_ONE_LAUNCH
    XcdBarrier bar = xcd_barrier_post((unsigned*)(args.ws + WS_CTL) + CW_BAR, (volatile LAS unsigned*)((LAS unsigned char*)lds + MISC_OFF) + 8);
#define GRID_BAR() xcd_barrier(bar)
#else
#define GRID_BAR() do { } while (0)
#endif
#ifndef PH_MASK
#define PH_MASK 63
#endif
#define IN(k) (((PH_MASK >> (k)) & 1) && lo <= (k) && (k) < hi)
#define BOTH(k) (IN(k) && IN((k) + 1))

#ifndef PX_REPEAT
#define PX_REPEAT -1
#endif
    if (IN(0)) { { FRAME(); p0_prologue(F); }
#if PX_REPEAT == 0
        GRID_BAR(); { FRAME(); p0_prologue(F); }
#endif
        if (BOTH(0)) GRID_BAR(); }

#ifndef P1_REPEAT
#define P1_REPEAT 1
#endif
#ifndef P2_REPEAT
#define P2_REPEAT 1
#endif
#define P1_BODY() do { FRAME(); \
        pg8::Gemm g{F.XB, F.WinT, 1024, F.MB, F.WmemT}; pg8::TileOrder S; S.init(RT / 256, 48, F.G, (int)blockIdx.x, 1, 16, 8, 4); \
        EpiIn E{F.U, F.MKV, F.CS, F.out}; \
        pg8::gemm_phase<EpiIn, pg8::TileOrder, true>(F.lds, g, S, E, F.tid); } while (0)
    if (IN(1)) {
        P1_BODY();
#if P1_REPEAT == 2
        GRID_BAR(); P1_BODY();
#endif
        GRID_BAR();
        { FRAME(); p1c_conv(F); }
        if (BOTH(1)) GRID_BAR();
    }

    if (IN(2)) {
#pragma unroll 1
        for (int rep = 0; rep < P2_REPEAT; ++rep) { p2_mixers(args, lds, CW_Q + 64 * rep); if (rep + 1 < P2_REPEAT) GRID_BAR(); }
#ifdef P2_EXTRA_LO
        GRID_BAR(); p2_mixers(args, lds, CW_Q + 192, P2_EXTRA_LO, P2_EXTRA_HI);
#endif
        if (BOTH(2)) GRID_BAR(); }

    if (IN(3)) {
        { FRAME();
        for (int it = (int)blockIdx.x; it < 512; it += F.G) p3_sample_item(F, it);
        pg8::Gemm g{F.ACAT, F.WbrT, 2048, nullptr, nullptr}; pg8::TileOrder S; S.init(RP / 256, 4, F.G, (int)blockIdx.x, 3, 0);
        EpiBr E{F.U, F.SSQ, F.MERGED};
        pg8::gemm_phase<EpiBr, pg8::TileOrder, true>(F.lds, g, S, E, F.tid); }
#if PX_REPEAT == 3
        GRID_BAR();
        { FRAME();
        pg8::Gemm g{F.ACAT, F.WbrT, 2048, nullptr, nullptr}; pg8::TileOrder S; S.init(RT / 256, 4, F.G, (int)blockIdx.x, 3, 0);
        EpiBr E{F.U, F.SSQ, F.MERGED};
        pg8::gemm_phase<EpiBr, pg8::TileOrder, true>(F.lds, g, S, E, F.tid); }
#endif
        if (BOTH(3)) GRID_BAR();
    }

    if (IN(4)) {
        { FRAME();
        for (int it = (int)blockIdx.x; it < 256; it += F.G) p4_sample_item(F, it);
        pg8::Gemm g{F.MERGED, F.WoutT, 1024, nullptr, nullptr}; pg8::TileOrder S; S.init(RP / 256, 4, F.G, (int)blockIdx.x, 1, 16);
        EpiOut E{F.xp, F.xs, F.out, F.RSQ};
        pg8::gemm_phase<EpiOut, pg8::TileOrder, true>(F.lds, g, S, E, F.tid); }
#if PX_REPEAT == 4
        GRID_BAR();
        { FRAME();
        pg8::Gemm g{F.MERGED, F.WoutT, 1024, nullptr, nullptr}; pg8::TileOrder S; S.init(RT / 256, 4, F.G, (int)blockIdx.x, 1, 16);
        EpiOut E{F.xp, F.xs, F.out, F.RSQ};
        pg8::gemm_phase<EpiOut, pg8::TileOrder, true>(F.lds, g, S, E, F.tid); }
#endif
        if (BOTH(4)) GRID_BAR();
    }

    if (IN(5)) { FRAME(); p5_final_norm(F); }
#undef IN
#undef BOTH
}

extern "C" void kernel_launch(void* const* d_in, const int* in_sizes, int n_in, void* d_out, int out_size, void* d_ws, size_t ws_size, hipStream_t stream) {
    static int grid = 0;
    if (grid == 0) {
        if (n_in != 24 || (size_t)out_size != O_TOTAL || ws_size < WS_END) { fprintf(stderr, "kernel_launch: unexpected problem shape (n_in %d, out %d, ws %zu, need %zu); nothing launched\n", n_in, out_size, ws_size, (size_t)WS_END); grid = -1; return; }
        int dev = 0, cus = 0, per_cu = 0;
        if (hipGetDevice(&dev) != hipSuccess || hipDeviceGetAttribute(&cus, hipDeviceAttributeMultiprocessorCount, dev) != hipSuccess) { grid = -1; return; }
        if (hipFuncSetAttribute((const void*)fwd_kernel, hipFuncAttributeMaxDynamicSharedMemorySize, LDS_BYTES) != hipSuccess) { fprintf(stderr, "kernel_launch: hipFuncSetAttribute failed\n"); grid = -1; return; }
        if (hipOccupancyMaxActiveBlocksPerMultiprocessor(&per_cu, (const void*)fwd_kernel, NTHREADS, LDS_BYTES) != hipSuccess || per_cu < 1)
            fprintf(stderr, "kernel_launch: note: occupancy query reports %d workgroups per CU\n", per_cu);
        (void)hipGetLastError();
        grid = cus;
    }
    if (grid < 0) return;
    if (hipMemsetAsync((char*)d_ws + WS_CTL, 0, CTL_ZERO_BYTES, stream) != hipSuccess) { fprintf(stderr, "kernel_launch: memset failed\n"); return; }
    Args a{};
    {
        static const int dict_sizes[24] = {33554432, 524288, 2097152, 16777216, 67108864, 268435456, 33554432, 786432, 16777216, 1024, 12599296, 8192, 2048, 16, 16, 16, 1024, 1024, 1048576, 1048576, 524288, 524288, 1048576, 1024};
        static const int sorted_to_dict[24] = {14, 6, 3, 5, 4, 12, 11, 15, 13, 17, 2, 23, 9, 16, 7, 8, 20, 21, 19, 10, 18, 22, 0, 1};
        bool is_dict = true, is_sorted = true;
        for (int i = 0; i < 24; ++i) { if (in_sizes[i] != dict_sizes[i]) is_dict = false; if (in_sizes[i] != dict_sizes[sorted_to_dict[i]]) is_sorted = false; }
        if (is_dict) { for (int i = 0; i < 24; ++i) a.in[i] = (const float*)d_in[i]; }
        else if (is_sorted) { for (int i = 0; i < 24; ++i) a.in[sorted_to_dict[i]] = (const float*)d_in[i]; }
        else { fprintf(stderr, "kernel_launch: input sizes match neither the dict order nor the sorted-key order; nothing launched\n"); return; }
    }
    a.out = (float*)d_out; a.ws = (unsigned char*)d_ws;
#if MK_ONE_LAUNCH
    a.ph_lo = 0; a.ph_hi = 6;
    hipLaunchKernelGGL(fwd_kernel, dim3(grid), dim3(NTHREADS), LDS_BYTES, stream, a);
#else
    for (int ph = 0; ph < 6; ++ph) { a.ph_lo = ph; a.ph_hi = ph + 1; hipLaunchKernelGGL(fwd_kernel, dim3(grid), dim3(NTHREADS), LDS_BYTES, stream, a); }
#endif
    const hipError_t le = hipPeekAtLastError();
    if (le != hipSuccess) fprintf(stderr, "kernel_launch: launch failed: %s\n", hipGetErrorName(le));
}
```

```cpp
#include <hip/hip_runtime.h>
#include <cstdio>
#include <cstdint>

#ifndef MK_ONE_LAUNCH
#define MK_ONE_LAUNCH 1
#endif

#define GAS __attribute__((address_space(1)))
#define LAS __attribute__((address_space(3)))
typedef unsigned short bf16_t;
typedef short bf16x8 __attribute__((ext_vector_type(8)));
typedef float f32x4 __attribute__((ext_vector_type(4)));
typedef float f32x2 __attribute__((ext_vector_type(2)));
typedef unsigned u32x4 __attribute__((ext_vector_type(4)));
typedef unsigned u32x2 __attribute__((ext_vector_type(2)));
#define RLX_AGENT __ATOMIC_RELAXED, __HIP_MEMORY_SCOPE_AGENT
#define LDS_WAIT() asm volatile("s_waitcnt lgkmcnt(0)" ::: "memory")
#define VM_WAIT() asm volatile("s_waitcnt vmcnt(0)" ::: "memory")

constexpr int DM = 1024;
constexpr int RP = 8 * 4096, RS = 128 * 4, RT = RP + RS;
constexpr int NINP = 12544;
constexpr int LDU = 12288;
constexpr int U_Z = 0, U_XBC = 1024, U_QKV = 3072, U_ZA = 7680, U_QM = 8192, U_ZM = 8704, U_GATE = 9216;
constexpr int LDA = 2048;
constexpr float EPS = 1e-6f;
constexpr size_t O_YP = 0, O_YS = 33554432, O_PW128 = 34078720, O_PW512 = 35127296, O_PW2048 = 39321600, O_PMEM = 56098816, O_PCONV = 58195968, O_PSSM = 58245120,
                 O_SW128 = 59293696, O_SW512 = 59817984, O_SW2048 = 60342272, O_SCONV = 60866560, O_SSSM = 61652992, O_TOTAL = 78430208;
constexpr size_t MiB = 1u << 20;
constexpr size_t WS_CTL = 0, CTL_ZERO_BYTES = 1 * MiB;
constexpr size_t WS_WIN = 1 * MiB;
constexpr size_t WS_WMEM = 26 * MiB;
constexpr size_t WS_WBR = 30 * MiB;
constexpr size_t WS_WOUT = 34 * MiB;
constexpr size_t WS_CS = 36 * MiB;
constexpr size_t WS_DT = 37 * MiB;
constexpr size_t WS_SSQ = 40 * MiB;
constexpr size_t WS_RSQ = 45 * MiB;
constexpr size_t WS_MB = 48 * MiB;
constexpr size_t WS_MKV = 52 * MiB;
constexpr size_t WS_XB = 58 * MiB;
constexpr size_t WS_MERGED = 124 * MiB;
constexpr size_t WS_ACAT = 190 * MiB;
constexpr size_t WS_U = 321 * MiB;
constexpr size_t WS_XC = WS_U + (size_t)RT * LDU * 2;
constexpr size_t WS_END = WS_XC + (size_t)RT * 2048 * 2;
static_assert(WS_WIN + (size_t)NINP * 1024 * 2 <= WS_WMEM && WS_XB + (size_t)RT * 1024 * 2 <= WS_MERGED && WS_MERGED + (size_t)RT * 1024 * 2 <= WS_ACAT && WS_ACAT + (size_t)RT * LDA * 2 <= WS_U, "d_ws map");
constexpr int CW_Q = 64;
constexpr int CW_BAR = 4096;
constexpr int RING_BYTES = 131072, LDSCTL_OFF = RING_BYTES, MISC_OFF = LDSCTL_OFF + 320, LDS_BYTES = 147456;
constexpr int NWAVES = 8, NTHREADS = 512;

__device__ __forceinline__ float bf2f(bf16_t b) { return __uint_as_float(((unsigned)b) << 16); }
__device__ __forceinline__ unsigned f2bf(float f) { unsigned u = __float_as_uint(f); return (u + 0x7fffu + ((u >> 16) & 1u)) >> 16; }
__device__ __forceinline__ unsigned pk2(float lo, float hi) { return f2bf(lo) | (f2bf(hi) << 16); }
__device__ __forceinline__ float silu_f(float x) { return x / (1.0f + __expf(-x)); }
__device__ __forceinline__ float wave_sum(float v) {
#pragma unroll
    for (int o = 1; o < 64; o <<= 1) v += __shfl_xor(v, o);
    return v;
}
__device__ __forceinline__ float wave_max(float v) {
#pragma unroll
    for (int o = 1; o < 64; o <<= 1) v = fmaxf(v, __shfl_xor(v, o));
    return v;
}
namespace pg8 {
constexpr int BM = 256, BK = 64, HALF = 128, HTB = HALF * BK * 2  , STAGE_BYTES = 8 * HTB, NXCD = 8, WGM = 8;

__host__ __device__ __forceinline__ int lds_byte(int r, int c) { const int st = (r >> 4) * 2 + (c >> 5), rr = r & 15, cc = c & 31, ob = rr * 64 + cc * 2; return st * 1024 + (ob ^ (((ob >> 9) & 1) << 5)); }
__host__ __device__ __forceinline__ void stage_rc(int b, int& R, int& C) { const int st = b / 1024, sb = b % 1024, swz = sb ^ (((sb >> 9) & 1) << 5); R = (st >> 1) * 16 + swz / 64; C = (st & 1) * 32 + (swz % 64) / 2; }
__host__ __device__ __forceinline__ int perm32(int rho) { const int n = rho >> 4, i = rho & 15; return 8 * (i >> 2) + 4 * n + (i & 3); }

struct Unit { int pm, pn, k0, nt, kind, src; };
struct Gemm { const bf16_t* A; const bf16_t* Bt; int ld; const bf16_t* A2; const bf16_t* Bt2; };

struct TileOrder {
    int nM, nN, nwg, G, c, nsub, ntfull, nM2, nN2;
    __device__ __forceinline__ void init(int nM_, int nN_, int G_, int c_, int nsub_, int ntfull_, int nM2_ = 0, int nN2_ = 0) { nM = nM_; nN = nN_; nwg = nM * nN; G = G_; c = c_; nsub = nsub_; ntfull = ntfull_; nM2 = nM2_; nN2 = nN2_; }
    __device__ __forceinline__ bool next(int i, Unit& u) const {
        int ti = i, sub = 0;
        if (nsub == 3) { ti = i / 3; sub = i - 3 * ti; }
        const long L = (long)ti * G + c; u.src = 0;
        if (L >= nwg) { const int e = (int)(L - nwg); if (e >= nM2 * nN2) return false; u.pm = e / nN2; u.pn = e - u.pm * nN2; u.kind = 0; u.k0 = 0; u.nt = ntfull; u.src = 1; return true; }
        int wgid = (int)L; { const int q = nwg / NXCD, r = nwg % NXCD, xcd = wgid % NXCD, off = wgid / NXCD; wgid = (xcd < r ? xcd * (q + 1) : r * (q + 1) + (xcd - r) * q) + off; }
        const int nig = WGM * nN, gid = wgid / nig, fm = gid * WGM, gsz = (nM - fm) < WGM ? (nM - fm) : WGM;
        u.pm = fm + ((wgid % nig) % gsz); u.pn = (wgid % nig) / gsz; u.kind = sub;
        if (nsub == 3) { u.k0 = sub == 0 ? 0 : (sub == 1 ? 1024 : 1536); u.nt = sub == 0 ? 16 : 8; } else { u.k0 = 0; u.nt = ntfull; }
        return true;
    }
};

__device__ __forceinline__ unsigned cvt_pk_bf16(float lo, float hi) { unsigned r; asm volatile("v_cvt_pk_bf16_f32 %0, %1, %2" : "=v"(r) : "v"(lo), "v"(hi)); return r; }

template <class Epi, class Sched, bool ALIGN_EPI = true>
__device__ __forceinline__ void gemm_phase(LAS unsigned char* lds, const Gemm g, const Sched& S, const Epi& E, const int tid) {
    const int wid = __builtin_amdgcn_readfirstlane(tid >> 6), lane = tid & 63, wr = wid >> 2, wc = wid & 3, fr = lane & 15, fq = lane >> 4;
    const int K = g.ld;
    unsigned voffA[2], voffB[2];
#pragma unroll
    for (int i = 0; i < 2; ++i) { int R, C; stage_rc(tid * 16 + i * 8192, R, C); const int Rb = Epi::PERM ? ((R & ~31) + perm32(R & 31)) : R;
        voffA[i] = (unsigned)(R * K + C) * 2u; voffB[i] = (unsigned)(Rb * K + C) * 2u; }
    const size_t kstep = (size_t)(BK * 2);
    const size_t hstep = (size_t)HALF * K * 2;
    const size_t tstep = 2 * hstep;
    const unsigned ldsw = (unsigned)wid * 1024u;
    const int aoff = lds_byte(wr * 64 + fr, fq * 8), boff = lds_byte(wc * 32 + fr, fq * 8);
#define PG8_SA(b, h) (((b) * 2 + (h)) * HTB)
#define PG8_SB(b, h) ((4 + (b) * 2 + (h)) * HTB)
#define PG8_STAGE(bufoff, gbase, voff) do { _Pragma("unroll") for (int _i = 0; _i < 2; ++_i) \
        __builtin_amdgcn_global_load_lds((const unsigned*)((const char*)(gbase) + (voff)[_i]), (LAS unsigned*)(lds + (bufoff) + ldsw + _i * 8192), 16, 0, 0); } while (0)
#define PG8_LDA(dst, b, h) do { _Pragma("unroll") for (int m = 0; m < 4; ++m) _Pragma("unroll") for (int k = 0; k < 2; ++k) dst[m][k] = *(const LAS bf16x8*)(lds + PG8_SA(b, h) + aoff + m * 2048 + k * 1024); } while (0)
#define PG8_LDB(dst, b, h) do { _Pragma("unroll") for (int n = 0; n < 2; ++n) _Pragma("unroll") for (int k = 0; k < 2; ++k) dst[n][k] = *(const LAS bf16x8*)(lds + PG8_SB(b, h) + boff + n * 2048 + k * 1024); } while (0)
#define PG8_MMA(ai, bj, At, Bt) do { __builtin_amdgcn_s_setprio(1); _Pragma("unroll") for (int m = 0; m < 4; ++m) _Pragma("unroll") for (int n = 0; n < 2; ++n) _Pragma("unroll") for (int k = 0; k < 2; ++k) \
        acc[ai][bj][m][n] = __builtin_amdgcn_mfma_f32_16x16x32_bf16(Bt[n][k], At[m][k], acc[ai][bj][m][n], 0, 0, 0); __builtin_amdgcn_s_setprio(0); } while (0)
#define PG8_WAIT_V(n) asm volatile("s_waitcnt vmcnt(" #n ")" ::: "memory")
#define PG8_WAIT_L(n) asm volatile("s_waitcnt lgkmcnt(" #n ")" ::: "memory")
#define PG8_BAR __builtin_amdgcn_s_barrier()
#define PG8_SCHED __builtin_amdgcn_sched_barrier(0)
    Unit cur, nxt; int ui = 0;
    if (!S.next(0, cur)) return;
    f32x4 acc[2][2][4][2];
#pragma unroll
    for (int a = 0; a < 2; ++a)
#pragma unroll
        for (int b = 0; b < 2; ++b)
#pragma unroll
            for (int m = 0; m < 4; ++m)
#pragma unroll
                for (int n = 0; n < 2; ++n) acc[a][b][m][n] = (f32x4){0.f, 0.f, 0.f, 0.f};
    bf16x8 At[4][2], B0[2][2], B1[2][2];
    const char* cA = (const char*)(cur.src ? g.A2 : g.A) + (size_t)cur.pm * tstep + (size_t)cur.k0 * 2; const char* cB = (const char*)(cur.src ? g.Bt2 : g.Bt) + (size_t)cur.pn * tstep + (size_t)cur.k0 * 2;
    PG8_STAGE(PG8_SB(0, 0), cB, voffB); PG8_STAGE(PG8_SB(0, 1), cB + hstep, voffB); PG8_STAGE(PG8_SA(0, 0), cA, voffA); PG8_STAGE(PG8_SA(0, 1), cA + hstep, voffA);
    if (wr == 1) PG8_BAR;
    PG8_WAIT_V(2); PG8_BAR;
    PG8_STAGE(PG8_SB(1, 0), cB + kstep, voffB); PG8_STAGE(PG8_SA(1, 0), cA + kstep, voffA); PG8_STAGE(PG8_SB(1, 1), cB + hstep + kstep, voffB);
    PG8_WAIT_V(6); PG8_BAR;
    for (;;) {
        const bool has_next = S.next(ui + 1, nxt);
        const char* nA = has_next ? (const char*)(nxt.src ? g.A2 : g.A) + (size_t)nxt.pm * tstep + (size_t)nxt.k0 * 2 : cA; const char* nB = has_next ? (const char*)(nxt.src ? g.Bt2 : g.Bt) + (size_t)nxt.pn * tstep + (size_t)nxt.k0 * 2 : cB;
        const int nt = cur.nt;
        for (int t = 0; t < nt; t += 2) {
            const bool last = (t == nt - 2);
            const char* a1 = cA + (size_t)(t + 1) * kstep;
            const char* a2 = last ? nA : cA + (size_t)(t + 2) * kstep; const char* b2 = last ? nB : cB + (size_t)(t + 2) * kstep;
            const char* a3 = a2 + kstep; const char* b3 = b2 + kstep;
            PG8_LDB(B0, 0, 0); PG8_LDB(B1, 0, 1); PG8_SCHED; PG8_LDA(At, 0, 0); PG8_STAGE(PG8_SA(1, 1), a1 + hstep, voffA);
            PG8_WAIT_V(8); PG8_WAIT_L(0); PG8_BAR; PG8_MMA(0, 0, At, B0); PG8_MMA(0, 1, At, B1); PG8_BAR; PG8_SCHED;
            PG8_LDA(At, 0, 1); PG8_STAGE(PG8_SB(0, 0), b2, voffB); PG8_STAGE(PG8_SB(0, 1), b2 + hstep, voffB); PG8_STAGE(PG8_SA(0, 0), a2, voffA);
            PG8_WAIT_V(8); PG8_WAIT_L(0); PG8_BAR; PG8_MMA(1, 0, At, B0); PG8_MMA(1, 1, At, B1); PG8_BAR; PG8_SCHED;
            PG8_LDB(B0, 1, 0); PG8_LDB(B1, 1, 1); PG8_SCHED; PG8_LDA(At, 1, 0); PG8_STAGE(PG8_SA(0, 1), a2 + hstep, voffA);
            PG8_WAIT_V(8); PG8_WAIT_L(0); PG8_BAR; PG8_MMA(0, 0, At, B0); PG8_MMA(0, 1, At, B1); PG8_BAR; PG8_SCHED;
            PG8_LDA(At, 1, 1); PG8_STAGE(PG8_SB(1, 0), b3, voffB); PG8_STAGE(PG8_SB(1, 1), b3 + hstep, voffB); PG8_STAGE(PG8_SA(1, 0), a3, voffA);
            PG8_WAIT_V(8); PG8_WAIT_L(0); PG8_BAR; PG8_MMA(1, 0, At, B0); PG8_MMA(1, 1, At, B1); PG8_BAR; PG8_SCHED;
        }
        if constexpr (ALIGN_EPI) { if (wr == 0) PG8_BAR; }
        E(acc, cur, wr, wc, fr, fq);
        if (!has_next) break;
        if (E.zero_after(cur)) {
#pragma unroll
        for (int a = 0; a < 2; ++a)
#pragma unroll
            for (int b = 0; b < 2; ++b)
#pragma unroll
                for (int m = 0; m < 4; ++m)
#pragma unroll
                    for (int n = 0; n < 2; ++n) acc[a][b][m][n] = (f32x4){0.f, 0.f, 0.f, 0.f};
        }
        cur = nxt; cA = nA; cB = nB; ++ui;
        if constexpr (ALIGN_EPI) { if (wr == 1) PG8_BAR; }
    }
    PG8_WAIT_V(0);
    if constexpr (!ALIGN_EPI) { if (wr == 0) PG8_BAR; }
    PG8_BAR;
#undef PG8_SA
#undef PG8_SB
#undef PG8_STAGE
#undef PG8_LDA
#undef PG8_LDB
#undef PG8_MMA
#undef PG8_WAIT_V
#undef PG8_WAIT_L
#undef PG8_BAR
#undef PG8_SCHED
}
}
#define XB_TMO      128
#define XB_XCNT(j)  (256  + 64 * (j))
#define XB_XSUB(j)  (1280 + 64 * (j))
#define XB_XGEN(j)  (2304 + 64 * (j))
#define XB_TOP      3328
#define XB_TOPGEN   3392
#define XCD_BAR_WORDS 3456
#define XB_SPIN_CAP (1u << 18)

__device__ __forceinline__ unsigned xb_ld(unsigned* p)              { return __hip_atomic_load(p, __ATOMIC_RELAXED, __HIP_MEMORY_SCOPE_AGENT); }
__device__ __forceinline__ unsigned xb_add(unsigned* p, unsigned v) { return __hip_atomic_fetch_add(p, v, __ATOMIC_RELAXED, __HIP_MEMORY_SCOPE_AGENT); }
__device__ __forceinline__ unsigned xb_xcc_id() { return (unsigned)__builtin_amdgcn_s_getreg((3 << 11) | 20) & 0xFu; }
#define XB_SPIN(cond, bar) do { unsigned _sp = 0; while (cond) { __builtin_amdgcn_s_sleep(1); \
    if ((++_sp & 255u) == 0u) { if (xb_ld(&(bar)[XB_TMO])) break; if (_sp > XB_SPIN_CAP) { atomicAdd(&(bar)[XB_TMO], 1u); break; } } } } while (0)

struct XcdBarrier {
    unsigned* bar; unsigned x;
    volatile LAS unsigned* st;
};

__device__ __forceinline__ XcdBarrier xcd_barrier_post(unsigned* bar, volatile LAS unsigned* st) {
    XcdBarrier b; b.bar = bar; b.x = xb_xcc_id(); b.st = st;
    if (threadIdx.x == 0) (void)xb_add(&bar[XB_XCNT(b.x)], 1u);
    return b;
}
__device__ __forceinline__ void xcd_barrier_complete(unsigned* bar, unsigned x, unsigned& nloc, unsigned& nx) {
    const unsigned G = gridDim.x * gridDim.y * gridDim.z;
    unsigned sum, cnt, mine, sp = 0u;
    for (;;) {
        sum = 0u; cnt = 0u; mine = 0u;
#pragma unroll
        for (unsigned j = 0; j < 16; ++j) { const unsigned c = xb_ld(&bar[XB_XCNT(j)]); sum += c; cnt += (c > 0u) ? 1u : 0u; mine = (j == x) ? c : mine; }
        if (sum == G) break;
        __builtin_amdgcn_s_sleep(1);
        if ((++sp & 255u) == 0u) { if (xb_ld(&bar[XB_TMO])) break; if (sp > XB_SPIN_CAP) { atomicAdd(&bar[XB_TMO], 1u); break; } }
    }
    nloc = mine > 0u ? mine : 1u; nx = cnt > 0u ? cnt : 1u;
}

__device__ __forceinline__ void xcd_barrier(const XcdBarrier& b) {
    asm volatile("s_waitcnt vmcnt(0)" ::: "memory");
    __syncthreads();
    if (threadIdx.x == 0) {
        unsigned* bar = b.bar;
        __builtin_amdgcn_s_waitcnt(0);
        unsigned nloc = b.st[0], nx = b.st[1];
        if (nloc == 0u) { xcd_barrier_complete(bar, b.x, nloc, nx); b.st[0] = nloc; b.st[1] = nx; }
        const unsigned old = xb_add(&bar[XB_XSUB(b.x)], 1u);
        const unsigned gen = old / nloc;
        if (old + 1u == (gen + 1u) * nloc) {
            __builtin_amdgcn_fence(__ATOMIC_RELEASE, "agent");
            asm volatile("s_waitcnt vmcnt(0)" ::: "memory");
            const unsigned og = xb_add(&bar[XB_TOP], 1u);
            const unsigned tg = og / nx;
            if (og + 1u == (tg + 1u) * nx) xb_add(&bar[XB_TOPGEN], 1u);
            else XB_SPIN(xb_ld(&bar[XB_TOPGEN]) == tg, bar);
            __builtin_amdgcn_fence(__ATOMIC_ACQUIRE, "agent");
            xb_add(&bar[XB_XGEN(b.x)], 1u);
            asm volatile("s_waitcnt vmcnt(0)" ::: "memory");
        } else {
            XB_SPIN(xb_ld(&bar[XB_XGEN(b.x)]) == gen, bar);
            __builtin_amdgcn_fence(__ATOMIC_ACQUIRE, "agent");
            asm volatile("s_waitcnt vmcnt(0)" ::: "memory");
        }
    }
    __syncthreads();
}

constexpr float L2E_ = 1.4426950408889634f;
using pg8::Unit; using pg8::cvt_pk_bf16;
__device__ __forceinline__ u32x4 pack8(const f32x4 v0, const f32x4 v1) { u32x4 w; w.x = cvt_pk_bf16(v0[0], v0[1]); w.y = cvt_pk_bf16(v0[2], v0[3]); w.z = cvt_pk_bf16(v1[0], v1[1]); w.w = cvt_pk_bf16(v1[2], v1[3]); return w; }

struct EpiIn {
    static constexpr bool PERM = true;
    bf16_t* U; bf16_t* MKV; const float* CS; float* out;
    __device__ __forceinline__ bool zero_after(const Unit&) const { return true; }
    __device__ __forceinline__ void operator()(f32x4 (&acc)[2][2][4][2], const Unit& u, int wr, int wc, int fr, int fq) const {
        const int pn = u.pn, rbase = u.pm * 256 + wr * 64 + fr, lc0 = wc * 32 + 8 * fq;
        if (u.src == 1) {
            const int c0 = u.pn * 256 + lc0;
#pragma unroll
            for (int ai = 0; ai < 2; ++ai)
#pragma unroll
                for (int m = 0; m < 4; ++m) { const int row = rbase + ai * 128 + m * 16;
#pragma unroll
                    for (int bj = 0; bj < 2; ++bj) { const f32x4 v0 = acc[ai][bj][m][0], v1 = acc[ai][bj][m][1]; const size_t o = (size_t)row * 1024 + c0 + bj * 128;
                        *(u32x4*)(MKV + o) = pack8(v0, v1); float* d = out + O_PMEM + o; __builtin_nontemporal_store(v0, (f32x4*)d); __builtin_nontemporal_store(v1, (f32x4*)(d + 4)); } }
            return;
        }
        int kind = 0, g = 0, half = 0;
        if (pn >= 4 && pn < 12) kind = 1;
        else if (pn >= 12 && pn < 30) { const int t12 = pn - 12; g = t12 / 6; const int j = (t12 - 6 * g) >> 1; half = t12 & 1; kind = 2 + j; }
        const bool rope = (kind == 2 || kind == 3) && ((wc & 1) == 0);
        const int W = g == 0 ? 128 : (g == 1 ? 512 : 2048);
        const size_t opw = g == 0 ? O_PW128 : (g == 1 ? O_PW512 : O_PW2048), osw = g == 0 ? O_SW128 : (g == 1 ? O_SW512 : O_SW2048);
#pragma unroll
        for (int ai = 0; ai < 2; ++ai)
#pragma unroll
            for (int m = 0; m < 4; ++m) {
                const int row = rbase + ai * 128 + m * 16;
                const bool samp = row >= RP;
                const int t = samp ? ((row - RP) & 3) : (row & 4095), b = samp ? ((row - RP) >> 2) : (row >> 12);
                f32x4 c0, c1, s0, s1;
                if (rope) { const float* cs = CS + (size_t)(samp ? 4096 + t : t) * 16; c0 = *(const f32x4*)cs; c1 = *(const f32x4*)(cs + 4); s0 = *(const f32x4*)(cs + 8); s1 = *(const f32x4*)(cs + 12);
                    if (fq == 0) { s0 = -s0; s1 = -s1; } }
#pragma unroll
                for (int bj = 0; bj < 2; ++bj) {
                    f32x4 v0 = acc[ai][bj][m][0], v1 = acc[ai][bj][m][1];
                    if (rope) {
                        f32x4 p0, p1;
#pragma unroll
                        for (int e = 0; e < 4; ++e) { p0[e] = __shfl_xor(v0[e], 16); p1[e] = __shfl_xor(v1[e], 16); }
                        if (fq < 2) { v0 = v0 * c0 + p0 * s0; v1 = v1 * c1 + p1 * s1; }
                    }
                    if (kind == 2) { v0 = v0 * 0.125f; v1 = v1 * 0.125f; }
                    if (kind == 5) {
#pragma unroll
                        for (int e = 0; e < 4; ++e) { v0[e] = fmaxf(__builtin_amdgcn_rcpf(1.0f + __builtin_amdgcn_exp2f(-L2E_ * v0[e])), 1e-30f); v1[e] = fmaxf(__builtin_amdgcn_rcpf(1.0f + __builtin_amdgcn_exp2f(-L2E_ * v1[e])), 1e-30f); } }
                    const int lc = bj * 128 + lc0;
                    __builtin_nontemporal_store(pack8(v0, v1), (u32x4*)(U + (size_t)row * LDU + pn * 256 + lc));
                    if (kind == 1) {
                        const int col = (pn - 4) * 256 + lc;
                        if (samp) { if (t >= 1) { float* d = out + O_SCONV + (size_t)(b * 3 + t - 1) * 2048 + col; __builtin_nontemporal_store(v0, (f32x4*)d); __builtin_nontemporal_store(v1, (f32x4*)(d + 4)); } }
                        else if (t >= 4093) { float* d = out + O_PCONV + (size_t)(b * 3 + t - 4093) * 2048 + col; __builtin_nontemporal_store(v0, (f32x4*)d); __builtin_nontemporal_store(v1, (f32x4*)(d + 4)); }
                    } else if (kind >= 3) {
                        const int hd = half * 256 + lc, kv = kind - 3;
                        if (samp) { float* d = out + osw + ((size_t)(row - RP) * 2 + kv) * 512 + hd; __builtin_nontemporal_store(v0, (f32x4*)d); __builtin_nontemporal_store(v1, (f32x4*)(d + 4)); }
                        else if (t >= 4096 - W) { float* d = out + opw + ((size_t)(b * W + t - (4096 - W)) * 2 + kv) * 512 + hd; __builtin_nontemporal_store(v0, (f32x4*)d); __builtin_nontemporal_store(v1, (f32x4*)(d + 4)); }
                    }
                }
            }
    }
};

struct EpiMem {
    static constexpr bool PERM = true;
    bf16_t* MKV; float* out;
    __device__ __forceinline__ bool zero_after(const Unit&) const { return true; }
    __device__ __forceinline__ void operator()(f32x4 (&acc)[2][2][4][2], const Unit& u, int wr, int wc, int fr, int fq) const {
        const int rbase = u.pm * 256 + wr * 64 + fr, c0 = u.pn * 256 + wc * 32 + 8 * fq;
#pragma unroll
        for (int ai = 0; ai < 2; ++ai)
#pragma unroll
            for (int m = 0; m < 4; ++m) { const int row = rbase + ai * 128 + m * 16;
#pragma unroll
                for (int bj = 0; bj < 2; ++bj) { const f32x4 v0 = acc[ai][bj][m][0], v1 = acc[ai][bj][m][1]; const size_t o = (size_t)row * 1024 + c0 + bj * 128;
                    *(u32x4*)(MKV + o) = pack8(v0, v1); float* d = out + O_PMEM + o; *(f32x4*)d = v0; *(f32x4*)(d + 4) = v1; } }
    }
};

struct EpiBr {
    static constexpr bool PERM = true;
    const bf16_t* U; const float* SSQ; bf16_t* MERGED;
    __device__ __forceinline__ bool zero_after(const Unit& u) const { return u.kind == 2; }
    __device__ __forceinline__ void operator()(f32x4 (&acc)[2][2][4][2], const Unit& u, int wr, int wc, int fr, int fq) const {
        const int rbase = u.pm * 256 + wr * 64 + fr, c0 = u.pn * 256 + wc * 32 + 8 * fq, kind = u.kind;
        const int goffa = kind == 0 ? 0 : (kind == 1 ? 1024 : 2048), goffb = kind == 0 ? 1024 : 2048;
#pragma unroll
        for (int am = 0; am < 8; ++am) { const int ai = am >> 2, mb = am & 3;
            u32x4 ga[4][2], gb[4][2]; f32x4 q0[4], q1[4];
#pragma unroll
            for (int m = mb; m < mb + 1; ++m) { const size_t row = (size_t)(rbase + ai * 128 + m * 16);
                if (kind == 0) { q0[m] = *(const f32x4*)(SSQ + row * 32 + 8 * fq); q1[m] = *(const f32x4*)(SSQ + row * 32 + 8 * fq + 4); }
#pragma unroll
                for (int bj = 0; bj < 2; ++bj) { const bf16_t* gp = U + row * LDU + U_GATE + c0 + bj * 128; ga[m][bj] = *(const u32x4*)(gp + goffa); if (kind != 2) gb[m][bj] = *(const u32x4*)(gp + goffb); } }
#pragma unroll
            for (int m = mb; m < mb + 1; ++m) { const size_t row = (size_t)(rbase + ai * 128 + m * 16);
                float rs = 1.0f;
                if (kind == 0) { float sq = ((q0[m][0] + q0[m][1]) + (q0[m][2] + q0[m][3])) + ((q1[m][0] + q1[m][1]) + (q1[m][2] + q1[m][3]));
                    sq += __shfl_xor(sq, 16); sq += __shfl_xor(sq, 32); rs = 1.0f / sqrtf(sq * (1.0f / 1024.0f) + EPS); }
#pragma unroll
                for (int bj = 0; bj < 2; ++bj) {
                    float f[8];
                    if (kind == 2) {
#pragma unroll
                        for (int e = 0; e < 4; ++e) { f[2 * e] = __builtin_amdgcn_rcpf(1.0f + __builtin_amdgcn_exp2f(-L2E_ * __builtin_amdgcn_fmed3f(__uint_as_float(ga[m][bj][e] << 16), -60.f, 60.f))); f[2 * e + 1] = __builtin_amdgcn_rcpf(1.0f + __builtin_amdgcn_exp2f(-L2E_ * __builtin_amdgcn_fmed3f(__uint_as_float(ga[m][bj][e] & 0xffff0000u), -60.f, 60.f))); }
                    } else {
#pragma unroll
                        for (int e = 0; e < 4; ++e) {
                            const float a_lo = __builtin_amdgcn_fmed3f(__uint_as_float(ga[m][bj][e] << 16), -60.f, 60.f), a_hi = __builtin_amdgcn_fmed3f(__uint_as_float(ga[m][bj][e] & 0xffff0000u), -60.f, 60.f);
                            const float b_lo = __builtin_amdgcn_fmed3f(__uint_as_float(gb[m][bj][e] << 16), -60.f, 60.f), b_hi = __builtin_amdgcn_fmed3f(__uint_as_float(gb[m][bj][e] & 0xffff0000u), -60.f, 60.f);
                            f[2 * e] = rs * (1.0f + __builtin_amdgcn_exp2f(-L2E_ * b_lo)) * __builtin_amdgcn_rcpf(1.0f + __builtin_amdgcn_exp2f(-L2E_ * a_lo));
                            f[2 * e + 1] = rs * (1.0f + __builtin_amdgcn_exp2f(-L2E_ * b_hi)) * __builtin_amdgcn_rcpf(1.0f + __builtin_amdgcn_exp2f(-L2E_ * a_hi)); }
                    }
                    f32x4 v0 = acc[ai][bj][m][0], v1 = acc[ai][bj][m][1];
                    v0 = v0 * (f32x4){f[0], f[1], f[2], f[3]}; v1 = v1 * (f32x4){f[4], f[5], f[6], f[7]};
                    acc[ai][bj][m][0] = v0; acc[ai][bj][m][1] = v1;
                    if (kind == 2) *(u32x4*)(MERGED + row * 1024 + c0 + bj * 128) = pack8(v0, v1);
                }
            }
        }
    }
};

struct EpiOut {
    static constexpr bool PERM = false;
    const float* xp; const float* xs; float* out; float* RSQ;
    __device__ __forceinline__ bool zero_after(const Unit&) const { return true; }
    __device__ __forceinline__ void operator()(f32x4 (&acc)[2][2][4][2], const Unit& u, int wr, int wc, int fr, int fq) const {
        const int rbase = u.pm * 256 + wr * 64 + fr, c0 = u.pn * 256 + wc * 32 + 4 * fq;
#pragma unroll
        for (int am = 0; am < 4; ++am) { const int ai = am >> 1, mb = 2 * (am & 1);
            f32x4 xr[4][2][2];
#pragma unroll
            for (int m = mb; m < mb + 2; ++m) { const int row = rbase + ai * 128 + m * 16;
                const float* xq = (row < RP ? xp + (size_t)row * 1024 : xs + (size_t)(row - RP) * 1024) + c0;
#pragma unroll
                for (int bj = 0; bj < 2; ++bj)
#pragma unroll
                    for (int n = 0; n < 2; ++n) xr[m][bj][n] = *(const f32x4*)(xq + bj * 128 + n * 16); }
#pragma unroll
            for (int m = mb; m < mb + 2; ++m) { const int row = rbase + ai * 128 + m * 16;
                float* orow = out + (size_t)row * 1024 + c0;
                float s = 0.f;
#pragma unroll
                for (int bj = 0; bj < 2; ++bj)
#pragma unroll
                    for (int n = 0; n < 2; ++n) { const f32x4 r = xr[m][bj][n] + acc[ai][bj][m][n]; *(f32x4*)(orow + bj * 128 + n * 16) = r;
                        s += (r[0] * r[0] + r[1] * r[1]) + (r[2] * r[2] + r[3] * r[3]); }
                s += __shfl_xor(s, 16); s += __shfl_xor(s, 32);
                if (fq == 0) RSQ[(size_t)row * 16 + u.pn * 4 + wc] = s;
            }
        }
    }
};
struct Frame {
    LAS unsigned char* lds;
    unsigned* ctl;
    int tid, lane, wave, G, vcu;
    const float *xp, *xs, *memp, *cw128, *cw512, *cw2048, *cmem, *sconv, *sssm, *norm_in_w, *w_in, *conv_w, *conv_b, *dt_bias, *a_log, *d_skip, *ssd_norm_w, *mem_norm_w, *w_mem_kv, *w_br_ssd, *w_br_att, *w_br_mem, *w_out, *norm_f_w;
    float* out;
    bf16_t *WinT, *WmemT, *WbrT, *WoutT, *XB, *MB, *U, *MKV, *ACAT, *MERGED, *XC;
    float *CS, *DT, *SSQ, *RSQ;
};

struct Args { const float* in[24]; float* out; unsigned char* ws; int ph_lo, ph_hi; };
#define FRAME() Frame F; \
    F.lds = (LAS unsigned char*)lds; F.tid = threadIdx.x; F.lane = F.tid & 63; F.wave = __builtin_amdgcn_readfirstlane(F.tid >> 6); \
    F.G = gridDim.x; { const int bx = blockIdx.x; F.vcu = (F.G % 8 == 0) ? (bx % 8) * (F.G / 8) + bx / 8 : bx; } \
    unsigned char* ws = args.ws; F.ctl = (unsigned*)(ws + WS_CTL); \
    F.xp = args.in[0]; F.xs = args.in[1]; F.memp = args.in[2]; F.cw128 = args.in[3]; F.cw512 = args.in[4]; F.cw2048 = args.in[5]; F.cmem = args.in[6]; F.sconv = args.in[7]; F.sssm = args.in[8]; \
    F.norm_in_w = args.in[9]; F.w_in = args.in[10]; F.conv_w = args.in[11]; F.conv_b = args.in[12]; F.dt_bias = args.in[13]; F.a_log = args.in[14]; F.d_skip = args.in[15]; F.ssd_norm_w = args.in[16]; \
    F.mem_norm_w = args.in[17]; F.w_mem_kv = args.in[18]; F.w_br_ssd = args.in[19]; F.w_br_att = args.in[20]; F.w_br_mem = args.in[21]; F.w_out = args.in[22]; F.norm_f_w = args.in[23]; \
    F.out = args.out; \
    F.WinT = (bf16_t*)(ws + WS_WIN); F.WmemT = (bf16_t*)(ws + WS_WMEM); F.WbrT = (bf16_t*)(ws + WS_WBR); F.WoutT = (bf16_t*)(ws + WS_WOUT); \
    F.XB = (bf16_t*)(ws + WS_XB); F.MB = (bf16_t*)(ws + WS_MB); F.U = (bf16_t*)(ws + WS_U); F.MKV = (bf16_t*)(ws + WS_MKV); F.ACAT = (bf16_t*)(ws + WS_ACAT); F.MERGED = (bf16_t*)(ws + WS_MERGED); F.XC = (bf16_t*)(ws + WS_XC); \
    F.CS = (float*)(ws + WS_CS); F.DT = (float*)(ws + WS_DT); F.SSQ = (float*)(ws + WS_SSQ); F.RSQ = (float*)(ws + WS_RSQ)

template <int MODE>
__device__ __forceinline__ void transpose_item(const float* W, int N, const float* ksc, bf16_t* WT, int ldk, int koff, int kb, int nb, LAS float* scr, int lane) {
    const int k0 = 64 * kb, n0 = 32 * nb;
    int nsrc = n0 + (lane & 31);
    if (MODE == 1) nsrc = nsrc < 3072 ? nsrc : (nsrc < 12288 ? nsrc + 16 : (nsrc < 12304 ? 3072 + nsrc - 12288 : -1));
#pragma unroll 16
    for (int i = 0; i < 32; ++i) { const int kk = 2 * i + (lane >> 5); float v = 0.f; if (nsrc >= 0) v = W[(size_t)(k0 + kk) * N + nsrc]; if (ksc) v *= ksc[k0 + kk]; scr[kk * 33 + (lane & 31)] = v; }
    LDS_WAIT(); asm volatile("" ::: "memory");
    const int c = lane & 7;
#pragma unroll
    for (int j = 0; j < 4; ++j) { const int n = (lane >> 3) + 8 * j; const LAS float* s = scr + (8 * c) * 33 + n;
        u32x4 o; o.x = pk2(s[0 * 33], s[1 * 33]); o.y = pk2(s[2 * 33], s[3 * 33]); o.z = pk2(s[4 * 33], s[5 * 33]); o.w = pk2(s[6 * 33], s[7 * 33]);
        *(u32x4*)(WT + (size_t)(n0 + n) * ldk + koff + k0 + 8 * c) = o; }
    LDS_WAIT(); asm volatile("" ::: "memory");
}
template <int NR>
__device__ __forceinline__ void rms_rows_to_bf16(const float* const (&xrow)[NR], bf16_t* const (&orow)[NR], int lane) {
    f32x4 v[NR][4];
#pragma unroll
    for (int r = 0; r < NR; ++r)
#pragma unroll
        for (int j = 0; j < 4; ++j) v[r][j] = ((const f32x4*)xrow[r])[lane + 64 * j];
#pragma unroll
    for (int r = 0; r < NR; ++r) { float s = 0.f;
#pragma unroll
        for (int j = 0; j < 4; ++j) s += (v[r][j][0] * v[r][j][0] + v[r][j][1] * v[r][j][1]) + (v[r][j][2] * v[r][j][2] + v[r][j][3] * v[r][j][3]);
        const float rstd = 1.0f / sqrtf(wave_sum(s) * (1.0f / 1024.0f) + EPS);
        u32x2* o8 = (u32x2*)orow[r] + lane;
#pragma unroll
        for (int j = 0; j < 4; ++j) { u32x2 w; w.x = pk2(v[r][j][0] * rstd, v[r][j][1] * rstd); w.y = pk2(v[r][j][2] * rstd, v[r][j][3] * rstd); o8[64 * j] = w; } }
}
__device__ __forceinline__ void sincos_d(float angf, float& sn, float& cs) {
    const double a = (double)angf; const double k = rint(a * 0.15915494309189533577);
    double r = a - k * 6.283185307179586232; r -= k * 2.4492935982947064e-16;
    const double r2 = r * r; double ts = r, tc = 1.0, ss = r, sc = 1.0;
#pragma unroll 1
    for (int i = 1; i <= 14; ++i) { tc = -tc * r2 / (double)((2 * i - 1) * (2 * i)); ts = -ts * r2 / (double)((2 * i) * (2 * i + 1)); sc += tc; ss += ts; }
    sn = (float)ss; cs = (float)sc;
}
__device__ __forceinline__ void p0_prologue(Frame& F) {
    LAS float* scr = (LAS float*)(F.lds + F.wave * 16384);
    const int gw = F.vcu * NWAVES + F.wave, NGW = F.G * NWAVES, lane = F.lane;
    constexpr int I_IN = 16 * (NINP / 32), I_MEM = 16 * 32, I_B1 = 16 * 32, I_B2 = 8 * 32, I_B3 = 8 * 32, I_OUT = 16 * 32;
    constexpr int NITEMS = I_IN + I_MEM + I_B1 + I_B2 + I_B3 + I_OUT;
#ifndef P0_MASK
#define P0_MASK 7
#endif
    if (P0_MASK & 1)
    for (int it = gw; it < NITEMS; it += NGW) {
        int r = it;
        if (r < I_IN) { transpose_item<1>(F.w_in, 12304, F.norm_in_w, F.WinT, 1024, 0, r / (NINP / 32), r % (NINP / 32), scr, lane); continue; } r -= I_IN;
        if (r < I_MEM) { transpose_item<0>(F.w_mem_kv, 1024, F.mem_norm_w, F.WmemT, 1024, 0, r / 32, r % 32, scr, lane); continue; } r -= I_MEM;
        if (r < I_B1) { transpose_item<0>(F.w_br_ssd, 1024, F.ssd_norm_w, F.WbrT, 2048, 0, r / 32, r % 32, scr, lane); continue; } r -= I_B1;
        if (r < I_B2) { transpose_item<0>(F.w_br_att, 1024, nullptr, F.WbrT, 2048, 1024, r / 32, r % 32, scr, lane); continue; } r -= I_B2;
        if (r < I_B3) { transpose_item<0>(F.w_br_mem, 1024, nullptr, F.WbrT, 2048, 1536, r / 32, r % 32, scr, lane); continue; } r -= I_B3;
        transpose_item<0>(F.w_out, 1024, nullptr, F.WoutT, 1024, 0, r / 32, r % 32, scr, lane);
    }
    if (P0_MASK & 2)
    for (int m4 = gw; m4 < (RT + 2048) / 4; m4 += NGW) {
        const int m = 4 * m4; const float* xr[4]; bf16_t* orw[4];
#pragma unroll
        for (int r = 0; r < 4; ++r) {
            if (m < RP) { xr[r] = F.xp + (size_t)(m + r) * 1024; orw[r] = F.XB + (size_t)(m + r) * 1024; }
            else if (m < RT) { xr[r] = F.xs + (size_t)(m + r - RP) * 1024; orw[r] = F.XB + (size_t)(m + r) * 1024; }
            else { xr[r] = F.memp + (size_t)(m + r - RT) * 1024; orw[r] = F.MB + (size_t)(m + r - RT) * 1024; } }
        rms_rows_to_bf16<4>(xr, orw, lane);
    }
    if (P0_MASK & 4)
    for (int idx = (F.vcu * NTHREADS + F.tid); idx < 4100 * 8; idx += F.G * NTHREADS) {
        const int pi = idx >> 3, i = idx & 7; const int pos = pi < 4096 ? pi : 8192 + (pi - 4096);
        const float inv = i == 0 ? 1.0f : i == 1 ? 0.1939227432012558f : i == 2 ? 0.03760603070259094f : i == 3 ? 0.007292664609849453f : i == 4 ? 0.0014142135623842478f : i == 5 ? 0.00027424818836152554f : i == 6 ? 5.318296098266728e-05f : 1.0313386155758053e-05f;
        const float ang = (float)pos * inv; float sn, cs; sincos_d(ang, sn, cs);
        F.CS[(size_t)pi * 16 + i] = cs; F.CS[(size_t)pi * 16 + 8 + i] = sn;
    }
}


__device__ __forceinline__ void p1c_conv(Frame& F) {
    const int gt = F.vcu * NTHREADS + F.tid, cg = gt & 255, rbi = gt >> 8, nrb = (F.G * NTHREADS) >> 8;
    f32x4 w0[4], w1[4];
#pragma unroll
    for (int kk = 0; kk < 4; ++kk) { w0[kk] = *(const f32x4*)(F.conv_w + kk * 2048 + 8 * cg); w1[kk] = *(const f32x4*)(F.conv_w + kk * 2048 + 8 * cg + 4); }
    const f32x4 b0 = *(const f32x4*)(F.conv_b + 8 * cg), b1 = *(const f32x4*)(F.conv_b + 8 * cg + 4);
    for (int rb = rbi; rb < RT / 4; rb += nrb) {
        const int row = 4 * rb; const bool samp = row >= RP;
        f32x4 x0[7], x1[7];
#pragma unroll
        for (int k = 0; k < 7; ++k) {
            x0[k] = (f32x4){0.f, 0.f, 0.f, 0.f}; x1[k] = x0[k];
            if (k >= 3 || (!samp && (row & 4095) != 0)) { const u32x4 xr = *(const u32x4*)(F.U + (size_t)(row - 3 + k) * LDU + U_XBC + 8 * cg);
                x0[k] = (f32x4){__uint_as_float(xr.x << 16), __uint_as_float(xr.x & 0xffff0000u), __uint_as_float(xr.y << 16), __uint_as_float(xr.y & 0xffff0000u)};
                x1[k] = (f32x4){__uint_as_float(xr.z << 16), __uint_as_float(xr.z & 0xffff0000u), __uint_as_float(xr.w << 16), __uint_as_float(xr.w & 0xffff0000u)}; }
            else if (samp) { const float* sp = F.sconv + (size_t)(((row - RP) >> 2) * 3 + k) * 2048 + 8 * cg; x0[k] = *(const f32x4*)sp; x1[k] = *(const f32x4*)(sp + 4); }
        }
#pragma unroll
        for (int r = 0; r < 4; ++r) { f32x4 a0 = b0, a1 = b1;
#pragma unroll
            for (int kk = 0; kk < 4; ++kk) { a0 += w0[kk] * x0[r + kk]; a1 += w1[kk] * x1[r + kk]; }
#pragma unroll
            for (int e = 0; e < 4; ++e) { a0[e] = silu_f(a0[e]); a1[e] = silu_f(a1[e]); }
            u32x4 o; o.x = pk2(a0[0], a0[1]); o.y = pk2(a0[2], a0[3]); o.z = pk2(a1[0], a1[1]); o.w = pk2(a1[2], a1[3]);
            *(u32x4*)(F.XC + (size_t)(row + r) * 2048 + 8 * cg) = o; }
    }
    const int lane = F.lane, fr = lane & 15, fq = lane >> 4;
    for (int tile = F.vcu * NWAVES + F.wave; tile < RT / 16; tile += F.G * NWAVES) {
        const bf16_t* ap = F.XB + (size_t)(16 * tile + fr) * 1024 + 8 * fq; const bf16_t* bp = F.WinT + (size_t)(12288 + fr) * 1024 + 8 * fq;
        f32x4 d = (f32x4){0.f, 0.f, 0.f, 0.f};
#pragma unroll 8
        for (int ks = 0; ks < 32; ++ks) d = __builtin_amdgcn_mfma_f32_16x16x32_bf16(*(const bf16x8*)(ap + 32 * ks), *(const bf16x8*)(bp + 32 * ks), d, 0, 0, 0);
#pragma unroll
        for (int v = 0; v < 4; ++v) F.DT[(size_t)(16 * tile + 4 * fq + v) * 16 + fr] = d[v];
    }
}

__device__ __forceinline__ float dot64_bf16(const bf16_t* kp, const LAS float* q) {
    float s = 0.f;
#pragma unroll
    for (int c = 0; c < 8; ++c) { const u32x4 w = *(const u32x4*)(kp + 8 * c); const f32x4 q0 = *(const LAS f32x4*)(q + 8 * c), q1 = *(const LAS f32x4*)(q + 8 * c + 4);
        s += __uint_as_float(w.x << 16) * q0[0] + __uint_as_float(w.x & 0xffff0000u) * q0[1] + __uint_as_float(w.y << 16) * q0[2] + __uint_as_float(w.y & 0xffff0000u) * q0[3]
           + __uint_as_float(w.z << 16) * q1[0] + __uint_as_float(w.z & 0xffff0000u) * q1[1] + __uint_as_float(w.w << 16) * q1[2] + __uint_as_float(w.w & 0xffff0000u) * q1[3]; }
    return s;
}
__device__ __forceinline__ float dot64_f32(const float* kp, const LAS float* q) {
    float s = 0.f;
#pragma unroll
    for (int c = 0; c < 16; ++c) { const f32x4 w = *(const f32x4*)(kp + 4 * c); const f32x4 q0 = *(const LAS f32x4*)(q + 4 * c); s += w[0] * q0[0] + w[1] * q0[1] + w[2] * q0[2] + w[3] * q0[3]; }
    return s;
}
typedef float f32x16 __attribute__((ext_vector_type(16)));
typedef short s16x4 __attribute__((ext_vector_type(4)));
typedef short v4i16_t __attribute__((ext_vector_type(4)));
typedef __bf16 bf16x2_t __attribute__((ext_vector_type(2)));
typedef float f32x2_t __attribute__((ext_vector_type(2)));
__device__ __forceinline__ unsigned cvtpk(float lo, float hi) { f32x2_t v = {lo, hi}; bf16x2_t b = __builtin_convertvector(v, bf16x2_t); return __builtin_bit_cast(unsigned, b); }
__device__ __forceinline__ s16x4 vtr(const LAS char* p) { return __builtin_bit_cast(s16x4, __builtin_amdgcn_ds_read_tr16_b64_v4i16((LAS v4i16_t*)p)); }
#define MFMA32(a, b, c) __builtin_amdgcn_mfma_f32_32x32x16_bf16((a), (b), (c), 0, 0, 0)
constexpr float L2E = 1.4426950408889634f;

template <int HD, bool MASK, bool DEEP>
__device__ __forceinline__ void att_tile_range(f32x16 (&o)[HD / 32], float& mrun, float& lrun, const bf16x8 (&qf)[HD / 16], const bf16_t* kp, const bf16_t* vp, size_t kstride, int ntiles, int rel0, float sl2e, LAS char* vl, int lane) {
    constexpr int NS = HD / 16, RSB = HD * 2 + 64, CPR = HD / 8, RPI = 64 / CPR;
    const int h = lane >> 5;
    const LAS char* trb = vl + (4 * h + ((lane & 15) >> 2)) * RSB + 32 * ((lane >> 4) & 1) + 8 * (lane & 3);
    LAS char* wrb = vl + (lane / CPR) * RSB + (lane % CPR) * 16;
    bf16x8 ka[NS], kb[DEEP ? NS : 1]; u32x4 va[NS];
#define ATT_LDK(dst, t_) do { const bf16_t* kq_ = kp + (size_t)(t_) * 32 * kstride; _Pragma("unroll") for (int s = 0; s < NS; ++s) dst[s] = *(const bf16x8*)(kq_ + 16 * s); } while (0)
#define ATT_LDV(dst, t_) do { const bf16_t* vq_ = vp + (size_t)(t_) * 32 * kstride; _Pragma("unroll") for (int s = 0; s < NS; ++s) dst[s] = *(const u32x4*)(vq_ + (size_t)(RPI * s) * kstride); } while (0)
#define ATT_STV(src) do { _Pragma("unroll") for (int s = 0; s < NS; ++s) *(LAS u32x4*)(wrb + (RPI * s) * RSB) = src[s]; } while (0)
#define ATT_STEP(KU, VN, VW, KAHEAD, VAHEAD) do { \
        if (kt + (VAHEAD) < ntiles) ATT_LDV(VN, kt + (VAHEAD)); \
        f32x16 sc; \
        _Pragma("unroll") for (int v = 0; v < 16; ++v) sc[v] = 0.f; \
        _Pragma("unroll") for (int s = 0; s < NS; ++s) sc = MFMA32(KU[s], qf[s], sc); \
        if (kt + (KAHEAD) < ntiles) ATT_LDK(KU, kt + (KAHEAD)); \
        float tmax = -1e30f; \
        if (MASK && (kt == 0 || kt + 1 == ntiles)) { \
            _Pragma("unroll") for (int v = 0; v < 16; ++v) { float y = sc[v] * sl2e; const int rel = rel0 - 32 * kt - ((v & 3) + 8 * (v >> 2)); if ((unsigned)rel > 128u) y = -1e30f; sc[v] = y; tmax = fmaxf(tmax, y); } \
        } else { \
            _Pragma("unroll") for (int v = 0; v < 16; ++v) { const float y = sc[v] * sl2e; sc[v] = y; tmax = fmaxf(tmax, y); } \
        } \
        tmax = fmaxf(tmax, __shfl_xor(tmax, 32)); \
        const float mnew = fmaxf(mrun, tmax); \
        if (__any(mnew > mrun)) { const float alpha = __builtin_amdgcn_exp2f(mrun - mnew); \
            _Pragma("unroll") for (int mt = 0; mt < HD / 32; ++mt) o[mt] = o[mt] * alpha; \
            lrun *= alpha; mrun = mnew; } \
        float ps = 0.f; unsigned pk[8]; \
        _Pragma("unroll") for (int v = 0; v < 16; v += 2) { const float p0 = __builtin_amdgcn_exp2f(sc[v] - mrun), p1 = __builtin_amdgcn_exp2f(sc[v + 1] - mrun); ps += p0 + p1; pk[v >> 1] = cvtpk(p0, p1); } \
        lrun += ps; \
        const bf16x8 pf0 = __builtin_bit_cast(bf16x8, (u32x4){pk[0], pk[1], pk[2], pk[3]}), pf1 = __builtin_bit_cast(bf16x8, (u32x4){pk[4], pk[5], pk[6], pk[7]}); \
        _Pragma("unroll") for (int mt = 0; mt < HD / 32; ++mt) { \
            const s16x4 a0 = vtr(trb + 64 * mt), a1 = vtr(trb + 8 * RSB + 64 * mt), a2 = vtr(trb + 16 * RSB + 64 * mt), a3 = vtr(trb + 24 * RSB + 64 * mt); \
            o[mt] = MFMA32(__builtin_shufflevector(a0, a1, 0, 1, 2, 3, 4, 5, 6, 7), pf0, o[mt]); \
            o[mt] = MFMA32(__builtin_shufflevector(a2, a3, 0, 1, 2, 3, 4, 5, 6, 7), pf1, o[mt]); } \
        if (kt + 1 < ntiles) ATT_STV(VW); } while (0)
    ATT_LDK(ka, 0); ATT_LDV(va, 0);
    ATT_STV(va);
    if (DEEP) {
        if (ntiles > 1) ATT_LDK(kb, 1);
#pragma unroll 1
        for (int kt = 0; kt < ntiles; ++kt) {
            ATT_STEP(ka, va, va, 2, 1);
            if (++kt >= ntiles) break;
            ATT_STEP(kb, va, va, 2, 1);
        }
    } else {
#pragma unroll 1
        for (int kt = 0; kt < ntiles; ++kt) ATT_STEP(ka, va, va, 1, 1);
    }
#undef ATT_LDK
#undef ATT_LDV
#undef ATT_STV
#undef ATT_STEP
}
__device__ __forceinline__ void att_tile_pair(f32x16 (&oa)[2], f32x16 (&ob)[2], float& ma, float& la, float& mb, float& lb, const bf16x8 (&qa)[4], const bf16x8 (&qb)[4],
                                              const bf16_t* kp, const bf16_t* vp, size_t kstride, int ntiles, int dq  , LAS char* vl, int lane) {
    constexpr int RSB = 192;
    const int h = lane >> 5, c = lane & 31;
    const LAS char* trb = vl + (4 * h + ((lane & 15) >> 2)) * RSB + 32 * ((lane >> 4) & 1) + 8 * (lane & 3);
    LAS char* wrb = vl + (lane >> 3) * RSB + (lane & 7) * 16;
    bf16x8 kf[4]; u32x4 vr[4];
#pragma unroll
    for (int s = 0; s < 4; ++s) { kf[s] = *(const bf16x8*)(kp + 16 * s); vr[s] = *(const u32x4*)(vp + (size_t)(8 * s) * kstride); }
#pragma unroll
    for (int s = 0; s < 4; ++s) *(LAS u32x4*)(wrb + (8 * s) * RSB) = vr[s];
#pragma unroll 1
    for (int kt = 0; kt < ntiles; ++kt) {
        const bool more = kt + 1 < ntiles;
        if (more) { const bf16_t* vq_ = vp + (size_t)(kt + 1) * 32 * kstride;
#pragma unroll
            for (int s = 0; s < 4; ++s) vr[s] = *(const u32x4*)(vq_ + (size_t)(8 * s) * kstride); }
        const int hiA = dq + 31 - 32 * kt, loA = dq - 32 * kt - 31, hiB = hiA + 32, loB = loA + 32;
        const bool useA = hiA >= 0 && loA <= 128, useB = hiB >= 0 && loB <= 128, mskA = !(loA >= 0 && hiA <= 128), mskB = !(loB >= 0 && hiB <= 128);
        f32x16 sa, sb;
#pragma unroll
        for (int v = 0; v < 16; ++v) { sa[v] = 0.f; sb[v] = 0.f; }
        if (useA) {
#pragma unroll
            for (int s = 0; s < 4; ++s) sa = MFMA32(kf[s], qa[s], sa); }
        if (useB) {
#pragma unroll
            for (int s = 0; s < 4; ++s) sb = MFMA32(kf[s], qb[s], sb); }
        if (more) { const bf16_t* kq_ = kp + (size_t)(kt + 1) * 32 * kstride;
#pragma unroll
            for (int s = 0; s < 4; ++s) kf[s] = *(const bf16x8*)(kq_ + 16 * s); }
        bf16x8 pa0, pa1, pb0, pb1;
#define ATT_SOFTMAX(SC, MSK, REL0, M, Lr, O, P0, P1) do { float tmax = -1e30f; \
            if (MSK) { _Pragma("unroll") for (int v = 0; v < 16; ++v) { float y = SC[v] * L2E; const int rel = (REL0) - ((v & 3) + 8 * (v >> 2)); if ((unsigned)rel > 128u) y = -1e30f; SC[v] = y; tmax = fmaxf(tmax, y); } } \
            else { _Pragma("unroll") for (int v = 0; v < 16; ++v) { const float y = SC[v] * L2E; SC[v] = y; tmax = fmaxf(tmax, y); } } \
            tmax = fmaxf(tmax, __shfl_xor(tmax, 32)); \
            const float mnew = fmaxf(M, tmax); \
            if (__any(mnew > M)) { const float alpha = __builtin_amdgcn_exp2f(M - mnew); O[0] = O[0] * alpha; O[1] = O[1] * alpha; Lr *= alpha; M = mnew; } \
            float ps = 0.f; unsigned pk[8]; \
            _Pragma("unroll") for (int v = 0; v < 16; v += 2) { const float p0 = __builtin_amdgcn_exp2f(SC[v] - M), p1 = __builtin_amdgcn_exp2f(SC[v + 1] - M); ps += p0 + p1; pk[v >> 1] = cvtpk(p0, p1); } \
            Lr += ps; \
            P0 = __builtin_bit_cast(bf16x8, (u32x4){pk[0], pk[1], pk[2], pk[3]}); P1 = __builtin_bit_cast(bf16x8, (u32x4){pk[4], pk[5], pk[6], pk[7]}); } while (0)
        const int relA = dq + c - 4 * h - 32 * kt;
        if (useA) ATT_SOFTMAX(sa, mskA, relA, ma, la, oa, pa0, pa1);
        if (useB) ATT_SOFTMAX(sb, mskB, relA + 32, mb, lb, ob, pb0, pb1);
#undef ATT_SOFTMAX
#pragma unroll
        for (int mt = 0; mt < 2; ++mt) {
            const s16x4 a0 = vtr(trb + 64 * mt), a1 = vtr(trb + 8 * RSB + 64 * mt), a2 = vtr(trb + 16 * RSB + 64 * mt), a3 = vtr(trb + 24 * RSB + 64 * mt);
            const bf16x8 v0 = __builtin_shufflevector(a0, a1, 0, 1, 2, 3, 4, 5, 6, 7), v1 = __builtin_shufflevector(a2, a3, 0, 1, 2, 3, 4, 5, 6, 7);
            if (useA) { oa[mt] = MFMA32(v0, pa0, oa[mt]); oa[mt] = MFMA32(v1, pa1, oa[mt]); }
            if (useB) { ob[mt] = MFMA32(v0, pb0, ob[mt]); ob[mt] = MFMA32(v1, pb1, ob[mt]); }
        }
        if (more) {
#pragma unroll
            for (int s = 0; s < 4; ++s) *(LAS u32x4*)(wrb + (8 * s) * RSB) = vr[s]; }
    }
}
template <int HD>
__device__ __forceinline__ void att_store(const f32x16 (&o)[HD / 32], float lrun, const bf16_t* zrow, bf16_t* orow, int lane) {
    const int h = lane >> 5;
    const float inv = 1.0f / (lrun + __shfl_xor(lrun, 32));
#pragma unroll
    for (int mt = 0; mt < HD / 32; ++mt)
#pragma unroll
        for (int vq = 0; vq < 4; ++vq) {
            const int d = 32 * mt + 8 * vq + 4 * h;
            const u32x2 zz = *(const u32x2*)(zrow + d);
            const float z0 = __uint_as_float(zz.x << 16), z1 = __uint_as_float(zz.x & 0xffff0000u), z2 = __uint_as_float(zz.y << 16), z3 = __uint_as_float(zz.y & 0xffff0000u);
            u32x2 w; w.x = cvtpk(o[mt][4 * vq] * inv * silu_f(z0), o[mt][4 * vq + 1] * inv * silu_f(z1)); w.y = cvtpk(o[mt][4 * vq + 2] * inv * silu_f(z2), o[mt][4 * vq + 3] * inv * silu_f(z3));
            *(u32x2*)(orow + d) = w;
        }
}
constexpr int ATT_ST_OFF = 8 * 6144, ATT_ST_PITCH = 144;
template <int PHASE  >
__device__ __forceinline__ void att_merge(Frame& F, f32x16 (&o)[2], float mrun, float lrun, LAS char* strow, const bf16_t* zrow, bf16_t* orow, int lane) {
    const int h = lane >> 5;
    float lu = lrun + __shfl_xor(lrun, 32), au = 1.0f, as = 0.f, m = mrun;
    if (PHASE > 0) { const f32x2 ml = *(const LAS f32x2*)(strow + 128); m = fmaxf(ml[0], mrun); as = __builtin_amdgcn_exp2f(ml[0] - m); au = __builtin_amdgcn_exp2f(mrun - m); lu = ml[1] * as + lu * au; }
    const float inv = 1.0f / lu;
#pragma unroll
    for (int mt = 0; mt < 2; ++mt)
#pragma unroll
        for (int vq = 0; vq < 4; ++vq) {
            const int d = 32 * mt + 8 * vq + 4 * h;
            float v0 = o[mt][4 * vq] * au, v1 = o[mt][4 * vq + 1] * au, v2 = o[mt][4 * vq + 2] * au, v3 = o[mt][4 * vq + 3] * au;
            if (PHASE > 0) { const u32x2 os = *(const LAS u32x2*)(strow + 2 * d);
                v0 += __uint_as_float(os.x << 16) * as; v1 += __uint_as_float(os.x & 0xffff0000u) * as; v2 += __uint_as_float(os.y << 16) * as; v3 += __uint_as_float(os.y & 0xffff0000u) * as; }
            if (PHASE < 2) { u32x2 w; w.x = cvtpk(v0, v1); w.y = cvtpk(v2, v3); *(LAS u32x2*)(strow + 2 * d) = w; }
            else { const u32x2 zz = *(const u32x2*)(zrow + d);
                const float z0 = __uint_as_float(zz.x << 16), z1 = __uint_as_float(zz.x & 0xffff0000u), z2 = __uint_as_float(zz.y << 16), z3 = __uint_as_float(zz.y & 0xffff0000u);
                u32x2 w; w.x = cvtpk(v0 * inv * silu_f(z0), v1 * inv * silu_f(z1)); w.y = cvtpk(v2 * inv * silu_f(z2), v3 * inv * silu_f(z3)); *(u32x2*)(orow + d) = w; }
        }
    if (PHASE < 2 && h == 0) *(LAS f32x2*)(strow + 128) = (f32x2){m, lu};
}
template <int PHASE>
__device__ __forceinline__ void att_prompt_unit(Frame& F, int b, int head, int J, int u, LAS char* vl) {
    constexpr int g = 2 - PHASE, lg = 2 * g, dil = 1 << lg;
    const int lane = F.lane, c = lane & 31, h = lane >> 5;
    const int rg = PHASE == 0 ? u : (PHASE == 1 ? (u & 3) : 0), k = PHASE == 0 ? 0 : (PHASE == 1 ? (u >> 2) : u);
    const int tl = ((32 * k + c) << lg) + rg, tc = 512 * J + tl; const size_t rowc = (size_t)b * 4096 + tc;
    const int qoff = U_QKV + g * 1536 + head * 64;
    bf16x8 qf[4];
#pragma unroll
    for (int s = 0; s < 4; ++s) qf[s] = *(const bf16x8*)(F.U + rowc * LDU + qoff + 16 * s + 8 * h);
    const int qi0 = ((512 * J) >> lg) + 32 * k, ks = qi0 >= 128 ? qi0 - 128 : 0, ntiles = ((qi0 - ks) >> 5) + 1;
    const size_t kstride = (size_t)dil * LDU;
    const bf16_t* base = F.U + ((size_t)b * 4096 + (size_t)ks * dil + rg) * LDU + qoff;
    f32x16 o[2];
#pragma unroll
    for (int v = 0; v < 16; ++v) { o[0][v] = 0.f; o[1][v] = 0.f; }
    float mrun = -1e29f, lrun = 0.f;
    att_tile_range<64, true, true>(o, mrun, lrun, qf, base + 512 + (size_t)c * kstride + 8 * h, base + 1024 + (size_t)(lane >> 3) * kstride + (lane & 7) * 8, kstride, ntiles, qi0 + c - ks - 4 * h, L2E, vl, lane);
    att_merge<PHASE>(F, o, mrun, lrun, (LAS char*)F.lds + ATT_ST_OFF + tl * ATT_ST_PITCH, F.U + rowc * LDU + U_ZA + head * 64, F.ACAT + rowc * LDA + 1024 + head * 64, lane);
}
template <int PHASE>
__device__ __forceinline__ void att_prompt_pair(Frame& F, int b, int head, int J, int u, LAS char* vl) {
    constexpr int g = 2 - PHASE, lg = 2 * g, dil = 1 << lg;
    const int lane = F.lane, c = lane & 31, h = lane >> 5;
    const int rg = PHASE == 1 ? (u & 3) : 0, kpair = PHASE == 1 ? (u >> 2) : u;
    const int tlA = ((64 * kpair + c) << lg) + rg, tlB = ((64 * kpair + 32 + c) << lg) + rg;
    const size_t rowA = (size_t)b * 4096 + 512 * J + tlA, rowB = (size_t)b * 4096 + 512 * J + tlB;
    const int qoff = U_QKV + g * 1536 + head * 64;
    bf16x8 qa[4], qb[4];
#pragma unroll
    for (int s = 0; s < 4; ++s) { qa[s] = *(const bf16x8*)(F.U + rowA * LDU + qoff + 16 * s + 8 * h); qb[s] = *(const bf16x8*)(F.U + rowB * LDU + qoff + 16 * s + 8 * h); }
    const int qi0 = ((512 * J) >> lg) + 64 * kpair, ks = qi0 >= 128 ? qi0 - 128 : 0, ntiles = ((qi0 + 32 - ks) >> 5) + 1;
    const size_t kstride = (size_t)dil * LDU;
    const bf16_t* base = F.U + ((size_t)b * 4096 + (size_t)ks * dil + rg) * LDU + qoff;
    f32x16 oa[2], ob[2];
#pragma unroll
    for (int v = 0; v < 16; ++v) { oa[0][v] = 0.f; oa[1][v] = 0.f; ob[0][v] = 0.f; ob[1][v] = 0.f; }
    float ma = -1e29f, la = 0.f, mb = -1e29f, lb = 0.f;
    att_tile_pair(oa, ob, ma, la, mb, lb, qa, qb, base + 512 + (size_t)c * kstride + 8 * h, base + 1024 + (size_t)(lane >> 3) * kstride + (lane & 7) * 8, kstride, ntiles, qi0 - ks, vl, lane);
    att_merge<PHASE>(F, oa, ma, la, (LAS char*)F.lds + ATT_ST_OFF + tlA * ATT_ST_PITCH, F.U + rowA * LDU + U_ZA + head * 64, F.ACAT + rowA * LDA + 1024 + head * 64, lane);
    att_merge<PHASE>(F, ob, mb, lb, (LAS char*)F.lds + ATT_ST_OFF + tlB * ATT_ST_PITCH, F.U + rowB * LDU + U_ZA + head * 64, F.ACAT + rowB * LDA + 1024 + head * 64, lane);
}
__device__ __forceinline__ void att_prompt_item(Frame& F, int b, int head, int J, LAS char* vl) {
#pragma unroll 1
    for (int u = 2 * F.wave; u < 2 * F.wave + 2; ++u) att_prompt_unit<0>(F, b, head, J, u, vl);
    __syncthreads();
    att_prompt_pair<1>(F, b, head, J, F.wave, vl);
    __syncthreads();
    att_prompt_pair<2>(F, b, head, J, F.wave, vl);
}
__device__ __forceinline__ void mem_prompt_item(Frame& F, int b, int head, int q0) {
    constexpr int KP = 272, VP = 320, STG = 32 * KP + 32 * VP;
    const int tid = F.tid, lane = F.lane, w = F.wave, c = lane & 31, h = lane >> 5;
    LAS char* L = (LAS char*)F.lds;
    const size_t rowc = (size_t)b * 4096 + q0 + 32 * w + c;
    bf16x8 qf[8];
#pragma unroll
    for (int s = 0; s < 8; ++s) qf[s] = *(const bf16x8*)(F.U + rowc * LDU + U_QM + head * 128 + 16 * s + 8 * h);
    const int pr = tid >> 4, pc = tid & 15;
    const bf16_t* ksrc = F.MKV + ((size_t)b * 256 + pr) * 1024 + head * 128 + 8 * pc;
    LAS char* kdst = L + pr * KP + 16 * pc; LAS char* vdst = L + 32 * KP + pr * VP + 16 * pc;
    f32x16 o[4];
#pragma unroll
    for (int v = 0; v < 16; ++v) { o[0][v] = 0.f; o[1][v] = 0.f; o[2][v] = 0.f; o[3][v] = 0.f; }
    float mrun = -1e29f, lrun = 0.f;
    const float sl2e = 0.08838834764831845f * L2E;
    u32x4 ka, va, kb, vb;
    ka = *(const u32x4*)ksrc; va = *(const u32x4*)(ksrc + 512);
    kb = *(const u32x4*)(ksrc + 32 * 1024); vb = *(const u32x4*)(ksrc + 32 * 1024 + 512);
    *(LAS u32x4*)kdst = ka; *(LAS u32x4*)vdst = va;
    __syncthreads();
    const LAS char* krd = L + c * KP + 16 * h;
    const LAS char* trb = L + 32 * KP + (4 * h + ((lane & 15) >> 2)) * VP + 32 * ((lane >> 4) & 1) + 8 * (lane & 3);
#define MEM_STEP(RN, RW_K, RW_V) do { const int so = (kt & 1) * STG; \
        if (kt + 2 < 8) { RN##a_ = *(const u32x4*)(ksrc + (size_t)(kt + 2) * 32 * 1024); RN##b_ = *(const u32x4*)(ksrc + (size_t)(kt + 2) * 32 * 1024 + 512); } \
        f32x16 sc; \
        _Pragma("unroll") for (int v = 0; v < 16; ++v) sc[v] = 0.f; \
        _Pragma("unroll") for (int s = 0; s < 8; ++s) { const bf16x8 kf = *(const LAS bf16x8*)(krd + so + 32 * s); sc = MFMA32(kf, qf[s], sc); } \
        float tmax = -1e30f; \
        _Pragma("unroll") for (int v = 0; v < 16; ++v) { const float y = sc[v] * sl2e; sc[v] = y; tmax = fmaxf(tmax, y); } \
        tmax = fmaxf(tmax, __shfl_xor(tmax, 32)); \
        const float mnew = fmaxf(mrun, tmax); \
        if (__any(mnew > mrun)) { const float alpha = __builtin_amdgcn_exp2f(mrun - mnew); \
            _Pragma("unroll") for (int mt = 0; mt < 4; ++mt) o[mt] = o[mt] * alpha; \
            lrun *= alpha; mrun = mnew; } \
        float ps = 0.f; unsigned pk[8]; \
        _Pragma("unroll") for (int v = 0; v < 16; v += 2) { const float p0 = __builtin_amdgcn_exp2f(sc[v] - mrun), p1 = __builtin_amdgcn_exp2f(sc[v + 1] - mrun); ps += p0 + p1; pk[v >> 1] = cvtpk(p0, p1); } \
        lrun += ps; \
        const bf16x8 pf0 = __builtin_bit_cast(bf16x8, (u32x4){pk[0], pk[1], pk[2], pk[3]}), pf1 = __builtin_bit_cast(bf16x8, (u32x4){pk[4], pk[5], pk[6], pk[7]}); \
        _Pragma("unroll") for (int mt = 0; mt < 4; ++mt) { \
            const s16x4 a0 = vtr(trb + so + 64 * mt), a1 = vtr(trb + so + 8 * VP + 64 * mt), a2 = vtr(trb + so + 16 * VP + 64 * mt), a3 = vtr(trb + so + 24 * VP + 64 * mt); \
            o[mt] = MFMA32(__builtin_shufflevector(a0, a1, 0, 1, 2, 3, 4, 5, 6, 7), pf0, o[mt]); \
            o[mt] = MFMA32(__builtin_shufflevector(a2, a3, 0, 1, 2, 3, 4, 5, 6, 7), pf1, o[mt]); } \
        if (kt + 1 < 8) { *(LAS u32x4*)(kdst + (STG - so)) = RW_K; *(LAS u32x4*)(vdst + (STG - so)) = RW_V; } \
        __syncthreads(); } while (0)
    u32x4 Aa_, Ab_, Ba_, Bb_;
    Ba_ = kb; Bb_ = vb;
#pragma unroll 1
    for (int kt = 0; kt < 8; kt += 2) {
        MEM_STEP(A, Ba_, Bb_);
        { const int kt_ = kt; (void)kt_; }
        { int ktn = kt + 1; const int kt = ktn; MEM_STEP(B, Aa_, Ab_); }
    }
#undef MEM_STEP
    att_store<128>(o, lrun, F.U + rowc * LDU + U_ZM + head * 128, F.ACAT + rowc * LDA + 1536 + head * 128, lane);
}
__device__ __forceinline__ void ssd_prompt_unit(Frame& F, int b, int h) {
    constexpr int XP = 192, BP = 320, CP = 272, IMG = 2 * 64 * XP + 64 * BP  , XWO = 64 * XP, BIO = 2 * 64 * XP, S0 = 2 * IMG, S1 = S0 + 64 * CP, ARR = S1 + 64 * CP;
    const int tid = F.tid, lane = F.lane, w = F.wave, g = h >> 2, c32 = lane & 31, hh = lane >> 5;
    LAS char* L = (LAS char*)F.lds;
    for (int idx = tid; idx < 64 * CP / 4; idx += NTHREADS) ((LAS unsigned*)(L + S0))[idx] = 0u;
    const float a = -__expf(F.a_log[h]), dsk = F.d_skip[h], dtb = F.dt_bias[h];
    const size_t row0 = (size_t)b * 4096;
    const int xr = tid >> 3, xc8 = tid & 7, br = tid >> 4, bc8 = tid & 15;
    const bf16_t* xsrc = F.XC + (row0 + xr) * 2048 + h * 64 + 8 * xc8;
    const bf16_t* bsrc = F.XC + (row0 + br) * 2048 + 1024 + g * 128 + 8 * bc8;
    const bf16_t* csrc = F.XC + row0 * 2048 + 1536 + g * 128 + 8 * hh;
    const int pt = (w >> 1) & 1, j = w & 1;
    const int pt2 = (w >> 1) & 1, ntb = 2 * (w & 1);
    const int q4 = (lane & 15) >> 2, p4 = lane & 3, blk = (lane >> 4) & 1;
    u32x4 rx, rb0, rb1; float dtraw; bf16x8 cf[8];
#define SSD_LOAD(cc) do { const size_t ro = (size_t)(64 * (cc)) * 2048; rx = *(const u32x4*)(xsrc + ro); rb0 = *(const u32x4*)(bsrc + ro); rb1 = *(const u32x4*)(bsrc + ro + 32 * 2048); \
        dtraw = F.DT[(row0 + 64 * (cc) + lane) * 16 + h]; \
        if (w < 4) { _Pragma("unroll") for (int ks = 0; ks < 8; ++ks) cf[ks] = *(const bf16x8*)(csrc + ro + (size_t)(32 * j + c32) * 2048 + 16 * ks); } } while (0)
#define SSD_PREP(cc) do { LAS float* arr_ = (LAS float*)(L + ARR + ((cc) & 1) * 1024); LAS char* I_ = L + ((cc) & 1) * IMG; \
        const float xx = dtraw + dtb; const float dt = xx > 20.f ? xx : log1pf(__expf(xx)); \
        float acs = dt * a; \
        _Pragma("unroll") for (int o = 1; o < 64; o <<= 1) { const float up = __shfl_up(acs, o); if (lane >= o) acs += up; } \
        const float last = __shfl(acs, 63); const float wd = dt * __expf(last - acs); \
        arr_[lane] = acs * L2E; arr_[64 + lane] = (acs - __logf(dt)) * L2E; arr_[128 + lane] = __expf(acs); \
        const float wdx = __shfl(wd, xr); \
        *(LAS u32x4*)(I_ + xr * XP + 16 * xc8) = rx; \
        { u32x4 o_; o_.x = cvtpk(__uint_as_float(rx.x << 16) * wdx, __uint_as_float(rx.x & 0xffff0000u) * wdx); o_.y = cvtpk(__uint_as_float(rx.y << 16) * wdx, __uint_as_float(rx.y & 0xffff0000u) * wdx); \
          o_.z = cvtpk(__uint_as_float(rx.z << 16) * wdx, __uint_as_float(rx.z & 0xffff0000u) * wdx); o_.w = cvtpk(__uint_as_float(rx.w << 16) * wdx, __uint_as_float(rx.w & 0xffff0000u) * wdx); \
          *(LAS u32x4*)(I_ + XWO + xr * XP + 16 * xc8) = o_; } \
        *(LAS u32x4*)(I_ + BIO + br * BP + 16 * bc8) = rb0; *(LAS u32x4*)(I_ + BIO + (32 + br) * BP + 16 * bc8) = rb1; } while (0)
    SSD_LOAD(0);
    f32x16 st0, st1;
#pragma unroll
    for (int v = 0; v < 16; ++v) { st0[v] = 0.f; st1[v] = 0.f; }
    bf16x8 cc_[8];
    SSD_PREP(0);
#pragma unroll
    for (int ks = 0; ks < 8; ++ks) cc_[ks] = cf[ks];
    __syncthreads();
#pragma unroll 1
    for (int c = 0; c < 64; ++c) {
        const LAS float* arr = (const LAS float*)(L + ARR + (c & 1) * 1024);
        const LAS char* I = L + (c & 1) * IMG;
        const LAS char* Scur = L + ((c & 1) ? S1 : S0); LAS char* Snxt = L + ((c & 1) ? S0 : S1);
        if (c + 1 < 64) SSD_LOAD(c + 1);
        if (w < 4) {
            const int l = 32 * j + c32; const size_t row = row0 + 64 * c + l;
            u32x2 zz[4];
#pragma unroll
            for (int vq = 0; vq < 4; ++vq) zz[vq] = *(const u32x2*)(F.U + row * LDU + U_Z + h * 64 + 32 * pt + 8 * vq + 4 * hh);
            f32x16 acc;
#pragma unroll
            for (int v = 0; v < 16; ++v) acc[v] = 0.f;
#pragma unroll
            for (int ks = 0; ks < 8; ++ks) { const bf16x8 sa = *(const LAS bf16x8*)(Scur + (32 * pt + c32) * CP + (16 * ks + 8 * hh) * 2); acc = MFMA32(sa, cc_[ks], acc); }
            const float al = arr[l];
            acc = acc * arr[128 + l];
#pragma unroll 1
            for (int i = 0; i <= j; ++i) {
                f32x16 cb;
#pragma unroll
                for (int v = 0; v < 16; ++v) cb[v] = 0.f;
#pragma unroll
                for (int ks = 0; ks < 8; ++ks) { const bf16x8 ba = *(const LAS bf16x8*)(I + BIO + (32 * i + c32) * BP + (16 * ks + 8 * hh) * 2); cb = MFMA32(ba, cc_[ks], cb); }
                unsigned pk[8];
#pragma unroll
                for (int vq = 0; vq < 4; ++vq) {
                    const f32x4 es = *(const LAS f32x4*)(arr + 64 + 32 * i + 8 * vq + 4 * hh);
                    float m[4];
#pragma unroll
                    for (int e = 0; e < 4; ++e) { m[e] = cb[4 * vq + e] * __builtin_amdgcn_exp2f(al - es[e]); if (i == j && (8 * vq + 4 * hh + e) > c32) m[e] = 0.f; }
                    pk[2 * vq] = cvtpk(m[0], m[1]); pk[2 * vq + 1] = cvtpk(m[2], m[3]);
                }
                const bf16x8 pf0 = __builtin_bit_cast(bf16x8, (u32x4){pk[0], pk[1], pk[2], pk[3]}), pf1 = __builtin_bit_cast(bf16x8, (u32x4){pk[4], pk[5], pk[6], pk[7]});
                const LAS char* xb = I + (32 * i + 4 * hh + q4) * XP + (32 * pt + 16 * blk + 4 * p4) * 2;
                const s16x4 a0 = vtr(xb), a1 = vtr(xb + 8 * XP), a2 = vtr(xb + 16 * XP), a3 = vtr(xb + 24 * XP);
                acc = MFMA32(__builtin_shufflevector(a0, a1, 0, 1, 2, 3, 4, 5, 6, 7), pf0, acc);
                acc = MFMA32(__builtin_shufflevector(a2, a3, 0, 1, 2, 3, 4, 5, 6, 7), pf1, acc);
            }
            float ssq = 0.f;
#pragma unroll
            for (int vq = 0; vq < 4; ++vq) {
                const int p = 32 * pt + 8 * vq + 4 * hh;
                const u32x2 xs = *(const LAS u32x2*)(I + l * XP + p * 2);
                const float x0 = __uint_as_float(xs.x << 16), x1 = __uint_as_float(xs.x & 0xffff0000u), x2 = __uint_as_float(xs.y << 16), x3 = __uint_as_float(xs.y & 0xffff0000u);
                const float z0 = __uint_as_float(zz[vq].x << 16), z1 = __uint_as_float(zz[vq].x & 0xffff0000u), z2 = __uint_as_float(zz[vq].y << 16), z3 = __uint_as_float(zz[vq].y & 0xffff0000u);
                const float v0 = (acc[4 * vq] + dsk * x0) * silu_f(z0), v1 = (acc[4 * vq + 1] + dsk * x1) * silu_f(z1), v2 = (acc[4 * vq + 2] + dsk * x2) * silu_f(z2), v3 = (acc[4 * vq + 3] + dsk * x3) * silu_f(z3);
                ssq += (v0 * v0 + v1 * v1) + (v2 * v2 + v3 * v3);
                u32x2 o; o.x = cvtpk(v0, v1); o.y = cvtpk(v2, v3);
                *(u32x2*)(F.ACAT + row * LDA + h * 64 + p) = o;
            }
            ssq += __shfl_xor(ssq, 32);
            if (hh == 0) F.SSQ[row * 32 + 2 * h + pt] = ssq;
        } else {
            const float dec = arr[128 + 63];
            st0 = st0 * dec; st1 = st1 * dec;
            const LAS char* bb = I + BIO + (8 * hh + q4) * BP + (32 * ntb + 16 * blk + 4 * p4) * 2;
            const LAS char* xw = I + XWO + (8 * hh + q4) * XP + (32 * pt2 + 16 * blk + 4 * p4) * 2;
#pragma unroll
            for (int ks = 0; ks < 4; ++ks) {
                const s16x4 x0 = vtr(xw + 16 * ks * XP), x1 = vtr(xw + (16 * ks + 4) * XP);
                const bf16x8 xf = __builtin_shufflevector(x0, x1, 0, 1, 2, 3, 4, 5, 6, 7);
                const s16x4 b0 = vtr(bb + 16 * ks * BP), b1 = vtr(bb + (16 * ks + 4) * BP), b2 = vtr(bb + 16 * ks * BP + 64), b3 = vtr(bb + (16 * ks + 4) * BP + 64);
                st0 = MFMA32(__builtin_shufflevector(b0, b1, 0, 1, 2, 3, 4, 5, 6, 7), xf, st0);
                st1 = MFMA32(__builtin_shufflevector(b2, b3, 0, 1, 2, 3, 4, 5, 6, 7), xf, st1);
            }
#pragma unroll
            for (int vq = 0; vq < 4; ++vq) { u32x2 o; o.x = cvtpk(st0[4 * vq], st0[4 * vq + 1]); o.y = cvtpk(st0[4 * vq + 2], st0[4 * vq + 3]);
                *(LAS u32x2*)(Snxt + (32 * pt2 + c32) * CP + (32 * ntb + 8 * vq + 4 * hh) * 2) = o;
                o.x = cvtpk(st1[4 * vq], st1[4 * vq + 1]); o.y = cvtpk(st1[4 * vq + 2], st1[4 * vq + 3]);
                *(LAS u32x2*)(Snxt + (32 * pt2 + c32) * CP + (32 * (ntb + 1) + 8 * vq + 4 * hh) * 2) = o; }
        }
        if (c + 1 < 64) { SSD_PREP(c + 1);
#pragma unroll
            for (int ks = 0; ks < 8; ++ks) cc_[ks] = cf[ks]; }
        __syncthreads();
    }
#undef SSD_LOAD
#undef SSD_PREP
    if (w >= 4) {
        float* sout = F.out + O_PSSM + ((size_t)(b * 16 + h) * 64 + 32 * pt2 + c32) * 128 + 32 * ntb + 4 * hh;
#pragma unroll
        for (int vq = 0; vq < 4; ++vq) { *(f32x4*)(sout + 8 * vq) = (f32x4){st0[4 * vq], st0[4 * vq + 1], st0[4 * vq + 2], st0[4 * vq + 3]};
            *(f32x4*)(sout + 32 + 8 * vq) = (f32x4){st1[4 * vq], st1[4 * vq + 1], st1[4 * vq + 2], st1[4 * vq + 3]}; }
    }
}

__device__ __forceinline__ void mini_mma(f32x16& acc, const bf16_t* wrow, const bf16_t* arow, int nks) {
#pragma unroll 8
    for (int s = 0; s < nks; ++s) acc = MFMA32(*(const bf16x8*)(wrow + 16 * s), *(const bf16x8*)(arow + 16 * s), acc);
}
__device__ __forceinline__ void p3_sample_item(Frame& F, int it) {
    const int lane = F.lane, w = F.wave, c = lane & 31, h = lane >> 5, rb = it >> 5, cb = it & 31;
    const size_t row = (size_t)RP + 32 * rb + c;
    LAS float* red = (LAS float*)F.lds;
    f32x16 a;
#pragma unroll
    for (int v = 0; v < 16; ++v) a[v] = 0.f;
    {   const bf16_t* ar = F.ACAT + row * LDA + 256 * w + 8 * h; const bf16_t* wr_ = F.WbrT + (size_t)(32 * cb + c) * 2048 + 256 * w + 8 * h;
        bf16x8 af[16], wf[16];
#pragma unroll
        for (int s = 0; s < 16; ++s) { af[s] = *(const bf16x8*)(ar + 16 * s); wf[s] = *(const bf16x8*)(wr_ + 16 * s); }
#pragma unroll
        for (int s = 0; s < 16; ++s) a = MFMA32(wf[s], af[s], a); }
#pragma unroll
    for (int v = 0; v < 16; ++v) red[(w * 16 + v) * 64 + lane] = a[v];
    __syncthreads();
    if (w < 4) {
        const int vq = w;
        float sq = 0.f;
#pragma unroll
        for (int k = 0; k < 8; ++k) { const f32x4 q = *(const f32x4*)(F.SSQ + row * 32 + 4 * k); sq += (q[0] + q[1]) + (q[2] + q[3]); }
        const float rs = 1.0f / sqrtf(sq * (1.0f / 1024.0f) + EPS);
        const int n = 32 * cb + 8 * vq + 4 * h;
        const bf16_t* gp = F.U + row * LDU + U_GATE + n;
        const u32x2 g0 = *(const u32x2*)gp, g1 = *(const u32x2*)(gp + 1024), g2 = *(const u32x2*)(gp + 2048);
        float o[4];
#pragma unroll
        for (int e = 0; e < 4; ++e) {
            const int v = 4 * vq + e;
            const float a0 = (red[(0 * 16 + v) * 64 + lane] + red[(1 * 16 + v) * 64 + lane]) + (red[(2 * 16 + v) * 64 + lane] + red[(3 * 16 + v) * 64 + lane]);
            const float a1 = red[(4 * 16 + v) * 64 + lane] + red[(5 * 16 + v) * 64 + lane], a2 = red[(6 * 16 + v) * 64 + lane] + red[(7 * 16 + v) * 64 + lane];
            const float x0 = __uint_as_float((e & 1) ? ((e >> 1 ? g0.y : g0.x) & 0xffff0000u) : ((e >> 1 ? g0.y : g0.x) << 16));
            const float x1 = __uint_as_float((e & 1) ? ((e >> 1 ? g1.y : g1.x) & 0xffff0000u) : ((e >> 1 ? g1.y : g1.x) << 16));
            const float x2 = __uint_as_float((e & 1) ? ((e >> 1 ? g2.y : g2.x) & 0xffff0000u) : ((e >> 1 ? g2.y : g2.x) << 16));
            const float s0 = 1.0f / (1.0f + __expf(-x0)), s1 = 1.0f / (1.0f + __expf(-x1)), s2 = 1.0f / (1.0f + __expf(-x2));
            o[e] = s0 * rs * a0 + s1 * a1 + s2 * a2;
        }
        u32x2 wv; wv.x = cvtpk(o[0], o[1]); wv.y = cvtpk(o[2], o[3]);
        *(u32x2*)(F.MERGED + row * 1024 + n) = wv;
    }
    __syncthreads();
}
__device__ __forceinline__ void p4_sample_item(Frame& F, int it) {
    const int lane = F.lane, w = F.wave, c = lane & 31, h = lane >> 5, rb = it >> 4, cb = it & 15;
    const size_t srow = (size_t)32 * rb + c, row = (size_t)RP + srow;
    LAS float* red = (LAS float*)F.lds;
    f32x16 a0, a1;
#pragma unroll
    for (int v = 0; v < 16; ++v) { a0[v] = 0.f; a1[v] = 0.f; }
    {   const bf16_t* ar = F.MERGED + row * 1024 + 128 * w + 8 * h; const bf16_t* w0 = F.WoutT + (size_t)(64 * cb + c) * 1024 + 128 * w + 8 * h;
        bf16x8 af[8], wf[8], wg[8];
#pragma unroll
        for (int s = 0; s < 8; ++s) { af[s] = *(const bf16x8*)(ar + 16 * s); wf[s] = *(const bf16x8*)(w0 + 16 * s); wg[s] = *(const bf16x8*)(w0 + 32 * 1024 + 16 * s); }
#pragma unroll
        for (int s = 0; s < 8; ++s) { a0 = MFMA32(wf[s], af[s], a0); a1 = MFMA32(wg[s], af[s], a1); } }
#pragma unroll
    for (int v = 0; v < 16; ++v) { red[(w * 32 + v) * 64 + lane] = a0[v]; red[(w * 32 + 16 + v) * 64 + lane] = a1[v]; }
    __syncthreads();
    const int t = w >> 2, vq = w & 3, n = 64 * cb + 32 * t + 8 * vq + 4 * h;
    const f32x4 x = *(const f32x4*)(F.xs + srow * 1024 + n);
    f32x4 r;
#pragma unroll
    for (int e = 0; e < 4; ++e) { const int v = 16 * t + 4 * vq + e; float sacc = 0.f;
#pragma unroll
        for (int k = 0; k < 8; ++k) sacc += red[(k * 32 + v) * 64 + lane];
        r[e] = x[e] + sacc; }
    *(f32x4*)(F.out + row * 1024 + n) = r;
    float ssq = (r[0] * r[0] + r[1] * r[1]) + (r[2] * r[2] + r[3] * r[3]);
    ssq += __shfl_xor(ssq, 32);
    __syncthreads();
    if (h == 0) red[w * 32 + c] = ssq;
    __syncthreads();
    if (w == 0 && h == 0) { float sacc = 0.f;
#pragma unroll
        for (int k = 0; k < 8; ++k) sacc += red[k * 32 + c];
        F.RSQ[row * 16 + cb] = sacc; }
    __syncthreads();
}
__device__ __forceinline__ void att_sample_wave(Frame& F, int srow, int head, LAS float* qs) {
    const int lane = F.lane, t = srow & 3, b = srow >> 2; const size_t row = (size_t)RP + srow;
    LAS float* sb = qs + 128;
    const int dq = lane & 15, rs = lane >> 4;
    float mrun = -1e30f, lrun = 0.f; f32x4 o = (f32x4){0.f, 0.f, 0.f, 0.f};
#pragma unroll
    for (int g = 0; g < 3; ++g) {
        const int dil = g == 0 ? 1 : (g == 1 ? 4 : 16), W = 128 * dil;
        const float* cache = (g == 0 ? F.cw128 : (g == 1 ? F.cw512 : F.cw2048)) + (size_t)b * W * 1024 + head * 64;
        const int qoff = U_QKV + g * 1536 + head * 64;
        const int jn = g == 0 ? t + 1 : 1, ncache = 129 - jn;
        LDS_WAIT(); asm volatile("" ::: "memory");
        qs[lane] = bf2f(F.U[row * LDU + qoff + lane]);
        LDS_WAIT(); asm volatile("" ::: "memory");
        float lm = -1e30f;
        if (lane < 4) { float sn = -1e30f; if (lane < jn) sn = dot64_bf16(F.U + (size_t)(RP + b * 4 + t - dil * lane) * LDU + qoff + 512, qs); sb[lane] = sn; lm = sn; }
#pragma unroll 1
        for (int p = 0; p < 2; ++p) { const int jj = p * 64 + lane; float s = -1e30f;
            if (jj < ncache) s = dot64_f32(cache + (size_t)(W + t - dil * (jn + jj)) * 1024, qs);
            sb[4 + jj] = s; lm = fmaxf(lm, s); }
        const float gm = wave_max(lm);
        const float mnew = fmaxf(mrun, gm), fsc = __expf(mrun - mnew);
        float ps = 0.f;
#pragma unroll 1
        for (int p = 0; p < 3; ++p) { const int k = p * 64 + lane; if (k < 132) { const float s = sb[k]; const float pr = s > -1e29f ? __expf(s - mnew) : 0.f; sb[k] = pr; ps += pr; } }
        lrun = lrun * fsc + wave_sum(ps); o = o * fsc; mrun = mnew;
        LDS_WAIT(); asm volatile("" ::: "memory");
        if (rs < jn) { const u32x2 vv = *(const u32x2*)(F.U + (size_t)(RP + b * 4 + t - dil * rs) * LDU + qoff + 1024 + 4 * dq); const float pj = sb[rs];
            o += pj * (f32x4){__uint_as_float(vv.x << 16), __uint_as_float(vv.x & 0xffff0000u), __uint_as_float(vv.y << 16), __uint_as_float(vv.y & 0xffff0000u)}; }
        const float* vbase = cache + 512 + 4 * dq;
#pragma unroll 1
        for (int j0 = 0; j0 < 128; j0 += 64) {
            f32x4 vv[16];
#pragma unroll
            for (int u = 0; u < 16; ++u) { int jj = j0 + 4 * u + rs; jj = jj < ncache ? jj : ncache - 1; vv[u] = *(const f32x4*)(vbase + (size_t)(W + t - dil * (jn + jj)) * 1024); }
#pragma unroll
            for (int u = 0; u < 16; ++u) o += sb[4 + j0 + 4 * u + rs] * vv[u];
        }
    }
#pragma unroll
    for (int e = 0; e < 4; ++e) { o[e] += __shfl_xor(o[e], 16); o[e] += __shfl_xor(o[e], 32); }
    if (rs == 0) { const u32x2 zz = *(const u32x2*)(F.U + row * LDU + U_ZA + head * 64 + 4 * dq); const float inv = 1.0f / lrun;
        u32x2 w; w.x = pk2(o[0] * inv * silu_f(__uint_as_float(zz.x << 16)), o[1] * inv * silu_f(__uint_as_float(zz.x & 0xffff0000u)));
        w.y = pk2(o[2] * inv * silu_f(__uint_as_float(zz.y << 16)), o[3] * inv * silu_f(__uint_as_float(zz.y & 0xffff0000u)));
        *(u32x2*)(F.ACAT + row * LDA + 1024 + head * 64 + 4 * dq) = w; }
}
__device__ __forceinline__ void mem_sample_wave(Frame& F, int srow, int head, LAS float* qs) {
    const int lane = F.lane, b = srow >> 2; const size_t row = (size_t)RP + srow;
    LAS float* sb = qs + 128;
    const float* cache = F.cmem + (size_t)b * 256 * 1024 + head * 128;
    LDS_WAIT(); asm volatile("" ::: "memory");
    qs[lane] = bf2f(F.U[row * LDU + U_QM + head * 128 + lane]) * 0.08838834764831845f;
    qs[lane + 64] = bf2f(F.U[row * LDU + U_QM + head * 128 + 64 + lane]) * 0.08838834764831845f;
    LDS_WAIT(); asm volatile("" ::: "memory");
    float lm = -1e30f;
#pragma unroll 1
    for (int p = 0; p < 4; ++p) { const int m = p * 64 + lane; const float* kp = cache + (size_t)m * 1024;
        float s = 0.f;
#pragma unroll
        for (int hf = 0; hf < 2; ++hf) { f32x4 kk[16];
#pragma unroll
            for (int cc = 0; cc < 16; ++cc) kk[cc] = *(const f32x4*)(kp + 64 * hf + 4 * cc);
#pragma unroll
            for (int cc = 0; cc < 16; ++cc) { const f32x4 q0 = *(const LAS f32x4*)(qs + 64 * hf + 4 * cc); s += kk[cc][0] * q0[0] + kk[cc][1] * q0[1] + kk[cc][2] * q0[2] + kk[cc][3] * q0[3]; } }
        sb[m] = s; lm = fmaxf(lm, s); }
    const float gm = wave_max(lm);
    float ps = 0.f;
#pragma unroll 1
    for (int p = 0; p < 4; ++p) { const float pr = __expf(sb[p * 64 + lane] - gm); sb[p * 64 + lane] = pr; ps += pr; }
    const float l = wave_sum(ps);
    LDS_WAIT(); asm volatile("" ::: "memory");
    const int dq = lane & 31, rs = lane >> 5;
    f32x4 o = (f32x4){0.f, 0.f, 0.f, 0.f};
    const float* vbase = cache + 512 + 4 * dq;
#pragma unroll 1
    for (int m0 = 0; m0 < 256; m0 += 32) {
        f32x4 vv[16];
#pragma unroll
        for (int u = 0; u < 16; ++u) vv[u] = *(const f32x4*)(vbase + (size_t)(m0 + 2 * u + rs) * 1024);
#pragma unroll
        for (int u = 0; u < 16; ++u) o += sb[m0 + 2 * u + rs] * vv[u];
    }
#pragma unroll
    for (int e = 0; e < 4; ++e) o[e] += __shfl_xor(o[e], 32);
    if (rs == 0) { const u32x2 zz = *(const u32x2*)(F.U + row * LDU + U_ZM + head * 128 + 4 * dq); const float inv = 1.0f / l;
        u32x2 w; w.x = pk2(o[0] * inv * silu_f(__uint_as_float(zz.x << 16)), o[1] * inv * silu_f(__uint_as_float(zz.x & 0xffff0000u)));
        w.y = pk2(o[2] * inv * silu_f(__uint_as_float(zz.y << 16)), o[3] * inv * silu_f(__uint_as_float(zz.y & 0xffff0000u)));
        *(u32x2*)(F.ACAT + row * LDA + 1536 + head * 128 + 4 * dq) = w; }
}
__device__ __forceinline__ void ssd_naive_unit(Frame& F, bool samp, int b, int h) {
    const int tid = F.tid, lane = F.lane, wave = F.wave;
    const int T = samp ? 4 : 4096, row0 = samp ? RP + b * 4 : b * 4096, g = h >> 2;
    constexpr int CH = 64;
    LAS float* xc = (LAS float*)F.lds;
    LAS float* dtv = xc + CH * 320;
    LAS float* ybuf = dtv + CH;
    const int p = tid >> 3, nq = tid & 7;
    float st[16];
    float* sout = F.out + (samp ? O_SSSM : O_PSSM) + ((size_t)(b * 16 + h) * 64 + p) * 128 + nq * 16;
    if (samp) { const float* sp = F.sssm + ((size_t)(b * 16 + h) * 64 + p) * 128 + nq * 16;
#pragma unroll
        for (int i = 0; i < 4; ++i) { const f32x4 v = *(const f32x4*)(sp + 4 * i); st[4 * i] = v[0]; st[4 * i + 1] = v[1]; st[4 * i + 2] = v[2]; st[4 * i + 3] = v[3]; } }
    else {
#pragma unroll
        for (int i = 0; i < 16; ++i) st[i] = 0.f; }
    const float a = -__expf(F.a_log[h]), dsk = F.d_skip[h], dtb = F.dt_bias[h];
#pragma unroll 1
    for (int t0 = 0; t0 < T; t0 += CH) {
        const int nst = (T - t0) < CH ? (T - t0) : CH;
        for (int idx = tid; idx < nst * 320; idx += NTHREADS) {
            const int s = idx / 320, c = idx - s * 320;
            const int ch = c < 64 ? h * 64 + c : (c < 192 ? 1024 + g * 128 + (c - 64) : 1536 + g * 128 + (c - 192));
            xc[s * 320 + c] = bf2f(F.XC[(size_t)(row0 + t0 + s) * 2048 + ch - 0]);
        }
        if (tid < nst) { const float x = F.DT[(size_t)(row0 + t0 + tid) * 16 + h] + dtb; dtv[tid] = x > 20.f ? x : log1pf(__expf(x)); }
        __syncthreads();
#pragma unroll 1
        for (int s = 0; s < nst; ++s) {
            const float dt = dtv[s], dA = __expf(dt * a), xv = xc[s * 320 + p], dtx = dt * xv;
            const LAS f32x4* Bp = (const LAS f32x4*)(xc + s * 320 + 64 + nq * 16); const LAS f32x4* Cp = (const LAS f32x4*)(xc + s * 320 + 192 + nq * 16);
            float y = 0.f;
#pragma unroll
            for (int i = 0; i < 4; ++i) { const f32x4 bv = Bp[i], cv = Cp[i];
#pragma unroll
                for (int e = 0; e < 4; ++e) { st[4 * i + e] = st[4 * i + e] * dA + dtx * bv[e]; y += cv[e] * st[4 * i + e]; } }
            y += __shfl_xor(y, 1); y += __shfl_xor(y, 2); y += __shfl_xor(y, 4);
            if (nq == 0) ybuf[s * 64 + p] = y + dsk * xv;
        }
        __syncthreads();
        for (int s = wave; s < nst; s += NWAVES) {
            const int row = row0 + t0 + s;
            const float z = bf2f(F.U[(size_t)row * LDU + U_Z + h * 64 + lane]);
            const float v = ybuf[s * 64 + lane] * silu_f(z);
            F.ACAT[(size_t)row * LDA + h * 64 + lane] = (bf16_t)f2bf(v);
            const float q = wave_sum(v * v);
            if (lane == 0) { F.SSQ[(size_t)row * 32 + 2 * h] = q; F.SSQ[(size_t)row * 32 + 2 * h + 1] = 0.f; }
        }
        __syncthreads();
    }
#pragma unroll
    for (int i = 0; i < 4; ++i) *(f32x4*)(sout + 4 * i) = (f32x4){st[4 * i], st[4 * i + 1], st[4 * i + 2], st[4 * i + 3]};
}
__device__ __forceinline__ void ssd_sample_item(Frame& F, int b, int h0) {
    const int lane = F.lane, w = F.wave, h = h0 + (w >> 2), pq = w & 3, g = h >> 2, p = 16 * pq + (lane >> 2), nc = lane & 3;
    LAS float* sq = (LAS float*)F.lds;
    const size_t so = ((size_t)(b * 16 + h) * 64 + p) * 128 + 32 * nc;
    float st[32];
#pragma unroll
    for (int i = 0; i < 8; ++i) { const f32x4 v = *(const f32x4*)(F.sssm + so + 4 * i); st[4 * i] = v[0]; st[4 * i + 1] = v[1]; st[4 * i + 2] = v[2]; st[4 * i + 3] = v[3]; }
    const float a = -__expf(F.a_log[h]), dsk = F.d_skip[h], dtb = F.dt_bias[h];
#pragma unroll 1
    for (int t = 0; t < 4; ++t) {
        const size_t row = (size_t)RP + 4 * b + t;
        const float xx = F.DT[row * 16 + h] + dtb; const float dt = xx > 20.f ? xx : log1pf(__expf(xx));
        const float dA = __expf(dt * a), xv = bf2f(F.XC[row * 2048 + h * 64 + p]), dtx = dt * xv;
        const bf16_t* bp = F.XC + row * 2048 + 1024 + g * 128 + 32 * nc;
        float y = 0.f;
#pragma unroll
        for (int i = 0; i < 4; ++i) { const u32x4 bv = *(const u32x4*)(bp + 8 * i), cv = *(const u32x4*)(bp + 512 + 8 * i);
#pragma unroll
            for (int e = 0; e < 4; ++e) { const float b0 = __uint_as_float(bv[e] << 16), b1 = __uint_as_float(bv[e] & 0xffff0000u), c0 = __uint_as_float(cv[e] << 16), c1 = __uint_as_float(cv[e] & 0xffff0000u);
                st[8 * i + 2 * e] = st[8 * i + 2 * e] * dA + dtx * b0; y += c0 * st[8 * i + 2 * e];
                st[8 * i + 2 * e + 1] = st[8 * i + 2 * e + 1] * dA + dtx * b1; y += c1 * st[8 * i + 2 * e + 1]; } }
        y += __shfl_xor(y, 1); y += __shfl_xor(y, 2);
        const float z = bf2f(F.U[row * LDU + U_Z + h * 64 + p]);
        const float v = (y + dsk * xv) * silu_f(z);
        if (nc == 0) F.ACAT[row * LDA + h * 64 + p] = (bf16_t)f2bf(v);
        const float q = wave_sum(nc == 0 ? v * v : 0.f);
        if (lane == 0) sq[(w >> 2) * 16 + t * 4 + pq] = q;
    }
#pragma unroll
    for (int i = 0; i < 8; ++i) *(f32x4*)(F.out + O_SSSM + so + 4 * i) = (f32x4){st[4 * i], st[4 * i + 1], st[4 * i + 2], st[4 * i + 3]};
    __syncthreads();
    if (F.tid < 8) { const int hl = F.tid >> 2, t = F.tid & 3; const LAS float* q4 = sq + hl * 16 + t * 4;
        const size_t row = (size_t)RP + 4 * b + t; F.SSQ[row * 32 + 2 * (h0 + hl)] = (q4[0] + q4[1]) + (q4[2] + q4[3]); F.SSQ[row * 32 + 2 * (h0 + hl) + 1] = 0.f; }
}
__device__ __forceinline__ void p2_mixers(const Args& args, unsigned char* lds, int qword, int it_lo = 0, int it_hi = 1 << 30) {
    Frame F0; F0.lds = (LAS unsigned char*)lds; F0.tid = threadIdx.x; F0.wave = __builtin_amdgcn_readfirstlane(F0.tid >> 6); F0.ctl = (unsigned*)(args.ws + WS_CTL);
#define F F0
    constexpr int N_SSDP = 128, N_ATTP = 512, N_MEMP = 512, N_ATTS = 512, N_MEMS = 256, N_SSDS = 1024, N_ITEMS = N_SSDP + N_ATTP + N_MEMP + N_ATTS + N_MEMS + N_SSDS;
    volatile LAS int* slot = (volatile LAS int*)(F.lds + MISC_OFF + 64);
    LAS float* qs = (LAS float*)(F.lds + 112 * 1024 + F.wave * 2048);
    LAS char* vl = (LAS char*)(F.lds + F.wave * 10240);
    for (;;) {
        __syncthreads();
        if (F.tid == 0) *slot = (int)__hip_atomic_fetch_add(F.ctl + qword, 1u, RLX_AGENT);
        __syncthreads();
        int it = *slot + it_lo;
        if (it >= N_ITEMS || it >= it_hi) break;
#define P2_FRAME() FRAME(); asm volatile("" : "+v"(F.lane), "+v"(F.tid))
#undef F
        if (it < N_SSDP) { P2_FRAME(); ssd_prompt_unit(F, it >> 4, it & 15); continue; } it -= N_SSDP;
        const int grp = it / 11, r = it - 11 * grp;
        if (r < 2) { const int i = 2 * grp + r; P2_FRAME(); att_prompt_item(F, i >> 6, i & 7, (i >> 3) & 7, (LAS char*)F.lds + F.wave * 6144); continue; }
        if (r < 4) { const int i = 2 * grp + r - 2; P2_FRAME(); mem_prompt_item(F, i >> 6, i & 3, ((i >> 2) & 15) * 256); continue; }
        if (r < 6) { const int i = 2 * grp + r - 4; P2_FRAME(); att_sample_wave(F, i, F.wave, (LAS float*)(F.lds + 112 * 1024 + F.wave * 2048)); continue; }
        if (r == 6) { const int i = grp; P2_FRAME(); mem_sample_wave(F, i * 2 + (F.wave >> 2), F.wave & 3, (LAS float*)(F.lds + 112 * 1024 + F.wave * 2048)); continue; }
        { const int i = 4 * grp + r - 7; P2_FRAME(); ssd_sample_item(F, i >> 3, 2 * (i & 7)); }
#define F F0
    }
#undef F
#undef P2_FRAME
}
__device__ __forceinline__ void p5_final_norm(Frame& F) {
    const int gw = F.vcu * NWAVES + F.wave, NGW = F.G * NWAVES, lane = F.lane;
    f32x4 w[4];
#pragma unroll
    for (int j = 0; j < 4; ++j) w[j] = ((const f32x4*)F.norm_f_w)[lane + 64 * j];
    for (int m = gw; m < RT; m += NGW) {
        const f32x4* q = (const f32x4*)(F.RSQ + (size_t)m * 16); const f32x4 a = q[0], b = q[1], c = q[2], d = q[3];
        const float s = ((a[0] + a[1]) + (a[2] + a[3])) + ((b[0] + b[1]) + (b[2] + b[3])) + ((c[0] + c[1]) + (c[2] + c[3])) + ((d[0] + d[1]) + (d[2] + d[3]));
        const float rstd = 1.0f / sqrtf(s * (1.0f / 1024.0f) + EPS);
        f32x4* o = (f32x4*)(F.out + (size_t)m * 1024) + lane;
#pragma unroll
        for (int j = 0; j < 4; ++j) o[64 * j] = o[64 * j] * rstd * w[j];
    }
}
__global__ void __launch_bounds__(NTHREADS, 2) fwd_kernel(Args args) {
    extern __shared__ __attribute__((aligned(16))) unsigned char lds[];
    const int tid0 = threadIdx.x; const int wave0 = __builtin_amdgcn_readfirstlane(tid0 >> 6);
    for (int u = tid0; u < (LDS_BYTES - LDSCTL_OFF) / 4; u += NTHREADS) ((LAS unsigned*)((LAS unsigned char*)lds + LDSCTL_OFF))[u] = 0u;
    __syncthreads();
    const int lo = args.ph_lo, hi = args.ph_hi;
#if MK_ONE_LAUNCH
    XcdBarrier bar = xcd_barrier_post((unsigned*)(args.ws + WS_CTL) + CW_BAR, (volatile LAS unsigned*)((LAS unsigned char*)lds + MISC_OFF) + 8);
#define GRID_BAR() xcd_barrier(bar)
#else
#define GRID_BAR() do { } while (0)
#endif
#ifndef PH_MASK
#define PH_MASK 63
#endif
#define IN(k) (((PH_MASK >> (k)) & 1) && lo <= (k) && (k) < hi)
#define BOTH(k) (IN(k) && IN((k) + 1))

#ifndef PX_REPEAT
#define PX_REPEAT -1
#endif
    if (IN(0)) { { FRAME(); p0_prologue(F); }
#if PX_REPEAT == 0
        GRID_BAR(); { FRAME(); p0_prologue(F); }
#endif
        if (BOTH(0)) GRID_BAR(); }

#ifndef P1_REPEAT
#define P1_REPEAT 1
#endif
#ifndef P2_REPEAT
#define P2_REPEAT 1
#endif
#define P1_BODY() do { FRAME(); \
        pg8::Gemm g{F.XB, F.WinT, 1024, F.MB, F.WmemT}; pg8::TileOrder S; S.init(RT / 256, 48, F.G, (int)blockIdx.x, 1, 16, 8, 4); \
        EpiIn E{F.U, F.MKV, F.CS, F.out}; \
        pg8::gemm_phase<EpiIn, pg8::TileOrder, true>(F.lds, g, S, E, F.tid); } while (0)
    if (IN(1)) {
        P1_BODY();
#if P1_REPEAT == 2
        GRID_BAR(); P1_BODY();
#endif
        GRID_BAR();
        { FRAME(); p1c_conv(F); }
        if (BOTH(1)) GRID_BAR();
    }

    if (IN(2)) {
#pragma unroll 1
        for (int rep = 0; rep < P2_REPEAT; ++rep) { p2_mixers(args, lds, CW_Q + 64 * rep); if (rep + 1 < P2_REPEAT) GRID_BAR(); }
#ifdef P2_EXTRA_LO
        GRID_BAR(); p2_mixers(args, lds, CW_Q + 192, P2_EXTRA_LO, P2_EXTRA_HI);
#endif
        if (BOTH(2)) GRID_BAR(); }

    if (IN(3)) {
        { FRAME();
        for (int it = (int)blockIdx.x; it < 512; it += F.G) p3_sample_item(F, it);
        pg8::Gemm g{F.ACAT, F.WbrT, 2048, nullptr, nullptr}; pg8::TileOrder S; S.init(RP / 256, 4, F.G, (int)blockIdx.x, 3, 0);
        EpiBr E{F.U, F.SSQ, F.MERGED};
        pg8::gemm_phase<EpiBr, pg8::TileOrder, true>(F.lds, g, S, E, F.tid); }
#if PX_REPEAT == 3
        GRID_BAR();
        { FRAME();
        pg8::Gemm g{F.ACAT, F.WbrT, 2048, nullptr, nullptr}; pg8::TileOrder S; S.init(RT / 256, 4, F.G, (int)blockIdx.x, 3, 0);
        EpiBr E{F.U, F.SSQ, F.MERGED};
        pg8::gemm_phase<EpiBr, pg8::TileOrder, true>(F.lds, g, S, E, F.tid); }
#endif
        if (BOTH(3)) GRID_BAR();
    }

    if (IN(4)) {
        { FRAME();
        for (int it = (int)blockIdx.x; it < 256; it += F.G) p4_sample_item(F, it);
        pg8::Gemm g{F.MERGED, F.WoutT, 1024, nullptr, nullptr}; pg8::TileOrder S; S.init(RP / 256, 4, F.G, (int)blockIdx.x, 1, 16);
        EpiOut E{F.xp, F.xs, F.out, F.RSQ};
        pg8::gemm_phase<EpiOut, pg8::TileOrder, true>(F.lds, g, S, E, F.tid); }
#if PX_REPEAT == 4
        GRID_BAR();
        { FRAME();
        pg8::Gemm g{F.MERGED, F.WoutT, 1024, nullptr, nullptr}; pg8::TileOrder S; S.init(RT / 256, 4, F.G, (int)blockIdx.x, 1, 16);
        EpiOut E{F.xp, F.xs, F.out, F.RSQ};
        pg8::gemm_phase<EpiOut, pg8::TileOrder, true>(F.lds, g, S, E, F.tid); }
#endif
        if (BOTH(4)) GRID_BAR();
    }

    if (IN(5)) { FRAME(); p5_final_norm(F); }
#undef IN
#undef BOTH
}

extern "C" void kernel_launch(void* const* d_in, const int* in_sizes, int n_in, void* d_out, int out_size, void* d_ws, size_t ws_size, hipStream_t stream) {
    static int grid = 0;
    if (grid == 0) {
        if (n_in != 24 || (size_t)out_size != O_TOTAL || ws_size < WS_END) { fprintf(stderr, "kernel_launch: unexpected problem shape (n_in %d, out %d, ws %zu, need %zu); nothing launched\n", n_in, out_size, ws_size, (size_t)WS_END); grid = -1; return; }
        int dev = 0, cus = 0, per_cu = 0;
        if (hipGetDevice(&dev) != hipSuccess || hipDeviceGetAttribute(&cus, hipDeviceAttributeMultiprocessorCount, dev) != hipSuccess) { grid = -1; return; }
        if (hipFuncSetAttribute((const void*)fwd_kernel, hipFuncAttributeMaxDynamicSharedMemorySize, LDS_BYTES) != hipSuccess) { fprintf(stderr, "kernel_launch: hipFuncSetAttribute failed\n"); grid = -1; return; }
        if (hipOccupancyMaxActiveBlocksPerMultiprocessor(&per_cu, (const void*)fwd_kernel, NTHREADS, LDS_BYTES) != hipSuccess || per_cu < 1)
            fprintf(stderr, "kernel_launch: note: occupancy query reports %d workgroups per CU\n", per_cu);
        (void)hipGetLastError();
        grid = cus;
    }
    if (grid < 0) return;
    if (hipMemsetAsync((char*)d_ws + WS_CTL, 0, CTL_ZERO_BYTES, stream) != hipSuccess) { fprintf(stderr, "kernel_launch: memset failed\n"); return; }
    Args a{};
    {
        static const int dict_sizes[24] = {33554432, 524288, 2097152, 16777216, 67108864, 268435456, 33554432, 786432, 16777216, 1024, 12599296, 8192, 2048, 16, 16, 16, 1024, 1024, 1048576, 1048576, 524288, 524288, 1048576, 1024};
        static const int sorted_to_dict[24] = {14, 6, 3, 5, 4, 12, 11, 15, 13, 17, 2, 23, 9, 16, 7, 8, 20, 21, 19, 10, 18, 22, 0, 1};
        bool is_dict = true, is_sorted = true;
        for (int i = 0; i < 24; ++i) { if (in_sizes[i] != dict_sizes[i]) is_dict = false; if (in_sizes[i] != dict_sizes[sorted_to_dict[i]]) is_sorted = false; }
        if (is_dict) { for (int i = 0; i < 24; ++i) a.in[i] = (const float*)d_in[i]; }
        else if (is_sorted) { for (int i = 0; i < 24; ++i) a.in[sorted_to_dict[i]] = (const float*)d_in[i]; }
        else { fprintf(stderr, "kernel_launch: input sizes match neither the dict order nor the sorted-key order; nothing launched\n"); return; }
    }
    a.out = (float*)d_out; a.ws = (unsigned char*)d_ws;
#if MK_ONE_LAUNCH
    a.ph_lo = 0; a.ph_hi = 6;
    hipLaunchKernelGGL(fwd_kernel, dim3(grid), dim3(NTHREADS), LDS_BYTES, stream, a);
#else
    for (int ph = 0; ph < 6; ++ph) { a.ph_lo = ph; a.ph_hi = ph + 1; hipLaunchKernelGGL(fwd_kernel, dim3(grid), dim3(NTHREADS), LDS_BYTES, stream, a); }
#endif
    const hipError_t le = hipPeekAtLastError();
    if (le != hipSuccess) fprintf(stderr, "kernel_launch: launch failed: %s\n", hipGetErrorName(le));
}
```
